# Optimizing an MI355X kernel written in HIP

```python
import jax, jax.numpy as jnp
from jax import lax
import numpy as np

D_MODEL = 2048
BATCH = 4
SEQ = 4096
DEPTH = 2

GRID_W = 64
CTX_LEN = 256
N_GROUPS = 4
GROUP_WIDTH = D_MODEL // N_GROUPS
HEAD_DIM = 128
N_HEADS = GROUP_WIDTH // HEAD_DIM
CHUNK = 64
GDN_CONV = 5
NA_ROWS = 8
NA_COLS = 16
MLA_Q_RANK = 384
MLA_KV_RANK = 256
MLA_NOPE = 128
MLA_ROPE = 64
MLA_V = 128
MLA_QK_DIM = MLA_NOPE + MLA_ROPE
ROPE_BASE = 10000.0
HGRN_FDIM = 128
Q_BLOCK = 128
MLP_HIDDEN = 4 * D_MODEL
ALPHA = (2 * DEPTH) ** 0.25
BETA_INIT = (8 * DEPTH) ** -0.25
LN_EPS = 1e-5
RMS_EPS = 1e-6
ADA_SCALE = 0.5

GDN_IN = 4 * GROUP_WIDTH + 4 * N_HEADS
NA_IN = 3 * GROUP_WIDTH
MLA_IN = MLA_Q_RANK + MLA_KV_RANK + MLA_ROPE
HGRN_IN = 5 * GROUP_WIDTH
IN_COLS = GDN_IN + NA_IN + MLA_IN + HGRN_IN

kernel_name = 'hybrid_parallel_heads_diffusion_block'

F32 = jnp.float32


def _split(z, sizes):
    return jnp.split(z, [int(s) for s in np.cumsum(sizes)[:-1]], axis=-1)


def _heads(t, d):
    B, L, _ = t.shape
    return t.reshape(B, L, -1, d).transpose(0, 2, 1, 3)


def _merge(t):
    B, H, L, d = t.shape
    return t.transpose(0, 2, 1, 3).reshape(B, L, H * d)


def _layernorm(x, w, b):
    xf = x.astype(F32)
    mu = jnp.mean(xf, -1, keepdims=True)
    var = jnp.mean(jnp.square(xf - mu), -1, keepdims=True)
    return ((xf - mu) * lax.rsqrt(var + LN_EPS) * w + b).astype(x.dtype)


def _rmsnorm(x, w):
    xf = x.astype(F32)
    return (xf * lax.rsqrt(jnp.mean(xf * xf, -1, keepdims=True) + RMS_EPS) * w).astype(x.dtype)


def _l2norm(t):
    t = t.astype(F32)
    return t * lax.rsqrt(jnp.sum(t * t, -1, keepdims=True) + RMS_EPS)


def _gated_head_norm(o, gate, w, dtype):
    o = o * lax.rsqrt(jnp.mean(o * o, -1, keepdims=True) + RMS_EPS) * w
    return (_merge(o) * jax.nn.silu(gate.astype(F32))).astype(dtype)


def _short_conv(x, w):
    K = w.shape[0]
    P = K // 2
    L = x.shape[1]
    xp = jnp.pad(x, ((0, 0), (P, P), (0, 0)))
    y = xp[:, 0:L] * w[0]
    for i in range(1, K):
        y = y + xp[:, i:i + L] * w[i]
    return jax.nn.silu(y)


def _to_chunks(t):
    B, H, L = t.shape[:3]
    return jnp.moveaxis(t.reshape(B, H, L // CHUNK, CHUNK, *t.shape[3:]), 2, 0)


def _from_chunks(o):
    n, B, H, C, d = o.shape
    return jnp.moveaxis(o, 0, 2).reshape(B, H, n * C, d)


def _gdn_chunk_scan(q, k, v, g, beta, state, emit):
    dv = v.shape[-1]
    incl = jnp.tril(jnp.ones((CHUNK, CHUNK), dtype=bool))
    strict = jnp.tril(jnp.ones((CHUNK, CHUNK), dtype=bool), -1)
    eye = jnp.eye(CHUNK, dtype=F32)

    def step(S, inp):
        qc, kc, vc, gc, bc = inp
        cum = jnp.cumsum(gc, axis=-1)
        decay = jnp.exp(jnp.where(incl, cum[..., :, None] - cum[..., None, :], -jnp.inf))
        kb = kc * bc[..., None]
        a = jnp.where(strict, jnp.einsum('bhtd,bhsd->bhts', kb, kc) * decay, 0.0)
        rhs = jnp.concatenate([vc * bc[..., None], kb * jnp.exp(cum)[..., None]], -1)
        sol = lax.linalg.triangular_solve(eye + a, rhs, left_side=True, lower=True, unit_diagonal=True)
        u, w = sol[..., :dv], sol[..., dv:]
        v_new = u - jnp.einsum('bhtd,bhdv->bhtv', w, S)
        last = cum[..., -1:]
        S_new = S * jnp.exp(last)[..., None] + jnp.einsum(
            'bhsd,bhsv->bhdv', kc * jnp.exp(last - cum)[..., None], v_new)
        if not emit:
            return S_new, None
        attn = jnp.where(incl, jnp.einsum('bhtd,bhsd->bhts', qc, kc) * decay, 0.0)
        o = jnp.einsum('bhtd,bhdv->bhtv', qc * jnp.exp(cum)[..., None], S) + jnp.einsum('bhts,bhsv->bhtv', attn, v_new)
        return S_new, o

    S, o = lax.scan(step, state, (_to_chunks(q), _to_chunks(k), _to_chunks(v), _to_chunks(g), _to_chunks(beta)))
    return S, (_from_chunks(o) if emit else None)


def _gla_chunk_scan(q, k, v, logf, state, emit):
    incl = jnp.tril(jnp.ones((CHUNK, CHUNK), dtype=bool))

    def step(S, inp):
        qc, kc, vc, gc = inp
        cum = jnp.cumsum(gc, axis=2)
        last = cum[:, :, -1]
        S_new = S * jnp.exp(last)[..., None] + jnp.einsum(
            'bhsd,bhsv->bhdv', kc * jnp.exp(last[:, :, None] - cum), vc)
        if not emit:
            return S_new, None
        diff = cum[:, :, :, None, :] - cum[:, :, None, :, :]
        decay = jnp.exp(jnp.where(incl[:, :, None], diff, -jnp.inf))
        scores = jnp.einsum('bhtd,bhsd,bhtsd->bhts', qc, kc, decay)
        o = jnp.einsum('bhts,bhsv->bhtv', scores, vc) + jnp.einsum('bhtd,bhdv->bhtv', qc * jnp.exp(cum), S)
        return S_new, o

    S, o = lax.scan(step, state, (_to_chunks(q), _to_chunks(k), _to_chunks(v), _to_chunks(logf)))
    return S, (_from_chunks(o) if emit else None)


def _bidirectional_prefix_scan(scan, ctx_f, ctx_b, lat_f, lat_b, state0, emit_ctx):
    def flip(ts):
        return tuple(jnp.flip(t, 2) for t in ts)
    s_f, oc_f = scan(*ctx_f, state0, emit_ctx)
    s_b, oc_b = scan(*flip(ctx_b), state0, emit_ctx)
    _, ol_f = scan(*lat_f, s_f, True)
    _, ol_b = scan(*flip(lat_b), s_b, True)
    o_lat = ol_f + jnp.flip(ol_b, 2)
    o_ctx = (oc_f + jnp.flip(oc_b, 2)) if emit_ctx else None
    return o_lat, o_ctx


def _gdn_mixer(zl, zc, conv_w, a_log, dt_bias, norm_w, emit_ctx):
    def prep(z):
        B, L, _ = z.shape
        qkv, gate, a, b = _split(z, [3 * GROUP_WIDTH, GROUP_WIDTH, 2 * N_HEADS, 2 * N_HEADS])
        q, k, v = jnp.split(_short_conv(qkv, conv_w), 3, axis=-1)
        q = _l2norm(_heads(q, HEAD_DIM)) * HEAD_DIM ** -0.5
        k = _l2norm(_heads(k, HEAD_DIM))
        v = _heads(v, HEAD_DIM).astype(F32)
        a = a.reshape(B, L, 2, N_HEADS).astype(F32)
        b = b.reshape(B, L, 2, N_HEADS).astype(F32)
        g = -jnp.exp(a_log.astype(F32)) * jax.nn.softplus(a + dt_bias.astype(F32))
        beta = jax.nn.sigmoid(b)
        g = jnp.transpose(g, (2, 0, 3, 1))
        beta = jnp.transpose(beta, (2, 0, 3, 1))
        return q, k, v, g, beta, gate

    qc, kc, vc, gc, bc, gate_c = prep(zc)
    ql, kl, vl, gl, bl, gate_l = prep(zl)
    B = zl.shape[0]
    s0 = jnp.zeros((B, N_HEADS, HEAD_DIM, HEAD_DIM), F32)
    o_lat, o_ctx = _bidirectional_prefix_scan(
        _gdn_chunk_scan,
        (qc, kc, vc, gc[0], bc[0]), (qc, kc, vc, gc[1], bc[1]),
        (ql, kl, vl, gl[0], bl[0]), (ql, kl, vl, gl[1], bl[1]), s0, emit_ctx)
    nw = norm_w.astype(F32)
    y_lat = _gated_head_norm(o_lat, gate_l, nw, zl.dtype)
    y_ctx = _gated_head_norm(o_ctx, gate_c, nw, zc.dtype) if emit_ctx else None
    return y_lat, y_ctx


def _blocked_attention(q, k, v, scale):
    B, H, S, dq = q.shape
    nb = S // Q_BLOCK
    qb = jnp.moveaxis(q.reshape(B, H, nb, Q_BLOCK, dq), 2, 0)

    def blk(qi):
        s = jnp.einsum('bhqd,bhkd->bhqk', qi, k).astype(F32) * scale
        p = jax.nn.softmax(s, axis=-1).astype(v.dtype)
        return jnp.einsum('bhqk,bhkd->bhqd', p, v)

    o = lax.map(blk, qb)
    return jnp.moveaxis(o, 0, 2).reshape(B, H, S, v.shape[-1])


def _neighbourhood_attention(q, k, v, kc, vc, rpb):
    B, H, S, dh = q.shape
    rows = S // GRID_W
    kr = min(NA_ROWS, rows)
    scale = dh ** -0.5
    qg = q.reshape(B, H, rows, GRID_W, dh)
    kg = k.reshape(B, H, rows, GRID_W, dh)
    vg = v.reshape(B, H, rows, GRID_W, dh)
    r = jnp.arange(rows)
    row_idx = jnp.clip(r - kr // 2, 0, rows - kr)[:, None] + jnp.arange(kr)[None, :]
    kw = kg[:, :, row_idx]
    vw = vg[:, :, row_idx]
    col = jnp.arange(GRID_W)
    c0 = jnp.clip(col - NA_COLS // 2, 0, GRID_W - NA_COLS)
    col_ok = (col[None, :] >= c0[:, None]) & (col[None, :] < c0[:, None] + NA_COLS)
    dr = row_idx - r[:, None] + NA_ROWS - 1
    dc = jnp.clip(col[None, :] - col[:, None], 1 - NA_COLS, NA_COLS - 1) + NA_COLS - 1
    bias = rpb[:, dr[:, None, :, None], dc[None, :, None, :]].astype(F32)
    s_win = jnp.einsum('bhrqd,bhrkwd->bhrqkw', qg, kw).astype(F32) * scale + bias
    s_win = jnp.where(col_ok[:, None, :], s_win, -jnp.inf)
    s_ctx = jnp.einsum('bhrqd,bhcd->bhrqc', qg, kc).astype(F32) * scale
    n_win = kr * GRID_W
    p = jax.nn.softmax(jnp.concatenate([s_win.reshape(B, H, rows, GRID_W, n_win), s_ctx], -1), axis=-1)
    p = p.astype(v.dtype)
    o = jnp.einsum('bhrqkw,bhrkwd->bhrqd', p[..., :n_win].reshape(s_win.shape), vw) + jnp.einsum(
        'bhrqc,bhcd->bhrqd', p[..., n_win:], vc)
    return o.reshape(B, H, S, dh)


def _na_mixer(zl, zc, rpb, emit_ctx):
    ql, kl, vl = [_heads(t, HEAD_DIM) for t in jnp.split(zl, 3, axis=-1)]
    qc, kc, vc = [_heads(t, HEAD_DIM) for t in jnp.split(zc, 3, axis=-1)]
    y_lat = _merge(_neighbourhood_attention(ql, kl, vl, kc, vc, rpb))
    y_ctx = _merge(_blocked_attention(qc, kc, vc, HEAD_DIM ** -0.5)) if emit_ctx else None
    return y_lat, y_ctx


def _axial_rope_tables(seq):
    n_freq = MLA_ROPE // 4
    freqs = ROPE_BASE ** (-jnp.arange(n_freq, dtype=F32) / n_freq)
    t = jnp.arange(seq)
    ang = jnp.concatenate([(t // GRID_W).astype(F32)[:, None] * freqs,
                           (t % GRID_W).astype(F32)[:, None] * freqs], -1)
    return jnp.cos(ang), jnp.sin(ang)


def _apply_rope(x, cos, sin):
    x1, x2 = x[..., 0::2], x[..., 1::2]
    out = jnp.stack([x1 * cos - x2 * sin, x1 * sin + x2 * cos], -1)
    return out.reshape(x.shape).astype(x.dtype)


def _mla_queries(z, q_norm_w, w_uq, rope):
    q = _heads(_rmsnorm(z[..., :MLA_Q_RANK], q_norm_w) @ w_uq, MLA_QK_DIM)
    if rope is not None:
        q = jnp.concatenate([q[..., :MLA_NOPE], _apply_rope(q[..., MLA_NOPE:], *rope)], -1)
    return q


def _mla_keys_values(z, kv_norm_w, w_uk, w_uv, rope):
    ckv = _rmsnorm(z[..., MLA_Q_RANK:MLA_Q_RANK + MLA_KV_RANK], kv_norm_w)
    k_rope = z[..., MLA_Q_RANK + MLA_KV_RANK:][:, None]
    if rope is not None:
        k_rope = _apply_rope(k_rope, *rope)
    k_nope = _heads(ckv @ w_uk, MLA_NOPE)
    v = _heads(ckv @ w_uv, MLA_V)
    k = jnp.concatenate([k_nope, jnp.broadcast_to(k_rope, k_nope.shape[:3] + (MLA_ROPE,))], -1)
    return k, v


def _mla_mixer(zl, zc, q_norm_w, kv_norm_w, w_uq, w_uk, w_uv, rope, emit_ctx):
    scale = MLA_QK_DIM ** -0.5
    kc, vc = _mla_keys_values(zc, kv_norm_w, w_uk, w_uv, None)
    kl, vl = _mla_keys_values(zl, kv_norm_w, w_uk, w_uv, rope)
    ql = _mla_queries(zl, q_norm_w, w_uq, rope)
    y_lat = _merge(_blocked_attention(ql, jnp.concatenate([kl, kc], 2), jnp.concatenate([vl, vc], 2), scale))
    y_ctx = None
    if emit_ctx:
        y_ctx = _merge(_blocked_attention(_mla_queries(zc, q_norm_w, w_uq, None), kc, vc, scale))
    return y_lat, y_ctx


def _hgrn_mixer(zl, zc, lb, norm_w, emit_ctx):
    lb = lb.astype(F32).reshape(N_HEADS, 1, HGRN_FDIM)

    def prep(z):
        q, f_f, f_b, i, gate = jnp.split(z, 5, axis=-1)
        q = _heads(jax.nn.silu(q), HGRN_FDIM).astype(F32) * HGRN_FDIM ** -0.5
        i = _heads(i, GROUP_WIDTH // N_HEADS).astype(F32)

        def gates(fz):
            f = lb + (1.0 - lb) * jax.nn.sigmoid(_heads(fz, HGRN_FDIM).astype(F32))
            return 1.0 - f, jnp.log(f)
        k_f, g_f = gates(f_f)
        k_b, g_b = gates(f_b)
        return q, i, k_f, g_f, k_b, g_b, gate

    qc, ic, kcf, gcf, kcb, gcb, gate_c = prep(zc)
    ql, il, klf, glf, klb, glb, gate_l = prep(zl)
    B = zl.shape[0]
    s0 = jnp.zeros((B, N_HEADS, HGRN_FDIM, GROUP_WIDTH // N_HEADS), F32)
    o_lat, o_ctx = _bidirectional_prefix_scan(
        _gla_chunk_scan,
        (qc, kcf, ic, gcf), (qc, kcb, ic, gcb),
        (ql, klf, il, glf), (ql, klb, il, glb), s0, emit_ctx)
    nw = norm_w.astype(F32)
    y_lat = _gated_head_norm(o_lat, gate_l, nw, zl.dtype)
    y_ctx = _gated_head_norm(o_ctx, gate_c, nw, zc.dtype) if emit_ctx else None
    return y_lat, y_ctx


def _sqrelu_mlp(h, w1, w2):
    return jnp.square(jax.nn.relu(h @ w1)) @ w2


def setup_inputs(seed: int = 0) -> dict:
    key = jax.random.key(seed)
    ks = jax.random.split(key, 26)
    nrm = jax.random.normal
    L = DEPTH
    dt = jnp.exp(jax.random.uniform(ks[9], (L, 2, N_HEADS)) * (np.log(0.1) - np.log(0.001)) + np.log(0.001))
    return {
        'x': nrm(ks[0], (BATCH, SEQ, D_MODEL), F32),
        'c': nrm(ks[1], (BATCH, D_MODEL), F32),
        'ctx': nrm(ks[2], (BATCH, CTX_LEN, D_MODEL), F32),
        'c_ctx': nrm(ks[3], (D_MODEL,), F32),
        'w_ada': nrm(ks[4], (L, D_MODEL, 6 * D_MODEL), F32) * (ADA_SCALE * D_MODEL ** -0.5),
        'b_ada': nrm(ks[5], (L, 6 * D_MODEL), F32) * 0.02,
        'w_in': nrm(ks[6], (L, D_MODEL, IN_COLS), F32) * D_MODEL ** -0.5,
        'gdn_conv_w': nrm(ks[7], (L, GDN_CONV, 3 * GROUP_WIDTH), F32) * GDN_CONV ** -0.5,
        'gdn_a_log': jnp.log(jax.random.uniform(ks[8], (L, 2, N_HEADS), F32, 1.0, 16.0)),
        'gdn_dt_bias': (dt + jnp.log(-jnp.expm1(-dt))).astype(F32),
        'gdn_norm_w': 1.0 + 0.1 * nrm(ks[10], (L, HEAD_DIM), F32),
        'na_rpb': 0.1 * nrm(ks[11], (L, N_HEADS, 2 * NA_ROWS - 1, 2 * NA_COLS - 1), F32),
        'mla_q_norm_w': 1.0 + 0.1 * nrm(ks[12], (L, MLA_Q_RANK), F32),
        'mla_kv_norm_w': 1.0 + 0.1 * nrm(ks[13], (L, MLA_KV_RANK), F32),
        'mla_w_uq': nrm(ks[14], (L, MLA_Q_RANK, N_HEADS * MLA_QK_DIM), F32) * MLA_Q_RANK ** -0.5,
        'mla_w_uk': nrm(ks[15], (L, MLA_KV_RANK, N_HEADS * MLA_NOPE), F32) * MLA_KV_RANK ** -0.5,
        'mla_w_uv': nrm(ks[16], (L, MLA_KV_RANK, N_HEADS * MLA_V), F32) * MLA_KV_RANK ** -0.5,
        'hgrn_lower_bounds': 0.5 * nrm(ks[17], (L, GROUP_WIDTH), F32),
        'hgrn_norm_w': 1.0 + 0.1 * nrm(ks[18], (L, GROUP_WIDTH // N_HEADS), F32),
        'w_out': nrm(ks[19], (L, D_MODEL, D_MODEL), F32) * (BETA_INIT * D_MODEL ** -0.5),
        'ln1_w': 1.0 + 0.1 * nrm(ks[20], (L, D_MODEL), F32),
        'ln1_b': 0.02 * nrm(ks[21], (L, D_MODEL), F32),
        'w_mlp1': nrm(ks[22], (L, D_MODEL, MLP_HIDDEN), F32) * D_MODEL ** -0.5,
        'w_mlp2': nrm(ks[23], (L, MLP_HIDDEN, D_MODEL), F32) * (BETA_INIT * MLP_HIDDEN ** -0.5),
        'ln2_w': 1.0 + 0.1 * nrm(ks[24], (L, D_MODEL), F32),
        'ln2_b': 0.02 * nrm(ks[25], (L, D_MODEL), F32),
    }


def reference(x, c, ctx, c_ctx, w_ada, b_ada, w_in, gdn_conv_w, gdn_a_log, gdn_dt_bias, gdn_norm_w,
              na_rpb, mla_q_norm_w, mla_kv_norm_w, mla_w_uq, mla_w_uk, mla_w_uv, hgrn_lower_bounds,
              hgrn_norm_w, w_out, ln1_w, ln1_b, w_mlp1, w_mlp2, ln2_w, ln2_b):
    rope = _axial_rope_tables(x.shape[1])
    p_lb = jax.nn.softmax(hgrn_lower_bounds.astype(F32), axis=0)
    lbs = jnp.cumsum(p_lb, axis=0) - p_lb[0]
    xc = ctx
    for l in range(DEPTH):
        emit_ctx = l < DEPTH - 1
        ada = (jax.nn.silu(c) @ w_ada[l] + b_ada[l])[:, None, :]
        ada_c = jax.nn.silu(c_ctx) @ w_ada[l] + b_ada[l]
        sh1, sc1, g1, sh2, sc2, g2 = jnp.split(ada, 6, axis=-1)
        sh1c, sc1c, g1c, sh2c, sc2c, g2c = jnp.split(ada_c, 6, axis=-1)
        zl = (x * (1 + sc1) + sh1) @ w_in[l]
        zc = (xc * (1 + sc1c) + sh1c) @ w_in[l]
        za, zb, zm, zh = _split(zl, [GDN_IN, NA_IN, MLA_IN, HGRN_IN])
        zac, zbc, zmc, zhc = _split(zc, [GDN_IN, NA_IN, MLA_IN, HGRN_IN])
        ya, yac = _gdn_mixer(za, zac, gdn_conv_w[l], gdn_a_log[l], gdn_dt_bias[l], gdn_norm_w[l], emit_ctx)
        yb, ybc = _na_mixer(zb, zbc, na_rpb[l], emit_ctx)
        ym, ymc = _mla_mixer(zm, zmc, mla_q_norm_w[l], mla_kv_norm_w[l], mla_w_uq[l], mla_w_uk[l],
                             mla_w_uv[l], rope, emit_ctx)
        yh, yhc = _hgrn_mixer(zh, zhc, lbs[l], hgrn_norm_w[l], emit_ctx)
        y = jnp.concatenate([ya, yb, ym, yh], axis=-1) @ w_out[l]
        x = _layernorm(ALPHA * x + g1 * y, ln1_w[l], ln1_b[l])
        m = _sqrelu_mlp(x * (1 + sc2) + sh2, w_mlp1[l], w_mlp2[l])
        x = _layernorm(ALPHA * x + g2 * m, ln2_w[l], ln2_b[l])
        if emit_ctx:
            yc = jnp.concatenate([yac, ybc, ymc, yhc], axis=-1) @ w_out[l]
            xc = _layernorm(ALPHA * xc + g1c * yc, ln1_w[l], ln1_b[l])
            mc = _sqrelu_mlp(xc * (1 + sc2c) + sh2c, w_mlp1[l], w_mlp2[l])
            xc = _layernorm(ALPHA * xc + g2c * mc, ln2_w[l], ln2_b[l])
    return x
```

```cpp
#include <hip/hip_runtime.h>
#include <hip/hip_cooperative_groups.h>
#include <cstdio>
#include <cstdint>
namespace cg = cooperative_groups;
#define LAS __attribute__((address_space(3)))
typedef unsigned short bf16;
typedef unsigned v4u __attribute__((ext_vector_type(4)));
typedef unsigned v2u __attribute__((ext_vector_type(2)));
typedef float f32x4 __attribute__((ext_vector_type(4)));
typedef float f32x2 __attribute__((ext_vector_type(2)));
typedef short bf16x8 __attribute__((ext_vector_type(8)));

constexpr int DM = 2048, NBATCH = 4, SEQ = 4096, CTX = 256, NLAT = NBATCH * SEQ, NCTX = NBATCH * CTX, RT = NLAT + NCTX;
constexpr int ZC = 6864, ZP = 6912;
constexpr int C_GDN = 0, C_NA = 2064, C_MLA = 3600, C_HG = 4304;
constexpr int FF = 8192, ADAW = 12288;
constexpr float LOG2E = 1.4426950408889634f;
constexpr float ALPHA_RES = 1.4142135623730951f;

constexpr size_t MiB = 1u << 20;
constexpr size_t WS_ADA = 1 * MiB;
constexpr size_t WS_WIN = 2 * MiB, WS_WOUT = 29 * MiB, WS_WM1 = 37 * MiB, WS_WM2 = 69 * MiB, WS_WUQ = 101 * MiB, WS_WUK = 102 * MiB, WS_WUV = 102 * MiB + 512 * 1024;
constexpr size_t WS_AY = 104 * MiB;
constexpr size_t WS_X = 172 * MiB;
constexpr size_t WS_ZH = 308 * MiB;
constexpr size_t WS_GQKV = 580 * MiB;
constexpr size_t WS_QN = 631 * MiB, WS_CKVN = 644 * MiB, WS_MQ = 653 * MiB, WS_MK = 679 * MiB, WS_MVT = 696 * MiB, WS_NAVT = 713 * MiB, WS_KROPE = 730 * MiB, WS_GB = 733 * MiB;
constexpr size_t WS_ROPE = 735 * MiB;
constexpr size_t WS_HSC = 736 * MiB;
constexpr size_t WS_GSCAL = 753 * MiB;
constexpr size_t WS_HDL = 755 * MiB;
constexpr size_t WS_HQD = 538 * MiB;
constexpr size_t WS_HKE2 = 572 * MiB;
constexpr size_t WS_PO = WS_QN, WS_PML = 643 * MiB;
constexpr size_t WS_PART = 757 * MiB;
constexpr size_t WS_END = 765 * MiB;
static_assert(WS_PO + (size_t)192 * 256 * 128 * 2 <= WS_PML && WS_PML + (size_t)192 * 256 * 2 * 4 <= WS_CKVN, "split-KV partials");
static_assert(WS_ZH + (size_t)RT * ZP * 2 <= WS_HQD && WS_HQD + (size_t)2176 * 16384 <= WS_HKE2 && WS_HKE2 + (size_t)512 * 16384 <= WS_GQKV, "hgrn pre-pass buffers in the z/h tail");
static_assert(WS_WIN + (size_t)ZP * DM * 2 <= WS_WOUT && WS_WM2 + (size_t)DM * FF * 2 <= WS_WUQ && WS_WUQ + 768 * 384 * 2 <= WS_WUK, "weights map");
static_assert(WS_AY + (size_t)RT * DM * 2 <= WS_X && WS_X + (size_t)RT * DM * 4 <= WS_ZH && WS_ZH + (size_t)RT * FF * 2 <= WS_GQKV, "act map");
static_assert(WS_GQKV + (size_t)RT * 1536 * 2 <= WS_QN && WS_QN + (size_t)RT * 384 * 2 <= WS_CKVN && WS_CKVN + (size_t)RT * 256 * 2 <= WS_MQ && WS_MQ + (size_t)RT * 768 * 2 <= WS_MK, "mixer map");
static_assert(WS_MK + (size_t)RT * 512 * 2 <= WS_MVT && WS_MVT + (size_t)RT * 512 * 2 <= WS_NAVT && WS_NAVT + (size_t)RT * 512 * 2 <= WS_KROPE && WS_KROPE + (size_t)RT * 64 * 2 <= WS_GB && WS_GB + (size_t)RT * 16 * 4 <= WS_END, "mixer map 2");
constexpr size_t OUT_OG = 0, OUT_OH = 34 * MiB, OUT_GT = 68 * MiB, OUT_HKE = 102 * MiB;
static_assert(OUT_OH + (size_t)2 * RT * 512 * 2 <= OUT_GT && OUT_GT + (size_t)2176 * 2 * 8192 <= OUT_HKE && OUT_HKE + (size_t)1664 * 16384 <= (size_t)NLAT * DM * 4, "d_out scratch");

constexpr int LDS_BYTES = 147456;

__device__ __forceinline__ float bf2f(unsigned short u) { return __builtin_bit_cast(float, (unsigned)u << 16); }
__device__ __forceinline__ float bflo(unsigned w) { return __builtin_bit_cast(float, w << 16); }
__device__ __forceinline__ float bfhi(unsigned w) { return __builtin_bit_cast(float, w & 0xffff0000u); }
__device__ __forceinline__ unsigned f2bf(float f) { unsigned u = __builtin_bit_cast(unsigned, f); return (u + 0x7fffu + ((u >> 16) & 1u)) >> 16; }
__device__ __forceinline__ unsigned pk2(float lo, float hi) { return f2bf(lo) | (f2bf(hi) << 16); }
__device__ __forceinline__ float wave_sum(float v) {
#pragma unroll
    for (int o = 1; o < 64; o <<= 1) v += __shfl_xor(v, o);
    return v;
}
__device__ __forceinline__ float sigmoidf_(float x) { return __builtin_amdgcn_rcpf(1.f + __expf(-x)); }
__device__ __forceinline__ float siluf_(float x) { return x * __builtin_amdgcn_rcpf(1.f + __expf(-x)); }
#define LDS_WAIT() asm volatile("s_waitcnt vmcnt(0) lgkmcnt(0)" ::: "memory")
#define LDS_BARRIER() do { asm volatile("s_waitcnt lgkmcnt(0)" ::: "memory"); __builtin_amdgcn_s_barrier(); asm volatile("" ::: "memory"); } while (0)

namespace pg8 {
#define PG8_LAS __attribute__((address_space(3)))
typedef unsigned short bf16_t;
typedef short bf16x8 __attribute__((ext_vector_type(8)));
typedef float f32x4 __attribute__((ext_vector_type(4)));
typedef unsigned u32x4 __attribute__((ext_vector_type(4)));
constexpr int BM = 256, BK = 64, HALF = 128, HTB = HALF * BK * 2  , STAGE_BYTES = 8 * HTB, NXCD = 8, WGM = 8;

__host__ __device__ __forceinline__ int lds_byte(int r, int c) { const int st = (r >> 4) * 2 + (c >> 5), rr = r & 15, cc = c & 31, ob = rr * 64 + cc * 2; return st * 1024 + (ob ^ (((ob >> 9) & 1) << 5)); }
__host__ __device__ __forceinline__ void stage_rc(int b, int& R, int& C) { const int st = b / 1024, sb = b % 1024, swz = sb ^ (((sb >> 9) & 1) << 5); R = (st >> 1) * 16 + swz / 64; C = (st & 1) * 32 + (swz % 64) / 2; }
__host__ __device__ __forceinline__ int perm32(int rho) { const int n = rho >> 4, i = rho & 15; return 8 * (i >> 2) + 4 * n + (i & 3); }

struct Unit { int pm, pn, ks; };
struct Gemm { const bf16_t* A; const bf16_t* Bt; int M, N, K, lda, ldb; };

struct StaticOrder {
    int nM, nN, nwg, G, c;
    __host__ __device__ void init(int M, int N, int G_, int c_) { nM = M / BM; nN = N / BM; nwg = nM * nN; G = G_; c = c_; }
    __host__ __device__ bool next(int i, Unit& u) const {
        const long L = (long)i * G + c; if (L >= nwg) return false;
        int wgid = (int)L; { const int q = nwg / NXCD, r = nwg % NXCD, xcd = wgid % NXCD, off = wgid / NXCD; wgid = (xcd < r ? xcd * (q + 1) : r * (q + 1) + (xcd - r) * q) + off; }
        const int nig = WGM * nN, gid = wgid / nig, fm = gid * WGM, gsz = (nM - fm) < WGM ? (nM - fm) : WGM;
        u.pm = fm + ((wgid % nig) % gsz); u.pn = (wgid % nig) / gsz; u.ks = 0; return true;
    }
    __device__ __forceinline__ void a_ready(const Unit&) const {}
    __device__ __forceinline__ void done(const Unit&) const {}
};

struct SplitKOrder {
    int nM, nN, KS, nwg, G, c;
    __host__ __device__ void init(int M, int N, int KS_, int G_, int c_) { nM = M / BM; nN = N / BM; KS = KS_; nwg = nM * nN * KS; G = G_; c = c_; }
    __host__ __device__ bool next(int i, Unit& u) const {
        const long L = (long)i * G + c; if (L >= nwg) return false;
        const int t = (int)L; u.ks = t % KS; const int r = t / KS; u.pm = r % nM; u.pn = r / nM; return true;
    }
    __device__ __forceinline__ void a_ready(const Unit&) const {}
    __device__ __forceinline__ void done(const Unit&) const {}
};

template <class Epi, class Sched, bool ALIGN_EPI = false, bool SP2 = false>
__device__ __forceinline__ void gemm_phase(PG8_LAS unsigned char* lds, const Gemm g, const Sched& S, const Epi& E) {
    int tid_ = threadIdx.x; asm volatile("" : "+v"(tid_));
    const int tid = tid_, wid = __builtin_amdgcn_readfirstlane(tid >> 6), lane = tid & 63, wr = wid >> 2, wc = wid & 3, fr = lane & 15, fq = lane >> 4;
    const int K = g.K, nt = K / BK;
    unsigned voffA[2], voffB[2];
#pragma unroll
    for (int i = 0; i < 2; ++i) { int R, C; stage_rc(tid * 16 + i * 8192, R, C); const int Rb = Epi::PERM ? ((R & ~31) + perm32(R & 31)) : R;
        voffA[i] = (unsigned)(R * g.lda + C) * 2u; voffB[i] = (unsigned)(Rb * g.ldb + C) * 2u; }
    const size_t kstep = (size_t)(BK * 2);
    const size_t hstepA = (size_t)HALF * g.lda * 2, hstepB = (size_t)HALF * g.ldb * 2;
    const size_t tstepA = 2 * hstepA, tstepB = 2 * hstepB, sstep = (size_t)K * 2;
    const unsigned ldsw = (unsigned)wid * 1024u;
    const int aoff = lds_byte(wr * 64 + fr, fq * 8), boff = lds_byte(wc * 32 + fr, fq * 8);
#define PG8_SA(b, h) (((b) * 2 + (h)) * HTB)
#define PG8_SB(b, h) ((4 + (b) * 2 + (h)) * HTB)
#define PG8_STAGE(bufoff, gbase, voff) do { _Pragma("unroll") for (int _i = 0; _i < 2; ++_i) \
        __builtin_amdgcn_global_load_lds((const unsigned*)((const char*)(gbase) + (voff)[_i]), (PG8_LAS unsigned*)(lds + (bufoff) + ldsw + _i * 8192), 16, 0, 0); } while (0)
#define PG8_LDA(dst, b, h) do { _Pragma("unroll") for (int m = 0; m < 4; ++m) _Pragma("unroll") for (int k = 0; k < 2; ++k) dst[m][k] = *(const PG8_LAS bf16x8*)(lds + PG8_SA(b, h) + aoff + m * 2048 + k * 1024); } while (0)
#define PG8_LDB(dst, b, h) do { _Pragma("unroll") for (int n = 0; n < 2; ++n) _Pragma("unroll") for (int k = 0; k < 2; ++k) dst[n][k] = *(const PG8_LAS bf16x8*)(lds + PG8_SB(b, h) + boff + n * 2048 + k * 1024); } while (0)
#define PG8_MMA(ai, bj, At, Bt) do { __builtin_amdgcn_s_setprio(1); _Pragma("unroll") for (int m = 0; m < 4; ++m) _Pragma("unroll") for (int n = 0; n < 2; ++n) _Pragma("unroll") for (int k = 0; k < 2; ++k) \
        acc[ai][bj][m][n] = __builtin_amdgcn_mfma_f32_16x16x32_bf16(Bt[n][k], At[m][k], acc[ai][bj][m][n], 0, 0, 0); __builtin_amdgcn_s_setprio(0); } while (0)
#define PG8_WAIT_V(n) asm volatile("s_waitcnt vmcnt(" #n ")" ::: "memory")
#define PG8_WAIT_L(n) asm volatile("s_waitcnt lgkmcnt(" #n ")" ::: "memory")
#define PG8_BAR __builtin_amdgcn_s_barrier()
#define PG8_SCHED __builtin_amdgcn_sched_barrier(0)
    Unit cur, nxt; int ui = 0;
    if (!S.next(0, cur)) return;
    f32x4 acc[2][2][4][2];
#pragma unroll
    for (int a = 0; a < 2; ++a)
#pragma unroll
        for (int b = 0; b < 2; ++b)
#pragma unroll
            for (int m = 0; m < 4; ++m)
#pragma unroll
                for (int n = 0; n < 2; ++n) acc[a][b][m][n] = (f32x4){0.f, 0.f, 0.f, 0.f};
    bf16x8 At[4][2], B0[2][2], B1[2][2];
    const char* cA = (const char*)g.A + (size_t)cur.pm * tstepA + (size_t)cur.ks * sstep; const char* cB = (const char*)g.Bt + (size_t)cur.pn * tstepB + (size_t)cur.ks * sstep;
    S.a_ready(cur);
    if constexpr (SP2) {
        PG8_STAGE(PG8_SB(0, 0), cB, voffB); PG8_STAGE(PG8_SB(0, 1), cB + hstepB, voffB); PG8_STAGE(PG8_SA(0, 0), cA, voffA); PG8_STAGE(PG8_SA(0, 1), cA + hstepA, voffA);
        if (wr == 1) PG8_BAR;
        PG8_WAIT_V(2); PG8_BAR;
        PG8_STAGE(PG8_SB(1, 0), cB + kstep, voffB); PG8_STAGE(PG8_SA(1, 0), cA + kstep, voffA); PG8_STAGE(PG8_SB(1, 1), cB + hstepB + kstep, voffB);
        PG8_WAIT_V(6); PG8_BAR;
    } else {
        PG8_STAGE(PG8_SB(0, 0), cB, voffB); PG8_STAGE(PG8_SA(0, 0), cA, voffA); PG8_STAGE(PG8_SB(0, 1), cB + hstepB, voffB); PG8_STAGE(PG8_SA(0, 1), cA + hstepA, voffA);
        if (wr == 1) PG8_BAR;
        PG8_WAIT_V(4); PG8_BAR;
        PG8_STAGE(PG8_SB(1, 0), cB + kstep, voffB); PG8_STAGE(PG8_SA(1, 0), cA + kstep, voffA); PG8_STAGE(PG8_SB(1, 1), cB + hstepB + kstep, voffB);
        PG8_WAIT_V(6); PG8_BAR;
    }
    for (;;) {
        const bool has_next = S.next(ui + 1, nxt);
        const char* nA = has_next ? (const char*)g.A + (size_t)nxt.pm * tstepA + (size_t)nxt.ks * sstep : cA; const char* nB = has_next ? (const char*)g.Bt + (size_t)nxt.pn * tstepB + (size_t)nxt.ks * sstep : cB;
        for (int t = 0; t < nt; t += 2) {
            const bool last = (t == nt - 2);
            const char* a1 = cA + (size_t)(t + 1) * kstep;
            const char* a2 = last ? nA : cA + (size_t)(t + 2) * kstep; const char* b2 = last ? nB : cB + (size_t)(t + 2) * kstep;
            const char* a3 = a2 + kstep; const char* b3 = b2 + kstep;
            if (last && has_next) S.a_ready(nxt);
            if constexpr (SP2) {
            PG8_LDB(B0, 0, 0); PG8_LDB(B1, 0, 1); PG8_SCHED; PG8_LDA(At, 0, 0); PG8_STAGE(PG8_SA(1, 1), a1 + hstepA, voffA);
            PG8_WAIT_V(8); PG8_WAIT_L(0); PG8_BAR; PG8_MMA(0, 0, At, B0); PG8_MMA(0, 1, At, B1); PG8_BAR; PG8_SCHED;
            PG8_LDA(At, 0, 1); PG8_STAGE(PG8_SB(0, 0), b2, voffB); PG8_STAGE(PG8_SB(0, 1), b2 + hstepB, voffB); PG8_STAGE(PG8_SA(0, 0), a2, voffA);
            PG8_WAIT_V(8); PG8_WAIT_L(0); PG8_BAR; PG8_MMA(1, 0, At, B0); PG8_MMA(1, 1, At, B1); PG8_BAR; PG8_SCHED;
            PG8_LDB(B0, 1, 0); PG8_LDB(B1, 1, 1); PG8_SCHED; PG8_LDA(At, 1, 0); PG8_STAGE(PG8_SA(0, 1), a2 + hstepA, voffA);
            PG8_WAIT_V(8); PG8_WAIT_L(0); PG8_BAR; PG8_MMA(0, 0, At, B0); PG8_MMA(0, 1, At, B1); PG8_BAR; PG8_SCHED;
            PG8_LDA(At, 1, 1); PG8_STAGE(PG8_SB(1, 0), b3, voffB); PG8_STAGE(PG8_SB(1, 1), b3 + hstepB, voffB); PG8_STAGE(PG8_SA(1, 0), a3, voffA);
            PG8_WAIT_V(8); PG8_WAIT_L(0); PG8_BAR; PG8_MMA(1, 0, At, B0); PG8_MMA(1, 1, At, B1); PG8_BAR; PG8_SCHED;
            } else {
            PG8_LDB(B0, 0, 0); PG8_SCHED; PG8_LDA(At, 0, 0); PG8_STAGE(PG8_SA(1, 1), a1 + hstepA, voffA);
            PG8_WAIT_L(8); PG8_BAR; PG8_WAIT_L(0); PG8_MMA(0, 0, At, B0); PG8_BAR; PG8_SCHED;
            PG8_LDB(B1, 0, 1); PG8_STAGE(PG8_SB(0, 0), b2, voffB);
            PG8_BAR; PG8_WAIT_L(0); PG8_MMA(0, 1, At, B1); PG8_BAR;
            PG8_LDA(At, 0, 1); PG8_STAGE(PG8_SA(0, 0), a2, voffA);
            PG8_BAR; PG8_WAIT_L(0); PG8_MMA(1, 0, At, B0); PG8_BAR; PG8_SCHED;
            PG8_STAGE(PG8_SB(0, 1), b2 + hstepB, voffB);
            PG8_WAIT_V(6); PG8_BAR; PG8_MMA(1, 1, At, B1); PG8_BAR;
            PG8_LDB(B0, 1, 0); PG8_SCHED; PG8_LDA(At, 1, 0); PG8_STAGE(PG8_SA(0, 1), a2 + hstepA, voffA);
            PG8_WAIT_L(8); PG8_BAR; PG8_WAIT_L(0); PG8_MMA(0, 0, At, B0); PG8_BAR; PG8_SCHED;
            PG8_LDB(B1, 1, 1); PG8_STAGE(PG8_SB(1, 0), b3, voffB);
            PG8_BAR; PG8_WAIT_L(0); PG8_MMA(0, 1, At, B1); PG8_BAR;
            PG8_LDA(At, 1, 1); PG8_STAGE(PG8_SA(1, 0), a3, voffA);
            PG8_BAR; PG8_WAIT_L(0); PG8_MMA(1, 0, At, B0); PG8_BAR; PG8_SCHED;
            PG8_STAGE(PG8_SB(1, 1), b3 + hstepB, voffB);
            PG8_WAIT_V(6); PG8_BAR; PG8_MMA(1, 1, At, B1); PG8_BAR;
            }
        }
        if constexpr (ALIGN_EPI) { if (wr == 0) PG8_BAR; }
        if constexpr (!Epi::AFTER_DRAIN) { E(acc, cur, wr, wc, fr, fq); S.done(cur); }
        if (!has_next) break;
#pragma unroll
        for (int a = 0; a < 2; ++a)
#pragma unroll
            for (int b = 0; b < 2; ++b)
#pragma unroll
                for (int m = 0; m < 4; ++m)
#pragma unroll
                    for (int n = 0; n < 2; ++n) acc[a][b][m][n] = (f32x4){0.f, 0.f, 0.f, 0.f};
        cur = nxt; cA = nA; cB = nB; ++ui;
        if constexpr (ALIGN_EPI) { if (wr == 1) PG8_BAR; }
    }
    PG8_WAIT_V(0);
    if constexpr (!ALIGN_EPI) { if (wr == 0) PG8_BAR; }
    PG8_BAR;
    if constexpr (Epi::AFTER_DRAIN) { E.fused(acc, cur, wr, wc, fr, fq, lds, wid, lane); S.done(cur); }
#undef PG8_SA
#undef PG8_SB
#undef PG8_STAGE
#undef PG8_LDA
#undef PG8_LDB
#undef PG8_MMA
#undef PG8_WAIT_V
#undef PG8_WAIT_L
#undef PG8_BAR
#undef PG8_SCHED
}
}

namespace pg8 {
__device__ __forceinline__ unsigned cvt_pk_bf16(float lo, float hi) { unsigned r; asm volatile("v_cvt_pk_bf16_f32 %0, %1, %2" : "=v"(r) : "v"(lo), "v"(hi)); return r; }
template <int ACT> struct EpiStore {
    static constexpr bool PERM = true, AFTER_DRAIN = false;
    bf16_t* O; int ldc;
    __device__ __forceinline__ void operator()(const f32x4 (&acc)[2][2][4][2], const Unit& u, int wr, int wc, int fr, int fq) const {
        const int row0 = u.pm * BM + wr * 64 + fr, col0 = u.pn * BM + wc * 32 + 8 * fq;
#pragma unroll
        for (int ai = 0; ai < 2; ++ai)
#pragma unroll
            for (int m = 0; m < 4; ++m) { bf16_t* rowp = O + (size_t)(row0 + ai * HALF + m * 16) * ldc + col0;
#pragma unroll
                for (int bj = 0; bj < 2; ++bj) { f32x4 v0 = acc[ai][bj][m][0], v1 = acc[ai][bj][m][1];
                    if (ACT == 1) {
#pragma unroll
                        for (int j = 0; j < 4; ++j) { float a = fmaxf(v0[j], 0.f), b = fmaxf(v1[j], 0.f); v0[j] = a * a; v1[j] = b * b; } }
                    u32x4 w; w.x = cvt_pk_bf16(v0[0], v0[1]); w.y = cvt_pk_bf16(v0[2], v0[3]); w.z = cvt_pk_bf16(v1[0], v1[1]); w.w = cvt_pk_bf16(v1[2], v1[3]);
                    *(u32x4*)(rowp + bj * HALF) = w; } }
    }
};
struct EpiResid {
    static constexpr bool PERM = false, AFTER_DRAIN = false;
    const float* xlat; const float* xctx; float* out; const float* gbase; float alpha;
    __device__ __forceinline__ void operator()(const f32x4 (&acc)[2][2][4][2], const Unit& u, int wr, int wc, int fr, int fq) const {
#pragma unroll
        for (int ai = 0; ai < 2; ++ai)
#pragma unroll
            for (int m = 0; m < 4; ++m) {
                const int row = u.pm * BM + ai * HALF + wr * 64 + m * 16 + fr;
                const int v = row < NLAT ? (row >> 12) : 4;
                const float* xin = row < NLAT ? xlat + (size_t)row * DM : xctx + (size_t)(row - NLAT) * DM;
                const float* g = gbase + (size_t)v * ADAW;
                float* op = out + (size_t)row * DM;
#pragma unroll
                for (int bj = 0; bj < 2; ++bj)
#pragma unroll
                    for (int n = 0; n < 2; ++n) { const int col = u.pn * BM + bj * HALF + wc * 32 + n * 16 + fq * 4;
                        const f32x4 x4 = *(const f32x4*)(xin + col), g4 = *(const f32x4*)(g + col);
                        *(f32x4*)(op + col) = x4 * alpha + g4 * acc[ai][bj][m][n]; }
            }
    }
};
struct EpiCtxSplit {
    static constexpr bool PERM = false, AFTER_DRAIN = false;
    float* out; float* part; const float* g;
    __device__ __forceinline__ void operator()(const f32x4 (&acc)[2][2][4][2], const Unit& u, int wr, int wc, int fr, int fq) const {
#pragma unroll
        for (int ai = 0; ai < 2; ++ai)
#pragma unroll
            for (int m = 0; m < 4; ++m) {
                const size_t ro = (size_t)(u.pm * BM + ai * HALF + wr * 64 + m * 16 + fr) * DM;
#pragma unroll
                for (int bj = 0; bj < 2; ++bj)
#pragma unroll
                    for (int n = 0; n < 2; ++n) { const int col = u.pn * BM + bj * HALF + wc * 32 + n * 16 + fq * 4; const f32x4 v = *(const f32x4*)(g + col) * acc[ai][bj][m][n];
                        if (u.ks == 0) *(f32x4*)(out + ro + col) = *(const f32x4*)(out + ro + col) + v; else *(f32x4*)(part + ro + col) = v; }
            }
    }
};
}

struct Args { const float* in[26]; float* out; unsigned char* ws; };
typedef const float* cfp_t;
typedef const __attribute__((address_space(4))) cfp_t* kargp_t;
struct Fr {
    kargp_t kp; float* out; unsigned char* ws; unsigned char* lds;
    int tid, lane, wave, G, gw, NGW;
};
__device__ __forceinline__ const float* inp(const Fr& F, int k) { kargp_t p = F.kp; asm volatile("" : "+s"(p)); return p[k]; }
#define WSP(T, off) ((T*)(F.ws + (off)))
__device__ __forceinline__ Fr RL(const Fr& F0) { Fr F = F0; int t = threadIdx.x; asm volatile("" : "+v"(t)); F.tid = t; F.lane = t & 63; F.wave = __builtin_amdgcn_readfirstlane(t >> 6); F.gw = blockIdx.x * 8 + F.wave; return F; }

__device__ __forceinline__ void phase_ada(const Fr& F) {
    float* sl = (float*)F.lds;
    float* red = sl + 5 * 2048;
    float* ADA = WSP(float, WS_ADA);
    const float* p_c = inp(F, 1); const float* p_cc = inp(F, 3); const float* p_wada = inp(F, 4); const float* p_bada = inp(F, 5);
    for (int i = F.tid; i < 5 * 2048; i += 512) { const float c = (i < 4 * 2048) ? p_c[i] : p_cc[i - 4 * 2048]; sl[i] = siluf_(c); }
    __syncthreads();
    for (int it = blockIdx.x; it < 2 * 384; it += F.G) {
        const int l = it / 384, n0 = (it % 384) * 32, c4 = (F.tid & 7) * 4, ks = F.tid >> 3;
        const float* W = p_wada + (size_t)l * DM * ADAW + n0 + c4;
        f32x4 a0 = (f32x4){0.f, 0.f, 0.f, 0.f}, a1 = a0, a2 = a0, a3 = a0, a4 = a0;
        const int k0 = ks * 32;
#pragma unroll 16
        for (int k = 0; k < 32; ++k) { const f32x4 wv = *(const f32x4*)(W + (size_t)(k0 + k) * ADAW);
            a0 += wv * sl[k0 + k]; a1 += wv * sl[2048 + k0 + k]; a2 += wv * sl[4096 + k0 + k]; a3 += wv * sl[6144 + k0 + k]; a4 += wv * sl[8192 + k0 + k]; }
        *(f32x4*)(red + (ks * 5 + 0) * 32 + c4) = a0; *(f32x4*)(red + (ks * 5 + 1) * 32 + c4) = a1; *(f32x4*)(red + (ks * 5 + 2) * 32 + c4) = a2;
        *(f32x4*)(red + (ks * 5 + 3) * 32 + c4) = a3; *(f32x4*)(red + (ks * 5 + 4) * 32 + c4) = a4;
        __syncthreads();
        if (F.tid < 160) { const int v = F.tid >> 5, ln = F.tid & 31; float s = 0.f;
#pragma unroll 16
            for (int ww = 0; ww < 64; ++ww) s += red[(ww * 5 + v) * 32 + ln];
            ADA[((size_t)l * 5 + v) * ADAW + n0 + ln] = s + p_bada[(size_t)l * ADAW + n0 + ln]; }
        __syncthreads();
    }
    {
        f32x2* RP = WSP(f32x2, WS_ROPE);
        for (int e = blockIdx.x * 512 + F.tid; e < SEQ * 32; e += F.G * 512) { const int t = e >> 5, i = e & 31; const int pos = i < 16 ? (t >> 6) : (t & 63);
            const float freq = exp2f(-(float)(i & 15) * 0.8304820237218406f)  ; float sn, cs; sincosf((float)pos * freq, &sn, &cs); RP[e] = (f32x2){cs, sn}; }
    }
}

__device__ __forceinline__ void transpose_item(const float* W, int K, int N, int NP, bf16* WT, float* scr, int item, int lane) {
    const int nblk = NP / 32, kb = item / nblk, nb = item % nblk, k0 = 64 * kb, n0 = 32 * nb;
    const int l8 = lane & 7, kr = lane >> 3, nn = n0 + 4 * l8; const bool ok = nn < N;
    f32x4 wv[8];
#pragma unroll
    for (int i = 0; i < 8; ++i) { const int kk = 8 * i + kr; wv[i] = ok ? *(const f32x4*)(W + (size_t)(k0 + kk) * N + nn) : (f32x4){0.f, 0.f, 0.f, 0.f}; }
#pragma unroll
    for (int i = 0; i < 8; ++i) { const int kk = 8 * i + kr; float* d = scr + kk * 33 + 4 * l8; d[0] = wv[i][0]; d[1] = wv[i][1]; d[2] = wv[i][2]; d[3] = wv[i][3]; }
    LDS_WAIT();
    const int c = lane & 7;
#pragma unroll
    for (int j = 0; j < 4; ++j) { const int n = (lane >> 3) + 8 * j; const float* s = scr + (8 * c) * 33 + n;
        v4u o; o.x = pk2(s[0 * 33], s[1 * 33]); o.y = pk2(s[2 * 33], s[3 * 33]); o.z = pk2(s[4 * 33], s[5 * 33]); o.w = pk2(s[6 * 33], s[7 * 33]);
        *(v4u*)(WT + (size_t)(n0 + n) * K + k0 + 8 * c) = o; }
    LDS_WAIT();
}
__device__ __forceinline__ void phase_wconv(const Fr& F, int l, int mode, int w0, int nw) {
    float* scr = (float*)F.lds + F.wave * (64 * 33);
    constexpr int I_IN = 32 * 216, I_OUT = 32 * 64, I_M1 = 32 * 256, I_M2 = 128 * 64, I_UQ = 6 * 24, I_UK = 4 * 16, I_UV = 4 * 16;
    constexpr int NIT = I_IN + I_OUT + I_M1 + I_M2 + I_UQ + I_UK + I_UV;
    for (int q = w0; ; q += nw) {
        int it;
        if (mode == 0) { if (q >= I_IN + I_UQ + I_UK + I_UV) break; it = q < I_IN ? q : q + I_OUT + I_M1 + I_M2; }
        else { if (q >= I_OUT + I_M1 + I_M2) break; it = I_IN + q; }
        int r = it;
        if (r < I_IN) { transpose_item(inp(F, 6) + (size_t)l * DM * ZC, DM, ZC, ZP, WSP(bf16, WS_WIN), scr, r, F.lane); continue; } r -= I_IN;
        if (r < I_OUT) { transpose_item(inp(F, 19) + (size_t)l * DM * DM, DM, DM, DM, WSP(bf16, WS_WOUT), scr, r, F.lane); continue; } r -= I_OUT;
        if (r < I_M1) { transpose_item(inp(F, 22) + (size_t)l * DM * FF, DM, FF, FF, WSP(bf16, WS_WM1), scr, r, F.lane); continue; } r -= I_M1;
        if (r < I_M2) { transpose_item(inp(F, 23) + (size_t)l * FF * DM, FF, DM, DM, WSP(bf16, WS_WM2), scr, r, F.lane); continue; } r -= I_M2;
        if (r < I_UQ) { transpose_item(inp(F, 14) + (size_t)l * 384 * 768, 384, 768, 768, WSP(bf16, WS_WUQ), scr, r, F.lane); continue; } r -= I_UQ;
        if (r < I_UK) { transpose_item(inp(F, 15) + (size_t)l * 256 * 512, 256, 512, 512, WSP(bf16, WS_WUK), scr, r, F.lane); continue; } r -= I_UK;
        transpose_item(inp(F, 16) + (size_t)l * 256 * 512, 256, 512, 512, WSP(bf16, WS_WUV), scr, r, F.lane);
    }
}

__device__ __forceinline__ void phase_mod0(const Fr& F) {
    const float* ADA = WSP(float, WS_ADA); bf16* AY = WSP(bf16, WS_AY);
    const float* p_x = inp(F, 0); const float* p_ctx = inp(F, 2);
    f32x4 xv[8], xn[8];
    if (F.gw < RT) { const float* xr = F.gw < NLAT ? p_x + (size_t)F.gw * DM : p_ctx + (size_t)(F.gw - NLAT) * DM;
#pragma unroll
        for (int j = 0; j < 8; ++j) xv[j] = *(const f32x4*)(xr + j * 256 + F.lane * 4); }
    for (int row = F.gw; row < RT; row += F.NGW) {
        { const int rn = row + F.NGW; if (rn < RT) { const float* xr = rn < NLAT ? p_x + (size_t)rn * DM : p_ctx + (size_t)(rn - NLAT) * DM;
#pragma unroll
            for (int j = 0; j < 8; ++j) xn[j] = *(const f32x4*)(xr + j * 256 + F.lane * 4); } }
        const int v = row < NLAT ? (row >> 12) : 4;
        const float* sh = ADA + (size_t)v * ADAW; const float* sc = sh + 2048;
#pragma unroll
        for (int j = 0; j < 8; ++j) { const int col = j * 256 + F.lane * 4;
            const f32x4 x = xv[j], s1 = *(const f32x4*)(sc + col), s0 = *(const f32x4*)(sh + col);
            const f32x4 y = x * (s1 + 1.f) + s0;
            v2u o; o.x = pk2(y[0], y[1]); o.y = pk2(y[2], y[3]);
            *(v2u*)(AY + (size_t)row * DM + col) = o;
            if (row >= NLAT) *(f32x4*)(WSP(float, WS_X) + (size_t)row * DM + col) = x * ALPHA_RES; }
#pragma unroll
        for (int j = 0; j < 8; ++j) xv[j] = xn[j];
    }
}

__device__ __forceinline__ void phase_ln(const Fr& F, int l, int which, int nrows) {
    const float* ADA = WSP(float, WS_ADA); bf16* AY = WSP(bf16, WS_AY); float* X = WSP(float, WS_X);
    const float* lw = (which == 1 ? inp(F, 20) : inp(F, 24)) + (size_t)l * DM; const float* lb = (which == 1 ? inp(F, 21) : inp(F, 25)) + (size_t)l * DM;
    const bool last = (which == 2 && l == 1);
    const size_t aoff = which == 1 ? ((size_t)l * 5 * ADAW + 3 * 2048) : ((size_t)(l + 1) * 5 * ADAW);
    f32x4 v[8], vn[8];
    if (F.gw < nrows) {
#pragma unroll
        for (int j = 0; j < 8; ++j) v[j] = *(const f32x4*)(X + (size_t)F.gw * DM + j * 256 + F.lane * 4); }
    for (int row = F.gw; row < nrows; row += F.NGW) {
        float* xr = X + (size_t)row * DM;
        if (row + F.NGW < nrows) {
#pragma unroll
            for (int j = 0; j < 8; ++j) vn[j] = *(const f32x4*)(xr + (size_t)F.NGW * DM + j * 256 + F.lane * 4); }
        float s = 0.f;
#pragma unroll
        for (int j = 0; j < 8; ++j) {
            if (which == 2 && l == 0 && row >= NLAT) v[j] = v[j] + *(const f32x4*)(WSP(float, WS_PART) + (size_t)(row - NLAT) * DM + j * 256 + F.lane * 4);
            s += (v[j][0] + v[j][1]) + (v[j][2] + v[j][3]); }
        const float mean = wave_sum(s) * (1.f / DM); float s2 = 0.f;
#pragma unroll
        for (int j = 0; j < 8; ++j) { v[j] = v[j] - mean; s2 += (v[j][0] * v[j][0] + v[j][1] * v[j][1]) + (v[j][2] * v[j][2] + v[j][3] * v[j][3]); }
        const float rstd = 1.f / sqrtf(wave_sum(s2) * (1.f / DM) + 1e-5f);
        const int vi = row < NLAT ? (row >> 12) : 4;
        const float* sh = ADA + aoff + (size_t)vi * ADAW; const float* sc = sh + 2048;
#pragma unroll
        for (int j = 0; j < 8; ++j) { const int col = j * 256 + F.lane * 4;
            const f32x4 y = v[j] * rstd * *(const f32x4*)(lw + col) + *(const f32x4*)(lb + col);
            if (last) { *(f32x4*)(F.out + (size_t)row * DM + col) = y; }
            else { *(f32x4*)(xr + col) = (which == 1) ? y * ALPHA_RES : y;
                const f32x4 a = y * (*(const f32x4*)(sc + col) + 1.f) + *(const f32x4*)(sh + col);
                v2u o; o.x = pk2(a[0], a[1]); o.y = pk2(a[2], a[3]);
                *(v2u*)(AY + (size_t)row * DM + col) = o; }
        }
#pragma unroll
        for (int j = 0; j < 8; ++j) v[j] = vn[j];
    }
}

__device__ __forceinline__ void phase_prep(const Fr& F, int l) {
    const bf16* Z = WSP(bf16, WS_ZH); bf16* GQKV = WSP(bf16, WS_GQKV); float* GB = WSP(float, WS_GB);
    bf16* QN = WSP(bf16, WS_QN); bf16* CKVN = WSP(bf16, WS_CKVN); bf16* KROPE = WSP(bf16, WS_KROPE);
    const float* cw = inp(F, 7) + (size_t)l * 5 * 1536;
    const float* p_alog = inp(F, 8); const float* p_dtb = inp(F, 9); const float* p_qnw = inp(F, 12); const float* p_kvnw = inp(F, 13);
    for (int row = F.gw; row < RT; row += F.NGW) {
        const bf16* zr = Z + (size_t)row * ZP;
#pragma unroll
      for (int g = 0; g < 4; ++g) {
        if (g < 3) {
            int t, len; if (row < NLAT) { t = row & 4095; len = SEQ; } else { t = (row - NLAT) & 255; len = CTX; }
            const int c0 = g * 512 + F.lane * 8;
            float acc[8];
#pragma unroll
            for (int j = 0; j < 8; ++j) acc[j] = 0.f;
#pragma unroll
            for (int i = 0; i < 5; ++i) { const int tt = t + i - 2; const bool okt = (tt >= 0 && tt < len);
                {
                    v4u zv = *(const v4u*)(zr + (okt ? (ptrdiff_t)(i - 2) * ZP : (ptrdiff_t)0) + c0); if (!okt) zv = (v4u){0u, 0u, 0u, 0u};
                    const f32x4 w0 = *(const f32x4*)(cw + i * 1536 + c0), w1 = *(const f32x4*)(cw + i * 1536 + c0 + 4);
                    acc[0] += bflo(zv.x) * w0[0]; acc[1] += bfhi(zv.x) * w0[1]; acc[2] += bflo(zv.y) * w0[2]; acc[3] += bfhi(zv.y) * w0[3];
                    acc[4] += bflo(zv.z) * w1[0]; acc[5] += bfhi(zv.z) * w1[1]; acc[6] += bflo(zv.w) * w1[2]; acc[7] += bfhi(zv.w) * w1[3]; } }
            float ss = 0.f;
#pragma unroll
            for (int j = 0; j < 8; ++j) { acc[j] = siluf_(acc[j]); ss += acc[j] * acc[j]; }
            if (g < 2) {
                ss += __shfl_xor(ss, 1); ss += __shfl_xor(ss, 2); ss += __shfl_xor(ss, 4); ss += __shfl_xor(ss, 8);
                float inv = 1.f / sqrtf(ss + 1e-6f); if (g == 0) inv *= 0.08838834764831845f;
#pragma unroll
                for (int j = 0; j < 8; ++j) acc[j] *= inv;
            }
            v4u o; o.x = pk2(acc[0], acc[1]); o.y = pk2(acc[2], acc[3]); o.z = pk2(acc[4], acc[5]); o.w = pk2(acc[6], acc[7]);
            *(v4u*)(GQKV + (size_t)row * 1536 + c0) = o;
            if (g == 0 && F.lane < 16) {
                float r;
                if (F.lane < 8) { const float a = bf2f(zr[2048 + F.lane]); const float x = a + p_dtb[l * 8 + F.lane];
                    const float ee = __expf(-fabsf(x)); const float l1p = (ee < 0.03f) ? ee * (1.f - ee * (0.5f - ee * 0.33333333f)) : __logf(1.f + ee); const float sp = fmaxf(x, 0.f) + l1p;     r = -__expf(p_alog[l * 8 + F.lane]) * sp; }
                else r = sigmoidf_(bf2f(zr[2056 + F.lane - 8]));
                GB[(size_t)row * 16 + F.lane] = r;
            }
        } else {
            {
                const unsigned* p = (const unsigned*)(zr + C_MLA + F.lane * 6); const unsigned w0 = p[0], w1 = p[1], w2 = p[2];
                float x[6] = {bflo(w0), bfhi(w0), bflo(w1), bfhi(w1), bflo(w2), bfhi(w2)};
                float ss = 0.f;
#pragma unroll
                for (int j = 0; j < 6; ++j) ss += x[j] * x[j];
                const float inv = 1.f / sqrtf(wave_sum(ss) * (1.f / 384.f) + 1e-6f);
                const float* nw = p_qnw + l * 384 + F.lane * 6;
                unsigned* q = (unsigned*)(QN + (size_t)row * 384 + F.lane * 6);
                q[0] = pk2(x[0] * inv * nw[0], x[1] * inv * nw[1]); q[1] = pk2(x[2] * inv * nw[2], x[3] * inv * nw[3]); q[2] = pk2(x[4] * inv * nw[4], x[5] * inv * nw[5]);
            }
            {
                const v2u w = *(const v2u*)(zr + C_MLA + 384 + F.lane * 4);
                float x[4] = {bflo(w.x), bfhi(w.x), bflo(w.y), bfhi(w.y)};
                const float ss = x[0] * x[0] + x[1] * x[1] + x[2] * x[2] + x[3] * x[3];
                const float inv = 1.f / sqrtf(wave_sum(ss) * (1.f / 256.f) + 1e-6f);
                const float* nw = p_kvnw + l * 256 + F.lane * 4;
                v2u o; o.x = pk2(x[0] * inv * nw[0], x[1] * inv * nw[1]); o.y = pk2(x[2] * inv * nw[2], x[3] * inv * nw[3]);
                *(v2u*)(CKVN + (size_t)row * 256 + F.lane * 4) = o;
            }
            {
                const float x = bf2f(zr[C_MLA + 640 + F.lane]);
                const float pr = __shfl_xor(x, 1);
                float o = x;
                if (row < NLAT) { const int t = row & 4095, i = F.lane >> 1; const f32x2 rc = WSP(const f32x2, WS_ROPE)[t * 32 + i]; const float cs = rc[0], sn = rc[1];
                    o = (F.lane & 1) ? (pr * sn + x * cs) : (x * cs - pr * sn); }
                KROPE[(size_t)row * 64 + F.lane] = (bf16)f2bf(o);
            }
        }
      }
    }
    { bf16* NAVT = WSP(bf16, WS_NAVT);
      for (int tile = F.gw; tile < (RT / 64) * 8; tile += F.NGW) {
        const int r0 = (tile >> 3) * 64, c0 = (tile & 7) * 64;
        const bf16* zr = Z + (size_t)(r0 + F.lane) * ZP + C_NA + 1024 + c0;
        v4u v[8];
#pragma unroll
        for (int j = 0; j < 8; ++j) v[j] = *(const v4u*)(zr + 8 * j);
        bf16* dst = NAVT + (size_t)c0 * RT + r0 + F.lane;
#pragma unroll
        for (int j = 0; j < 8; ++j) {
            dst[(size_t)(8 * j + 0) * RT] = (bf16)(v[j].x & 0xffffu); dst[(size_t)(8 * j + 1) * RT] = (bf16)(v[j].x >> 16);
            dst[(size_t)(8 * j + 2) * RT] = (bf16)(v[j].y & 0xffffu); dst[(size_t)(8 * j + 3) * RT] = (bf16)(v[j].y >> 16);
            dst[(size_t)(8 * j + 4) * RT] = (bf16)(v[j].z & 0xffffu); dst[(size_t)(8 * j + 5) * RT] = (bf16)(v[j].z >> 16);
            dst[(size_t)(8 * j + 6) * RT] = (bf16)(v[j].w & 0xffffu); dst[(size_t)(8 * j + 7) * RT] = (bf16)(v[j].w >> 16); }
      } }
}

__device__ __forceinline__ void phase_post(const Fr& F, int l, int nrows) {
    const bf16* Z = WSP(bf16, WS_ZH); bf16* Y = WSP(bf16, WS_AY);
    const bf16* OG = (const bf16*)((const unsigned char*)F.out + OUT_OG); const bf16* OH = (const bf16*)((const unsigned char*)F.out + OUT_OH);
    const float* p_gnw = inp(F, 10) + l * 128; const float* p_hnw = inp(F, 18) + l * 128;
    if (F.G - 64 == 192) {
        const bf16* PO = WSP(bf16, WS_PO); const float* PML = WSP(float, WS_PML);
        for (int it = F.gw; it < 64 * 256; it += F.NGW) { const int su = it >> 8, r = it & 255, u = 192 + su, hh = (u >> 4) & 3, qb = u & 15;
            float m[3], lv[3];
#pragma unroll
            for (int p = 0; p < 3; ++p) { m[p] = PML[((size_t)(su * 3 + p) * 256 + r) * 2]; lv[p] = PML[((size_t)(su * 3 + p) * 256 + r) * 2 + 1]; }
            const float M = fmaxf(m[0], fmaxf(m[1], m[2]));
            float L = 0.f, o0 = 0.f, o1 = 0.f;
#pragma unroll
            for (int p = 0; p < 3; ++p) { const float wp = __builtin_amdgcn_exp2f(m[p] - M); L += wp * lv[p];
                const unsigned pv = *(const unsigned*)(PO + ((size_t)(su * 3 + p) * 256 + r) * 128 + F.lane * 2); o0 += wp * bflo(pv); o1 += wp * bfhi(pv); }
            const float inv = 1.f / L;
            *(unsigned*)(Y + (size_t)(3 * SEQ + qb * 256 + r) * DM + 1024 + hh * 128 + F.lane * 2) = pk2(o0 * inv, o1 * inv); }
    }
    for (int row = F.gw; row < nrows; row += F.NGW) {
#pragma unroll
      for (int which = 0; which < 2; ++which) {
        const bf16* O = which ? OH : OG;
        const v4u a = *(const v4u*)(O + (size_t)row * 512 + F.lane * 8), b = *(const v4u*)(O + (size_t)(RT + row) * 512 + F.lane * 8);
        const v4u gz = *(const v4u*)(Z + (size_t)row * ZP + (which ? (C_HG + 4 * 512) : 1536) + F.lane * 8);
        float o[8] = {bflo(a.x) + bflo(b.x), bfhi(a.x) + bfhi(b.x), bflo(a.y) + bflo(b.y), bfhi(a.y) + bfhi(b.y), bflo(a.z) + bflo(b.z), bfhi(a.z) + bfhi(b.z), bflo(a.w) + bflo(b.w), bfhi(a.w) + bfhi(b.w)};
        const float gt[8] = {bflo(gz.x), bfhi(gz.x), bflo(gz.y), bfhi(gz.y), bflo(gz.z), bfhi(gz.z), bflo(gz.w), bfhi(gz.w)};
        float ss = 0.f;
#pragma unroll
        for (int j = 0; j < 8; ++j) ss += o[j] * o[j];
        ss += __shfl_xor(ss, 1); ss += __shfl_xor(ss, 2); ss += __shfl_xor(ss, 4); ss += __shfl_xor(ss, 8);
        const float inv = 1.f / sqrtf(ss * (1.f / 128.f) + 1e-6f);
        const float* nw = (which ? p_hnw : p_gnw) + (F.lane & 15) * 8;
#pragma unroll
        for (int j = 0; j < 8; ++j) o[j] = o[j] * inv * nw[j] * siluf_(gt[j]);
        v4u w; w.x = pk2(o[0], o[1]); w.y = pk2(o[2], o[3]); w.z = pk2(o[4], o[5]); w.w = pk2(o[6], o[7]);
        *(v4u*)(Y + (size_t)row * DM + (which ? 1536 : 0) + F.lane * 8) = w;
      }
    }
}

constexpr int SC_PR = 0, SC_VS = 64 * 288 * 4, SC_SC = SC_VS + 64 * 64 * 4, SC_OB = SC_SC + 64 * 16, SC_END = SC_OB + 64 * 64 * 4;
static_assert(SC_END <= 131072, "scan LDS");
template <int CTRL> __device__ __forceinline__ float dppf(float v) { return __builtin_bit_cast(float, __builtin_amdgcn_update_dpp(0, __builtin_bit_cast(int, v), CTRL, 0xF, 0xF, true)); }
__device__ __forceinline__ float reduce8(float v) { v += dppf<0xB1>(v); v += dppf<0x4E>(v); v += dppf<0x141>(v); return v; }

template <bool GDN>
__device__ __forceinline__ void scan_item(const Fr& F, int l, int item) {
    const int chain = item >> 1, ch = item & 1, b = chain >> 3, h = (chain >> 1) & 3, dir = chain & 1;
    const int tid = F.tid, slice = tid & 7, cl = tid >> 3;
    float* PR = (float*)(F.lds + SC_PR); float* VS = (float*)(F.lds + SC_VS); f32x4* SC = (f32x4*)(F.lds + SC_SC); float* OB = (float*)(F.lds + SC_OB);
    const bf16* Z = WSP(bf16, WS_ZH); const bf16* GQKV = WSP(bf16, WS_GQKV); const float* GB = WSP(float, WS_GB);
    bf16* O = (bf16*)((unsigned char*)F.out + (GDN ? OUT_OG : OUT_OH)) + (size_t)dir * RT * 512 + h * 128 + ch * 64;
    const bf16* srcA; const bf16* srcB; const bf16* srcV; int pitch;
    if (GDN) { pitch = 1536; srcA = GQKV + 512 + h * 128; srcB = GQKV + h * 128; srcV = GQKV + 1024 + h * 128 + ch * 64; }
    else { pitch = ZP; srcA = Z + C_HG + 512 * (1 + dir) + h * 128; srcB = Z + C_HG + h * 128; srcV = Z + C_HG + 3 * 512 + h * 128 + ch * 64; }
    float lbv[2][8];
    if (!GDN) { const float* p_lb = inp(F, 17);
#pragma unroll
        for (int i = 0; i < 2; ++i) { const int d0 = ((tid + 512 * i) & 15) * 8;
#pragma unroll
            for (int j = 0; j < 8; ++j) lbv[i][j] = (l == 0) ? 0.f : sigmoidf_(p_lb[512 + h * 128 + d0 + j] - p_lb[h * 128 + d0 + j]); }
    }
    float S[16];
#pragma unroll
    for (int j = 0; j < 16; ++j) S[j] = 0.f;
    v4u ra[2], rb[2], rv; float rg = 0.f, rbeta = 0.f;
    constexpr int NCH = (CTX + SEQ) / 64;
    int base = 0, sgn = 1;
#define SCAN_ROWS(c) do { const int gs = (c) * 64; if (gs < CTX) { base = NLAT + b * CTX + (dir ? (CTX - 1 - gs) : gs); } else { const int t = gs - CTX; base = b * SEQ + (dir ? (SEQ - 1 - t) : t); } sgn = dir ? -1 : 1; } while (0)
#define SCAN_LOAD() do { _Pragma("unroll") for (int i = 0; i < 2; ++i) { const int p = tid + 512 * i, s = p >> 4, d0 = (p & 15) * 8; const size_t ro = (size_t)(base + sgn * s) * pitch + d0; \
        ra[i] = *(const v4u*)(srcA + ro); rb[i] = *(const v4u*)(srcB + ro); } \
        { const int s = tid >> 3, c0 = (tid & 7) * 8; rv = *(const v4u*)(srcV + (size_t)(base + sgn * s) * pitch + c0); } \
        if (GDN && tid < 64) { const size_t ro = (size_t)(base + sgn * tid) * 16 + dir * 4 + h; rg = GB[ro]; rbeta = GB[ro + 8]; } } while (0)
#define SCAN_STORE() do { _Pragma("unroll") for (int i = 0; i < 2; ++i) { const int p = tid + 512 * i, s = p >> 4, d0 = (p & 15) * 8; \
        float av[8] = {bflo(ra[i].x), bfhi(ra[i].x), bflo(ra[i].y), bfhi(ra[i].y), bflo(ra[i].z), bfhi(ra[i].z), bflo(ra[i].w), bfhi(ra[i].w)}; \
        float bv[8] = {bflo(rb[i].x), bfhi(rb[i].x), bflo(rb[i].y), bfhi(rb[i].y), bflo(rb[i].z), bfhi(rb[i].z), bflo(rb[i].w), bfhi(rb[i].w)}; \
        if (!GDN) { _Pragma("unroll") for (int j = 0; j < 8; ++j) { av[j] = lbv[i][j] + (1.f - lbv[i][j]) * sigmoidf_(av[j]); bv[j] = siluf_(bv[j]) * 0.08838834764831845f; } } \
        float* dst = PR + s * 288 + (d0 >> 4) * 36 + (d0 & 15) * 2; \
        _Pragma("unroll") for (int j = 0; j < 4; ++j) *(f32x4*)(dst + 4 * j) = (f32x4){av[2 * j], bv[2 * j], av[2 * j + 1], bv[2 * j + 1]}; } \
        { const int s = tid >> 3, c0 = (tid & 7) * 8; float* dv = VS + s * 64 + c0; \
          *(f32x4*)dv = (f32x4){bflo(rv.x), bfhi(rv.x), bflo(rv.y), bfhi(rv.y)}; *(f32x4*)(dv + 4) = (f32x4){bflo(rv.z), bfhi(rv.z), bflo(rv.w), bfhi(rv.w)}; } \
        if (GDN && tid < 64) { float* sc = (float*)(SC + tid); sc[0] = __expf(rg); sc[1] = rbeta; } } while (0)
#define SCAN_QK() do { if (GDN) { _Pragma("unroll") for (int e = 0; e < 8; ++e) { const int s = F.wave * 8 + e; const f32x4 kq = *(const f32x4*)(PR + s * 288 + (F.lane >> 3) * 36 + (F.lane & 7) * 4); \
        const float d = wave_sum(kq[0] * kq[1] + kq[2] * kq[3]); if (F.lane == 0) ((float*)(SC + s))[2] = d; } } } while (0)

    SCAN_ROWS(0); SCAN_LOAD(); SCAN_STORE(); __syncthreads(); SCAN_QK(); __syncthreads();
    const float* prs = PR + slice * 36;
    for (int c = 0; c < NCH; ++c) {
        const int obase = base, osgn = sgn;
        if (c + 1 < NCH) { SCAN_ROWS(c + 1); SCAN_LOAD(); }
        f32x4 cur[8];
#pragma unroll
        for (int i = 0; i < 8; ++i) cur[i] = *(const f32x4*)(prs + i * 4);
        f32x4 scv = SC[0]; float vv = VS[cl];
#pragma unroll 2
        for (int s = 0; s < 64; ++s) {
            f32x4 nxt[8]; f32x4 nsc; float nvv;
            const int sn = (s + 1) & 63;
#pragma unroll
            for (int i = 0; i < 8; ++i) nxt[i] = *(const f32x4*)(prs + sn * 288 + i * 4);
            nsc = SC[sn]; nvv = VS[sn * 64 + cl];
            float o;
            if (GDN) {
                float pk = 0.f, pq = 0.f;
#pragma unroll
                for (int i = 0; i < 8; ++i) { pk += cur[i][0] * S[2 * i]; pq += cur[i][1] * S[2 * i]; pk += cur[i][2] * S[2 * i + 1]; pq += cur[i][3] * S[2 * i + 1]; }
                pk = reduce8(pk); pq = reduce8(pq);
                const float a = scv[0], u = scv[1] * (vv - a * pk);
                o = a * pq + scv[2] * u;
#pragma unroll
                for (int i = 0; i < 8; ++i) { S[2 * i] = a * S[2 * i] + cur[i][0] * u; S[2 * i + 1] = a * S[2 * i + 1] + cur[i][2] * u; }
            } else {
                float po = 0.f;
#pragma unroll
                for (int i = 0; i < 8; ++i) { const float f0 = cur[i][0], f1 = cur[i][2];
                    S[2 * i] = f0 * S[2 * i] + (1.f - f0) * vv; S[2 * i + 1] = f1 * S[2 * i + 1] + (1.f - f1) * vv;
                    po += cur[i][1] * S[2 * i]; po += cur[i][3] * S[2 * i + 1]; }
                o = reduce8(po);
            }
            if (slice == 0) OB[s * 64 + cl] = o;
#pragma unroll
            for (int i = 0; i < 8; ++i) cur[i] = nxt[i];
            scv = nsc; vv = nvv;
        }
        __syncthreads();
        {
            const int s = tid >> 3, c0 = (tid & 7) * 8; const float* ob = OB + s * 64 + c0;
            const f32x4 x0 = *(const f32x4*)ob, x1 = *(const f32x4*)(ob + 4);
            v4u w; w.x = pk2(x0[0], x0[1]); w.y = pk2(x0[2], x0[3]); w.z = pk2(x1[0], x1[1]); w.w = pk2(x1[2], x1[3]);
            *(v4u*)(O + (size_t)(obase + osgn * s) * 512 + c0) = w;
        }
        if (c + 1 < NCH) SCAN_STORE();
        __syncthreads();
        if (c + 1 < NCH) SCAN_QK();
        __syncthreads();
    }
#undef SCAN_ROWS
#undef SCAN_LOAD
#undef SCAN_STORE
#undef SCAN_QK
}

__device__ __forceinline__ unsigned cvtpk(float lo, float hi) { unsigned r; asm volatile("v_cvt_pk_bf16_f32 %0, %1, %2" : "=v"(r) : "v"(lo), "v"(hi)); return r; }
template <int DQK, bool NA>
__device__ __forceinline__ void attn_unit(const Fr& F, const bf16* Qh, int qpitch, int qrow0, bool qrope,
                                          const bf16* K1h, int k1pitch, const bf16* Vth,
                                          int kbase0, int n0, int kbase1, int ntiles, bf16* Yh, float sl2, int lo, int qgr, const float* rpbh, int pidx) {
    const bf16* K2 = WSP(bf16, WS_KROPE);
    constexpr int NDC = DQK / 32, KPB = (DQK + 16) * 2, KBUF = 64 * KPB, VPB = 160, VBUF = 128 * VPB,     BUF = KBUF + VBUF, PPR = DQK / 8, NKP = 64 * PPR / 512;
    static_assert(2 * BUF + 2048 <= 131072, "attn LDS");
    unsigned char* lds = F.lds;
    float* bt = (float*)(lds + 2 * BUF);
    const int tid = F.tid, lane = F.lane, w = F.wave, r16 = lane & 15, quad = lane >> 4;
    if (NA) { for (int i = tid; i < 15 * 32; i += 512) { const int dr = i >> 5, dc = i & 31; bt[i] = (rpbh != nullptr && dc < 31) ? rpbh[dr * 31 + dc] * LOG2E : 0.f; } }
    bf16x8 qf[2][NDC];
#pragma unroll
    for (int n = 0; n < 2; ++n) { const int row = qrow0 + w * 32 + n * 16 + r16;
#pragma unroll
        for (int dc = 0; dc < NDC; ++dc) qf[n][dc] = *(const bf16x8*)(Qh + (size_t)row * qpitch + dc * 32 + quad * 8);
        if (!NA && qrope) { const int t = row & 4095;
#pragma unroll
            for (int dc = 4; dc < NDC; ++dc) {
#pragma unroll
                for (int jj = 0; jj < 4; ++jj) { const f32x2 rc = WSP(const f32x2, WS_ROPE)[t * 32 + (dc - 4) * 16 + quad * 4 + jj]; const float cs = rc[0], sn = rc[1];
                    const float x1 = bf2f((unsigned short)qf[n][dc][2 * jj]), x2 = bf2f((unsigned short)qf[n][dc][2 * jj + 1]);
                    qf[n][dc][2 * jj] = (short)f2bf(x1 * cs - x2 * sn); qf[n][dc][2 * jj + 1] = (short)f2bf(x1 * sn + x2 * cs); } } }
    }
    f32x4 o[8][2];
#pragma unroll
    for (int dt = 0; dt < 8; ++dt) { o[dt][0] = (f32x4){0.f, 0.f, 0.f, 0.f}; o[dt][1] = (f32x4){0.f, 0.f, 0.f, 0.f}; }
    float mrun[2] = {-1e30f, -1e30f}, lsum[2] = {0.f, 0.f};
    v4u kreg[NKP], vreg[2];
    const int gr = qgr + (w >> 1);
    const int w0 = min(max(gr - 4, 0), 56);
#define AT_KROW(i) ((i) < n0 ? kbase0 + 64 * (i) : kbase1 + 64 * ((i) - n0))
#define AT_LOADK(i) do { const int kr0 = AT_KROW(i); _Pragma("unroll") for (int x = 0; x < NKP; ++x) { const int p = tid + 512 * x, key = p / PPR, pc = p % PPR; \
        const bf16* src = (pc < 16) ? K1h + (size_t)(kr0 + key) * k1pitch + pc * 8 : K2 + (size_t)(kr0 + key) * 64 + (pc - 16) * 8; kreg[x] = *(const v4u*)src; } } while (0)
#define AT_LOADV(i) do { const int kr0 = AT_KROW(i); _Pragma("unroll") for (int x = 0; x < 2; ++x) { const int p = tid + 512 * x, d = p >> 3, pc = p & 7; vreg[x] = *(const v4u*)(Vth + (size_t)d * RT + kr0 + pc * 8); } } while (0)
#define AT_STOREK(buf) do { _Pragma("unroll") for (int x = 0; x < NKP; ++x) { const int p = tid + 512 * x, key = p / PPR, pc = p % PPR; \
        const int slot = (key & 32) + ((key >> 2) & 1) * 16 + ((key & 31) >> 3) * 4 + (key & 3); *(v4u*)(lds + (buf) * BUF + slot * KPB + pc * 16) = kreg[x]; } } while (0)
#define AT_STOREV(buf) do { _Pragma("unroll") for (int x = 0; x < 2; ++x) { const int p = tid + 512 * x, d = p >> 3, pc = p & 7; *(v4u*)(lds + (buf) * BUF + KBUF + d * VPB + pc * 16) = vreg[x]; } } while (0)
    AT_LOADK(0); AT_LOADV(0); AT_STOREK(0); AT_STOREV(0); __syncthreads();
    for (int i = 0; i < ntiles; ++i) {
        int tid = F.tid; asm volatile("" : "+v"(tid));
        if (i + 1 < ntiles) AT_LOADK(i + 1);
        const bool win = NA && (i < n0);
        const int kr = lo + i;
        const bool active = !win || (kr >= w0 && kr < w0 + 8);
        const unsigned char* kb = lds + (i & 1) * BUF; const unsigned char* vb = kb + KBUF;
#pragma unroll
        for (int sub = 0; sub < 2; ++sub) {
            if (sub == 1 && i + 1 < ntiles) { AT_STOREK((i + 1) & 1); AT_LOADV(i + 1); }
            if (active) {
                f32x4 s[2][2];
                __builtin_amdgcn_s_setprio(1);
#pragma unroll
                for (int t = 0; t < 2; ++t) { s[t][0] = (f32x4){0.f, 0.f, 0.f, 0.f}; s[t][1] = (f32x4){0.f, 0.f, 0.f, 0.f};
                    if (!NA && t == 1) asm volatile("" ::: "memory");
#pragma unroll
                    for (int dc = 0; dc < NDC; ++dc) { const bf16x8 a = *(const bf16x8*)(kb + (sub * 32 + t * 16 + r16) * KPB + dc * 64 + quad * 16);
                        s[t][0] = __builtin_amdgcn_mfma_f32_16x16x32_bf16(a, qf[0][dc], s[t][0], 0, 0, 0);
                        s[t][1] = __builtin_amdgcn_mfma_f32_16x16x32_bf16(a, qf[1][dc], s[t][1], 0, 0, 0); } }
                __builtin_amdgcn_s_setprio(0);
                bf16x8 pb[2];
#pragma unroll
                for (int n = 0; n < 2; ++n) {
                    float mx = -1e30f;
                    const int qc = (w & 1) * 32 + n * 16 + r16; const int c0 = min(max(qc - 8, 0), 48);
#pragma unroll
                    for (int t = 0; t < 2; ++t)
#pragma unroll
                        for (int j = 0; j < 4; ++j) { float x = s[t][n][j] * sl2;
                            if (win) { const int kc = sub * 32 + quad * 8 + t * 4 + j; const bool ok = (kc >= c0) && (kc < c0 + 16);
                                const int dcc = min(max(kc - qc + 15, 0), 30); const float bb = bt[(kr - gr + 7) * 32 + dcc]; x = ok ? x + bb : -1e30f; }
                            s[t][n][j] = x; mx = fmaxf(mx, x); }
                    mx = fmaxf(mx, __shfl_xor(mx, 16)); mx = fmaxf(mx, __shfl_xor(mx, 32));
                    const float mnew = fmaxf(mrun[n], mx), alpha = __builtin_amdgcn_exp2f(mrun[n] - mnew); mrun[n] = mnew;
                    float ps = 0.f;
#pragma unroll
                    for (int t = 0; t < 2; ++t)
#pragma unroll
                        for (int j = 0; j < 4; ++j) { const float p = __builtin_amdgcn_exp2f(s[t][n][j] - mnew); s[t][n][j] = p; ps += p; }
                    lsum[n] = lsum[n] * alpha + ps;
#pragma unroll
                    for (int dt = 0; dt < 8; ++dt) o[dt][n] = o[dt][n] * alpha;
                    v4u u; u.x = cvtpk(s[0][n][0], s[0][n][1]); u.y = cvtpk(s[0][n][2], s[0][n][3]); u.z = cvtpk(s[1][n][0], s[1][n][1]); u.w = cvtpk(s[1][n][2], s[1][n][3]);
                    pb[n] = __builtin_bit_cast(bf16x8, u);
                }
                __builtin_amdgcn_s_setprio(1);
#pragma unroll
                for (int dt = 0; dt < 8; ++dt) { const bf16x8 a = *(const bf16x8*)(vb + (dt * 16 + r16) * VPB + sub * 64 + quad * 16);
                    o[dt][0] = __builtin_amdgcn_mfma_f32_16x16x32_bf16(a, pb[0], o[dt][0], 0, 0, 0);
                    o[dt][1] = __builtin_amdgcn_mfma_f32_16x16x32_bf16(a, pb[1], o[dt][1], 0, 0, 0); }
                __builtin_amdgcn_s_setprio(0);
            }
        }
        if (i + 1 < ntiles) AT_STOREV((i + 1) & 1);
        __syncthreads();
    }
#pragma unroll
    for (int n = 0; n < 2; ++n) { float lt = lsum[n]; lt += __shfl_xor(lt, 16); lt += __shfl_xor(lt, 32);
        const bool part = (pidx >= 0); const float inv = part ? 1.f : 1.f / lt;
        bf16* PO = WSP(bf16, WS_PO) + (size_t)pidx * 256 * 128; float* PML = WSP(float, WS_PML) + (size_t)pidx * 512;
        const int rl = w * 32 + n * 16 + r16, row = qrow0 + rl;
        bf16* dst = part ? PO + (size_t)rl * 128 + quad * 4 : Yh + (size_t)row * DM + quad * 4;
#pragma unroll
        for (int dt = 0; dt < 8; ++dt) { const f32x4 v = o[dt][n] * inv; v2u u; u.x = cvtpk(v[0], v[1]); u.y = cvtpk(v[2], v[3]); *(v2u*)(dst + dt * 16) = u; }
        if (part && quad == 0) { PML[rl * 2] = mrun[n]; PML[rl * 2 + 1] = lt; } }
#undef AT_KROW
#undef AT_LOADK
#undef AT_LOADV
#undef AT_STOREK
#undef AT_STOREV
}


typedef short s16x4 __attribute__((ext_vector_type(4)));
typedef short v4i16_t __attribute__((ext_vector_type(4)));
__device__ __forceinline__ s16x4 ldtr(const unsigned char* p) { return __builtin_bit_cast(s16x4, __builtin_amdgcn_ds_read_tr16_b64_v4i16((LAS v4i16_t*)p)); }
__device__ __forceinline__ bf16x8 cat8(s16x4 a, s16x4 b) { return __builtin_shufflevector(a, b, 0, 1, 2, 3, 4, 5, 6, 7); }
__device__ __forceinline__ bf16x8 pack8(f32x4 a, f32x4 b) { v4u u; u.x = cvtpk(a[0], a[1]); u.y = cvtpk(a[2], a[3]); u.z = cvtpk(b[0], b[1]); u.w = cvtpk(b[2], b[3]); return __builtin_bit_cast(bf16x8, u); }
constexpr int NCHK = (CTX + SEQ) / 64;
__device__ __forceinline__ int chunk_row_lo(int b, int dir, int c) {
    const int gs = c * 64;
    if (gs < CTX) return NLAT + b * CTX + (dir ? (CTX - 64 - gs) : gs);
    const int t = gs - CTX; return b * SEQ + (dir ? (SEQ - 64 - t) : t);
}

__device__ __forceinline__ void hg_lb(const Fr& F, int l, int h, float (&lbv)[8]) {
    const float* p_lb = inp(F, 17); const int d0 = (F.tid & 15) * 8;
#pragma unroll
    for (int j = 0; j < 8; ++j) lbv[j] = (l == 0) ? 0.f : sigmoidf_(p_lb[512 + h * 128 + d0 + j] - p_lb[h * 128 + d0 + j]);
}
__device__ __forceinline__ void hg_load_qf(const Fr& F, int cid, v4u (&ra)[2], v4u (&rb)[2]) {
    const int chain = cid / NCHK, c = cid % NCHK, b = chain >> 3, h = (chain >> 1) & 3, dir = chain & 1; const int row_lo = chunk_row_lo(b, dir, c);
    const bf16* Z = WSP(bf16, WS_ZH);
#pragma unroll
    for (int i = 0; i < 2; ++i) { const int p = F.tid + 512 * i, m = p >> 4, d0 = (p & 15) * 8;
        const bf16* zr = Z + (size_t)(row_lo + m) * ZP + C_HG + h * 128 + d0; ra[i] = *(const v4u*)(zr + 512 * (1 + dir)); rb[i] = *(const v4u*)zr; }
}
__device__ __forceinline__ void hg_compute_qf(const float (&lbv)[8], const v4u (&ra)[2], const v4u (&rb)[2], float (&qv)[2][8], float (&fv)[2][8]) {
#pragma unroll
    for (int i = 0; i < 2; ++i) { const v4u a = ra[i], b = rb[i];
        const float av[8] = {bflo(a.x), bfhi(a.x), bflo(a.y), bfhi(a.y), bflo(a.z), bfhi(a.z), bflo(a.w), bfhi(a.w)};
        const float bv[8] = {bflo(b.x), bfhi(b.x), bflo(b.y), bfhi(b.y), bflo(b.z), bfhi(b.z), bflo(b.w), bfhi(b.w)};
#pragma unroll
        for (int j = 0; j < 8; ++j) { const float lb = lbv[j]; fv[i][j] = lb + (1.f - lb) * sigmoidf_(av[j]); qv[i][j] = siluf_(bv[j]) * 0.08838834764831845f; } }
}
template <int LP> __device__ __forceinline__ void time_cumsum(const Fr& F, float* Lm, float* SEG, int dir) {
    const int d = F.tid & 127, seg = F.tid >> 7;
    float s = 0.f;
#pragma unroll
    for (int i = 0; i < 16; ++i) { const int t = seg * 16 + i, m = dir ? 63 - t : t; s += Lm[m * LP + d]; Lm[m * LP + d] = s; }
    SEG[seg * 128 + d] = s;
    LDS_BARRIER();
    float off = 0.f;
#pragma unroll
    for (int j = 0; j < 3; ++j) if (j < seg) off += SEG[j * 128 + d];
    if (seg > 0) {
#pragma unroll
        for (int i = 0; i < 16; ++i) { const int t = seg * 16 + i, m = dir ? 63 - t : t; Lm[m * LP + d] += off; } }
    LDS_BARRIER();
}
constexpr int HP = 132;
__device__ __forceinline__ void hg_scores(const Fr& F, int l, int cid, int cid_next, v4u (&ra)[2], v4u (&rb)[2]) {
    const int chain = cid / NCHK, h = (chain >> 1) & 3, dir = chain & 1;
    float* Q_ = (float*)F.lds; float* K_ = Q_ + 64 * HP; float* L_ = K_ + 64 * HP; float* SEG = L_ + 64 * HP;
    bf16* SCG = WSP(bf16, WS_HSC) + (size_t)cid * 4096;
    float qv[2][8], fv[2][8];
    {
        float lbv[8];
        hg_lb(F, l, h, lbv);
        hg_compute_qf(lbv, ra, rb, qv, fv);
        if (cid_next < 32 * NCHK) hg_load_qf(F, cid_next, ra, rb);
#pragma unroll
        for (int i = 0; i < 2; ++i) { const int p = F.tid + 512 * i, m = p >> 4, d0 = (p & 15) * 8;
#pragma unroll
            for (int j = 0; j < 8; ++j) { Q_[m * HP + d0 + j] = qv[i][j]; K_[m * HP + d0 + j] = 1.f - fv[i][j]; L_[m * HP + d0 + j] = __logf(fv[i][j]); } }
    }
    LDS_BARRIER();
    time_cumsum<HP>(F, L_, SEG, dir);
    {
        const int mlast = dir ? 0 : 63;
        bf16* QDG = WSP(bf16, WS_HQD) + (size_t)cid * 8192;
        bf16* KEG = (cid < 1664) ? (bf16*)((unsigned char*)F.out + OUT_HKE) + (size_t)cid * 8192 : WSP(bf16, WS_HKE2) + (size_t)(cid - 1664) * 8192;
#pragma unroll
        for (int i = 0; i < 2; ++i) { const int p = F.tid + 512 * i, m = p >> 4, d0 = (p & 15) * 8;
            float qd[8], ke[8];
#pragma unroll
            for (int j = 0; j < 8; ++j) { const float Lv = L_[m * HP + d0 + j], Lt = L_[mlast * HP + d0 + j]; qd[j] = qv[i][j] * __expf(Lv); ke[j] = (1.f - fv[i][j]) * __expf(Lt - Lv); }
            v4u o; o.x = cvtpk(qd[0], qd[1]); o.y = cvtpk(qd[2], qd[3]); o.z = cvtpk(qd[4], qd[5]); o.w = cvtpk(qd[6], qd[7]); *(v4u*)(QDG + m * 128 + d0) = o;
            o.x = cvtpk(ke[0], ke[1]); o.y = cvtpk(ke[2], ke[3]); o.z = cvtpk(ke[4], ke[5]); o.w = cvtpk(ke[6], ke[7]); *(v4u*)(KEG + m * 128 + d0) = o; }
        if (F.tid < 128) WSP(float, WS_HDL)[(size_t)cid * 128 + F.tid] = __expf(L_[mlast * HP + F.tid]);
    }
    const int lane = F.lane, r16 = lane & 15, quad = lane >> 4;
    for (int p = F.wave; p < 16; p += 8) {
        int ip, jp;
        if (p < 10) { ip = (p >= 6) ? 3 : (p >= 3) ? 2 : (p >= 1) ? 1 : 0; jp = p - ip * (ip + 1) / 2; }
        else { const int r = p - 10; ip = (r >= 5) ? 2 : (r >= 3) ? 1 : 0; jp = (r >= 5) ? 3 : (r >= 3) ? (r - 3 + 2) : (r + 1); }
        const int i = dir ? 3 - ip : ip, j = dir ? 3 - jp : jp;
        f32x4 acc = (f32x4){0.f, 0.f, 0.f, 0.f};
        if (p < 10) {
            const int mt = 16 * i + r16, ms = 16 * j + r16, mref = dir ? 16 * i + 15 : 16 * i;
#pragma unroll
            for (int dk = 0; dk < 4; ++dk) { const int d0 = dk * 32 + quad * 8;
                float av[8], bv[8];
#pragma unroll
                for (int hh = 0; hh < 2; ++hh) { const f32x4 q4 = *(const f32x4*)(Q_ + mt * HP + d0 + 4 * hh), lt = *(const f32x4*)(L_ + mt * HP + d0 + 4 * hh), lr = *(const f32x4*)(L_ + mref * HP + d0 + 4 * hh);
                    const f32x4 k4 = *(const f32x4*)(K_ + ms * HP + d0 + 4 * hh), ls = *(const f32x4*)(L_ + ms * HP + d0 + 4 * hh);
#pragma unroll
                    for (int e = 0; e < 4; ++e) { av[4 * hh + e] = q4[e] * __expf(lt[e] - lr[e]); bv[4 * hh + e] = k4[e] * __expf(fminf(lr[e] - ls[e], 85.f)); } }
                v4u ua, ub; ua.x = cvtpk(av[0], av[1]); ua.y = cvtpk(av[2], av[3]); ua.z = cvtpk(av[4], av[5]); ua.w = cvtpk(av[6], av[7]);
                ub.x = cvtpk(bv[0], bv[1]); ub.y = cvtpk(bv[2], bv[3]); ub.z = cvtpk(bv[4], bv[5]); ub.w = cvtpk(bv[6], bv[7]);
                acc = __builtin_amdgcn_mfma_f32_16x16x32_bf16(__builtin_bit_cast(bf16x8, ua), __builtin_bit_cast(bf16x8, ub), acc, 0, 0, 0); }
        }
        const int ms = 16 * j + r16;
#pragma unroll
        for (int e = 0; e < 4; ++e) { const int mt = 16 * i + 4 * quad + e; const bool ok = (p < 10) && (dir ? (ms >= mt) : (ms <= mt));
            SCG[mt * 64 + ms] = (bf16)f2bf(ok ? acc[e] : 0.f); }
    }
    LDS_BARRIER();
}

constexpr int HS_DL = 0, HS_QD = 512, HS_KE = HS_QD + 64 * 272, HS_V = HS_KE + 64 * 272, HS_SC = HS_V + 64 * 272, HS_END = HS_SC + 64 * 144;
static_assert(HS_END <= 131072, "hgrn seq LDS");
__device__ __forceinline__ void hg_seq(const Fr& F, int l, int chain) {
    const int b = chain >> 3, h = (chain >> 1) & 3, dir = chain & 1;
    const int tid = F.tid, lane = F.lane, w = F.wave, r16 = lane & 15, quad = lane >> 4, tq = (lane & 15) >> 2, tp = lane & 3;
    unsigned char* lds = F.lds;
    float* DL = (float*)(lds + HS_DL);
    const bf16* Z = WSP(bf16, WS_ZH);
    bf16* O = (bf16*)((unsigned char*)F.out + OUT_OH) + (size_t)dir * RT * 512 + h * 128 + 16 * w + r16;
    f32x4 S[8];
#pragma unroll
    for (int dt = 0; dt < 8; ++dt) S[dt] = (f32x4){0.f, 0.f, 0.f, 0.f};
    v4u rQ[2], rK[2], rV[2], rS; float rD = 0.f;
#define HS_LOAD(c) do { const int cid = chain * NCHK + (c); const int rl = chunk_row_lo(b, dir, (c)); \
        const bf16* QDG = WSP(bf16, WS_HQD) + (size_t)cid * 8192; \
        const bf16* KEG = (cid < 1664) ? (const bf16*)((const unsigned char*)F.out + OUT_HKE) + (size_t)cid * 8192 : WSP(bf16, WS_HKE2) + (size_t)(cid - 1664) * 8192; \
        _Pragma("unroll") for (int i = 0; i < 2; ++i) { const int p = tid + 512 * i, m = p >> 4, d0 = (p & 15) * 8; rQ[i] = *(const v4u*)(QDG + m * 128 + d0); rK[i] = *(const v4u*)(KEG + m * 128 + d0); \
            rV[i] = *(const v4u*)(Z + (size_t)(rl + m) * ZP + C_HG + 3 * 512 + h * 128 + d0); } \
        rS = *(const v4u*)(WSP(bf16, WS_HSC) + (size_t)cid * 4096 + tid * 8); \
        if (tid < 128) rD = WSP(float, WS_HDL)[(size_t)cid * 128 + tid]; } while (0)
    HS_LOAD(0);
    for (int c = 0; c < NCHK; ++c) {
        const int row_lo = chunk_row_lo(b, dir, c);
#pragma unroll
        for (int i = 0; i < 2; ++i) { const int p = tid + 512 * i, m = p >> 4, d0 = (p & 15) * 8;
            *(v4u*)(lds + HS_QD + m * 272 + d0 * 2) = rQ[i]; *(v4u*)(lds + HS_KE + m * 272 + d0 * 2) = rK[i]; *(v4u*)(lds + HS_V + m * 272 + d0 * 2) = rV[i]; }
        { const int m = tid >> 3, c0 = (tid & 7) * 8; *(v4u*)(lds + HS_SC + m * 144 + c0 * 2) = rS; }
        if (tid < 128) DL[tid] = rD;
        if (c + 1 < NCHK) HS_LOAD(c + 1);
        LDS_BARRIER();
        bf16x8 vb[2], sb[4];
#pragma unroll
        for (int ks = 0; ks < 2; ++ks) { const unsigned char* p0 = lds + HS_V + (32 * ks + 8 * quad + tq) * 272 + (16 * w + 4 * tp) * 2; vb[ks] = cat8(ldtr(p0), ldtr(p0 + 4 * 272)); }
#pragma unroll
        for (int ks = 0; ks < 4; ++ks) sb[ks] = pack8(S[2 * ks], S[2 * ks + 1]);
#pragma unroll
        for (int i = 0; i < 4; ++i) {
            f32x4 acc = (f32x4){0.f, 0.f, 0.f, 0.f};
            const unsigned char* qrow = lds + HS_QD + (16 * i + r16) * 272;
#pragma unroll
            for (int ks = 0; ks < 4; ++ks) { const bf16x8 a = cat8(*(const s16x4*)(qrow + (32 * ks + 4 * quad) * 2), *(const s16x4*)(qrow + (32 * ks + 16 + 4 * quad) * 2));
                acc = __builtin_amdgcn_mfma_f32_16x16x32_bf16(a, sb[ks], acc, 0, 0, 0); }
            const unsigned char* srow = lds + HS_SC + (16 * i + r16) * 144;
#pragma unroll
            for (int ks = 0; ks < 2; ++ks) { const bf16x8 a = *(const bf16x8*)(srow + (32 * ks + 8 * quad) * 2); acc = __builtin_amdgcn_mfma_f32_16x16x32_bf16(a, vb[ks], acc, 0, 0, 0); }
#pragma unroll
            for (int e = 0; e < 4; ++e) O[(size_t)(row_lo + 16 * i + 4 * quad + e) * 512] = (bf16)f2bf(acc[e]);
        }
#pragma unroll
        for (int dt = 0; dt < 8; ++dt) {
            const f32x4 dl = *(const f32x4*)(DL + 16 * dt + 4 * quad);
            f32x4 acc = S[dt] * dl;
#pragma unroll
            for (int ks = 0; ks < 2; ++ks) { const unsigned char* p0 = lds + HS_KE + (32 * ks + 8 * quad + tq) * 272 + (16 * dt + 4 * tp) * 2;
                acc = __builtin_amdgcn_mfma_f32_16x16x32_bf16(cat8(ldtr(p0), ldtr(p0 + 4 * 272)), vb[ks], acc, 0, 0, 0); }
            S[dt] = acc;
        }
        LDS_BARRIER();
    }
#undef HS_LOAD
}

__device__ __forceinline__ void gd_pre(const Fr& F, int cid) {
    const int chain = cid / NCHK, c = cid % NCHK, b = chain >> 3, h = (chain >> 1) & 3, dir = chain & 1;
    const int row_lo = chunk_row_lo(b, dir, c), lane = F.lane, r16 = lane & 15, quad = lane >> 4;
    float* Af = (float*)(F.lds + F.wave * 16896);
    float* cumL = Af + 4096; float* betaL = cumL + 64;
    const bf16* GQKV = WSP(bf16, WS_GQKV); const float* GB = WSP(float, WS_GB);
    bf16* T1G = (bf16*)((unsigned char*)F.out + OUT_GT) + (size_t)cid * 2 * 4096; bf16* ATG = T1G + 4096;
    float* SCL = WSP(float, WS_GSCAL) + (size_t)cid * 132;
    const float g = GB[(size_t)(row_lo + lane) * 16 + dir * 4 + h], beta = GB[(size_t)(row_lo + lane) * 16 + 8 + dir * 4 + h];
    float cum = g;
#pragma unroll
    for (int off = 1; off < 64; off <<= 1) { const float v = dir ? __shfl_down(cum, off) : __shfl_up(cum, off); const bool ok = dir ? (lane + off < 64) : (lane >= off); if (ok) cum += v; }
    cumL[lane] = cum; betaL[lane] = beta;
    const float last = __shfl(cum, dir ? 0 : 63);
    SCL[lane] = __expf(cum); SCL[64 + lane] = __expf(last - cum); if (lane == 0) SCL[128] = __expf(last);
    LDS_WAIT();
#pragma unroll 1
    for (int i = 0; i < 4; ++i) {
        bf16x8 qf[4], kfi[4];
#pragma unroll
        for (int dk = 0; dk < 4; ++dk) { const bf16* gr = GQKV + (size_t)(row_lo + 16 * i + r16) * 1536 + h * 128 + dk * 32 + quad * 8; qf[dk] = *(const bf16x8*)gr; kfi[dk] = *(const bf16x8*)(gr + 512); }
#pragma unroll 1
        for (int j2 = 0; j2 < 2; ++j2) {
            bf16x8 kfj[2][4];
#pragma unroll
            for (int jj = 0; jj < 2; ++jj)
#pragma unroll
                for (int dk = 0; dk < 4; ++dk) kfj[jj][dk] = *(const bf16x8*)(GQKV + (size_t)(row_lo + 16 * (2 * j2 + jj) + r16) * 1536 + 512 + h * 128 + dk * 32 + quad * 8);
#pragma unroll
            for (int jj = 0; jj < 2; ++jj) { const int j = 2 * j2 + jj;
                f32x4 kk = (f32x4){0.f, 0.f, 0.f, 0.f}, qk = (f32x4){0.f, 0.f, 0.f, 0.f};
#pragma unroll
                for (int dk = 0; dk < 4; ++dk) { kk = __builtin_amdgcn_mfma_f32_16x16x32_bf16(kfi[dk], kfj[jj][dk], kk, 0, 0, 0); qk = __builtin_amdgcn_mfma_f32_16x16x32_bf16(qf[dk], kfj[jj][dk], qk, 0, 0, 0); }
                const int ms = 16 * j + r16, s = dir ? 63 - ms : ms; const float cs = cumL[ms];
#pragma unroll
                for (int e = 0; e < 4; ++e) { const int mt = 16 * i + 4 * quad + e, t = dir ? 63 - mt : mt;
                    const float dec = __expf(fminf(cumL[mt] - cs, 0.f));
                    Af[t * 64 + s] = (s < t) ? betaL[mt] * kk[e] * dec : 0.f;
                    ATG[mt * 64 + ms] = (bf16)f2bf((s <= t) ? qk[e] * dec : 0.f); } }
        }
    }
    LDS_WAIT();
    for (int t = 0; t < 64; ++t) {
        float v0 = (t == lane) ? 1.f : 0.f, v1 = 0.f, v2 = 0.f, v3 = 0.f;
        for (int s0 = 0; s0 < t; s0 += 16) {
            f32x4 a[4]; float ts[16];
#pragma unroll
            for (int x = 0; x < 4; ++x) a[x] = *(const f32x4*)(Af + t * 64 + s0 + 4 * x);
#pragma unroll
            for (int x = 0; x < 16; ++x) ts[x] = Af[(s0 + x) * 64 + lane];
#pragma unroll
            for (int x = 0; x < 4; ++x) {
                v0 -= (s0 + 4 * x + 0 < t) ? a[x][0] * ts[4 * x + 0] : 0.f; v1 -= (s0 + 4 * x + 1 < t) ? a[x][1] * ts[4 * x + 1] : 0.f;
                v2 -= (s0 + 4 * x + 2 < t) ? a[x][2] * ts[4 * x + 2] : 0.f; v3 -= (s0 + 4 * x + 3 < t) ? a[x][3] * ts[4 * x + 3] : 0.f; }
        }
        const float v = (v0 + v1) + (v2 + v3);
        Af[t * 64 + lane] = v;
    }
    LDS_WAIT();
    const int msl = dir ? 63 - lane : lane; const float bs = betaL[msl];
    for (int t = 0; t < 64; ++t) { const int mt = dir ? 63 - t : t; const float tv = Af[t * 64 + lane]; T1G[mt * 64 + msl] = (bf16)f2bf(tv * bs); }
    LDS_WAIT();
}

constexpr int GS_T1 = 0, GS_T2 = 9216, GS_AT = 18432, GS_K = 27648, GS_Q = GS_K + 17408, GS_V = GS_Q + 17408, GS_W = GS_V + 17408, GS_SCL = GS_W + 17408, GS_END = GS_SCL + 1024;
static_assert(GS_END <= 131072, "gdn seq LDS");
__device__ __forceinline__ void gd_seq(const Fr& F, int chain) {
    const int b = chain >> 3, h = (chain >> 1) & 3, dir = chain & 1;
    const int tid = F.tid, lane = F.lane, w = F.wave, r16 = lane & 15, quad = lane >> 4, tq = (lane & 15) >> 2, tp = lane & 3;
    unsigned char* lds = F.lds;
    const bf16* GQKV = WSP(bf16, WS_GQKV);
    const bf16* TG = (const bf16*)((const unsigned char*)F.out + OUT_GT) + (size_t)chain * NCHK * 2 * 4096;
    const float* SCG = WSP(float, WS_GSCAL) + (size_t)chain * NCHK * 132;
    float* SCL = (float*)(lds + GS_SCL);
    bf16* O = (bf16*)((unsigned char*)F.out + OUT_OG) + (size_t)dir * RT * 512 + h * 128 + 16 * w + r16;
    f32x4 S[8];
#pragma unroll
    for (int dt = 0; dt < 8; ++dt) S[dt] = (f32x4){0.f, 0.f, 0.f, 0.f};
    v4u rT[2], rK[2], rQ[2], rV[2]; f32x4 rE[2]; float rS = 0.f;
#define GS_LOAD(c) do { const int rl = chunk_row_lo(b, dir, (c)); \
        _Pragma("unroll") for (int x = 0; x < 2; ++x) rT[x] = *(const v4u*)(TG + ((size_t)(c) * 2 + x) * 4096 + tid * 8); \
        rE[0] = *(const f32x4*)(SCG + (size_t)(c) * 132 + (tid & 7) * 8); rE[1] = *(const f32x4*)(SCG + (size_t)(c) * 132 + (tid & 7) * 8 + 4); \
        _Pragma("unroll") for (int i = 0; i < 2; ++i) { const int p = tid + 512 * i, m = p >> 4, d0 = (p & 15) * 8; const bf16* gr = GQKV + (size_t)(rl + m) * 1536 + h * 128 + d0; \
            rQ[i] = *(const v4u*)gr; rK[i] = *(const v4u*)(gr + 512); rV[i] = *(const v4u*)(gr + 1024); } \
        if (tid < 132) rS = SCG[(size_t)(c) * 132 + tid]; } while (0)
    GS_LOAD(0);
    for (int c = 0; c < NCHK; ++c) {
        const int row_lo = chunk_row_lo(b, dir, c);
        { const int m = tid >> 3, c0 = (tid & 7) * 8;
          *(v4u*)(lds + GS_T1 + m * 144 + c0 * 2) = rT[0]; *(v4u*)(lds + GS_AT + m * 144 + c0 * 2) = rT[1];
          v4u t2; t2.x = cvtpk(-bflo(rT[0].x) * rE[0][0], -bfhi(rT[0].x) * rE[0][1]); t2.y = cvtpk(-bflo(rT[0].y) * rE[0][2], -bfhi(rT[0].y) * rE[0][3]);
          t2.z = cvtpk(-bflo(rT[0].z) * rE[1][0], -bfhi(rT[0].z) * rE[1][1]); t2.w = cvtpk(-bflo(rT[0].w) * rE[1][2], -bfhi(rT[0].w) * rE[1][3]);
          *(v4u*)(lds + GS_T2 + m * 144 + c0 * 2) = t2; }
#pragma unroll
        for (int i = 0; i < 2; ++i) { const int p = tid + 512 * i, m = p >> 4, d0 = (p & 15) * 8;
            *(v4u*)(lds + GS_K + m * 272 + d0 * 2) = rK[i]; *(v4u*)(lds + GS_Q + m * 272 + d0 * 2) = rQ[i]; *(v4u*)(lds + GS_V + m * 272 + d0 * 2) = rV[i]; }
        if (tid < 132) SCL[tid] = rS;
        if (c + 1 < NCHK) GS_LOAD(c + 1);
        LDS_BARRIER();
        {
            bf16x8 kb[2];
#pragma unroll
            for (int ks = 0; ks < 2; ++ks) { const unsigned char* p0 = lds + GS_K + (32 * ks + 8 * quad + tq) * 272 + (16 * w + 4 * tp) * 2; kb[ks] = cat8(ldtr(p0), ldtr(p0 + 4 * 272)); }
#pragma unroll
            for (int i = 0; i < 4; ++i) { f32x4 acc = (f32x4){0.f, 0.f, 0.f, 0.f};
                const unsigned char* trow = lds + GS_T2 + (16 * i + r16) * 144;
#pragma unroll
                for (int ks = 0; ks < 2; ++ks) acc = __builtin_amdgcn_mfma_f32_16x16x32_bf16(*(const bf16x8*)(trow + (32 * ks + 8 * quad) * 2), kb[ks], acc, 0, 0, 0);
#pragma unroll
                for (int e = 0; e < 4; ++e) *(bf16*)(lds + GS_W + (16 * i + 4 * quad + e) * 272 + (16 * w + r16) * 2) = (bf16)f2bf(acc[e]); }
        }
        LDS_BARRIER();
        {
            bf16x8 vb[2], sb[4];
#pragma unroll
            for (int ks = 0; ks < 2; ++ks) { const unsigned char* p0 = lds + GS_V + (32 * ks + 8 * quad + tq) * 272 + (16 * w + 4 * tp) * 2; vb[ks] = cat8(ldtr(p0), ldtr(p0 + 4 * 272)); }
#pragma unroll
            for (int ks = 0; ks < 4; ++ks) sb[ks] = pack8(S[2 * ks], S[2 * ks + 1]);
            f32x4 vn[4];
#pragma unroll
            for (int i = 0; i < 4; ++i) { f32x4 acc = (f32x4){0.f, 0.f, 0.f, 0.f};
                const unsigned char* trow = lds + GS_T1 + (16 * i + r16) * 144;
#pragma unroll
                for (int ks = 0; ks < 2; ++ks) acc = __builtin_amdgcn_mfma_f32_16x16x32_bf16(*(const bf16x8*)(trow + (32 * ks + 8 * quad) * 2), vb[ks], acc, 0, 0, 0);
                const unsigned char* wrow = lds + GS_W + (16 * i + r16) * 272;
#pragma unroll
                for (int ks = 0; ks < 4; ++ks) acc = __builtin_amdgcn_mfma_f32_16x16x32_bf16(cat8(*(const s16x4*)(wrow + (32 * ks + 4 * quad) * 2), *(const s16x4*)(wrow + (32 * ks + 16 + 4 * quad) * 2)), sb[ks], acc, 0, 0, 0);
                vn[i] = acc; }
            bf16x8 vnb[2];
#pragma unroll
            for (int ks = 0; ks < 2; ++ks) vnb[ks] = pack8(vn[2 * ks], vn[2 * ks + 1]);
#pragma unroll
            for (int i = 0; i < 4; ++i) { f32x4 acc = (f32x4){0.f, 0.f, 0.f, 0.f};
                const unsigned char* qrow = lds + GS_Q + (16 * i + r16) * 272;
#pragma unroll
                for (int ks = 0; ks < 4; ++ks) acc = __builtin_amdgcn_mfma_f32_16x16x32_bf16(cat8(*(const s16x4*)(qrow + (32 * ks + 4 * quad) * 2), *(const s16x4*)(qrow + (32 * ks + 16 + 4 * quad) * 2)), sb[ks], acc, 0, 0, 0);
                acc = acc * *(const f32x4*)(SCL + 16 * i + 4 * quad);
                const unsigned char* arow = lds + GS_AT + (16 * i + r16) * 144;
#pragma unroll
                for (int ks = 0; ks < 2; ++ks) acc = __builtin_amdgcn_mfma_f32_16x16x32_bf16(cat8(*(const s16x4*)(arow + (32 * ks + 4 * quad) * 2), *(const s16x4*)(arow + (32 * ks + 16 + 4 * quad) * 2)), vnb[ks], acc, 0, 0, 0);
#pragma unroll
                for (int e = 0; e < 4; ++e) O[(size_t)(row_lo + 16 * i + 4 * quad + e) * 512] = (bf16)f2bf(acc[e]); }
#pragma unroll
            for (int i = 0; i < 4; ++i) vn[i] = vn[i] * *(const f32x4*)(SCL + 64 + 16 * i + 4 * quad);
#pragma unroll
            for (int ks = 0; ks < 2; ++ks) vnb[ks] = pack8(vn[2 * ks], vn[2 * ks + 1]);
            const float elast = SCL[128];
#pragma unroll
            for (int dt = 0; dt < 8; ++dt) { f32x4 acc = S[dt] * elast;
#pragma unroll
                for (int ks = 0; ks < 2; ++ks) { const unsigned char* p0 = lds + GS_K + (32 * ks + 4 * quad + tq) * 272 + (16 * dt + 4 * tp) * 2;
                    acc = __builtin_amdgcn_mfma_f32_16x16x32_bf16(cat8(ldtr(p0), ldtr(p0 + 16 * 272)), vnb[ks], acc, 0, 0, 0); }
                S[dt] = acc; }
        }
        LDS_BARRIER();
    }
#undef GS_LOAD
}

__device__ __forceinline__ void phase_prepass(const Fr& F, int l) {
    {
        const int N = 32 * NCHK, bx = blockIdx.x; int c0, cstep, cend;
        if (F.G == 256) { if (bx < 240) { c0 = bx; cstep = 240; cend = N - 64; } else { c0 = N - 64 + (bx - 240); cstep = 16; cend = N; } }
        else { c0 = bx; cstep = F.G; cend = N; }
        v4u ra[2], rb[2]; if (c0 < cend) hg_load_qf(F, c0, ra, rb);
        for (int cid = c0; cid < cend; cid += cstep) hg_scores(F, l, cid, (cid + cstep < cend) ? cid + cstep : N, ra, rb);
    }
    __syncthreads();
    for (int cid = (F.G - 1 - (int)blockIdx.x) * 8 + F.wave; cid < 32 * NCHK; cid += F.NGW) gd_pre(F, cid);
    __syncthreads();
}

#define XB_TMO      128
#define XB_XCNT(j)  (256  + 64 * (j))
#define XB_XSUB(j)  (1280 + 64 * (j))
#define XB_XGEN(j)  (2304 + 64 * (j))
#define XB_TOP      3328
#define XB_TOPGEN   3392
#define XCD_BAR_WORDS 3456
#define XB_SPIN_CAP (1u << 18)

__device__ __forceinline__ unsigned xb_ld(unsigned* p)              { return __hip_atomic_load(p, __ATOMIC_RELAXED, __HIP_MEMORY_SCOPE_AGENT); }
__device__ __forceinline__ unsigned xb_add(unsigned* p, unsigned v) { return __hip_atomic_fetch_add(p, v, __ATOMIC_RELAXED, __HIP_MEMORY_SCOPE_AGENT); }
__device__ __forceinline__ unsigned xb_xcc_id() { return (unsigned)__builtin_amdgcn_s_getreg((3 << 11) | 20) & 0xFu; }
#define XB_SPIN(cond, bar) do { unsigned _sp = 0; while (cond) { __builtin_amdgcn_s_sleep(1); \
    if ((++_sp & 255u) == 0u) { if (xb_ld(&(bar)[XB_TMO])) break; if (_sp > XB_SPIN_CAP) { atomicAdd(&(bar)[XB_TMO], 1u); break; } } } } while (0)

struct XcdBarrier {
    unsigned* bar; unsigned x;
    volatile LAS unsigned* st;
};

__device__ __forceinline__ XcdBarrier xcd_barrier_post(unsigned* bar, volatile LAS unsigned* st) {
    XcdBarrier b; b.bar = bar; b.x = xb_xcc_id(); b.st = st;
    if (threadIdx.x == 0) (void)xb_add(&bar[XB_XCNT(b.x)], 1u);
    return b;
}
__device__ __forceinline__ void xcd_barrier_complete(unsigned* bar, unsigned x, unsigned& nloc, unsigned& nx) {
    const unsigned G = gridDim.x * gridDim.y * gridDim.z;
    unsigned sum, cnt, mine, sp = 0u;
    for (;;) {
        sum = 0u; cnt = 0u; mine = 0u;
#pragma unroll
        for (unsigned j = 0; j < 16; ++j) { const unsigned c = xb_ld(&bar[XB_XCNT(j)]); sum += c; cnt += (c > 0u) ? 1u : 0u; mine = (j == x) ? c : mine; }
        if (sum == G) break;
        __builtin_amdgcn_s_sleep(1);
        if ((++sp & 255u) == 0u) { if (xb_ld(&bar[XB_TMO])) break; if (sp > XB_SPIN_CAP) { atomicAdd(&bar[XB_TMO], 1u); break; } }
    }
    nloc = mine > 0u ? mine : 1u; nx = cnt > 0u ? cnt : 1u;
}

__device__ __forceinline__ void xcd_barrier(const XcdBarrier& b) {
    asm volatile("s_waitcnt vmcnt(0)" ::: "memory");
    __syncthreads();
    if (threadIdx.x == 0) {
        unsigned* bar = b.bar;
        __builtin_amdgcn_s_waitcnt(0);
        unsigned nloc = b.st[0], nx = b.st[1];
        if (nloc == 0u) { xcd_barrier_complete(bar, b.x, nloc, nx); b.st[0] = nloc; b.st[1] = nx; }
        const unsigned old = xb_add(&bar[XB_XSUB(b.x)], 1u);
        const unsigned gen = old / nloc;
        if (old + 1u == (gen + 1u) * nloc) {
            __builtin_amdgcn_fence(__ATOMIC_RELEASE, "agent");
            asm volatile("s_waitcnt vmcnt(0)" ::: "memory");
            const unsigned og = xb_add(&bar[XB_TOP], 1u);
            const unsigned tg = og / nx;
            if (og + 1u == (tg + 1u) * nx) xb_add(&bar[XB_TOPGEN], 1u);
            else XB_SPIN(xb_ld(&bar[XB_TOPGEN]) == tg, bar);
            __builtin_amdgcn_fence(__ATOMIC_ACQUIRE, "agent");
            xb_add(&bar[XB_XGEN(b.x)], 1u);
            asm volatile("s_waitcnt vmcnt(0)" ::: "memory");
        } else {
            XB_SPIN(xb_ld(&bar[XB_XGEN(b.x)]) == gen, bar);
            __builtin_amdgcn_fence(__ATOMIC_ACQUIRE, "agent");
            asm volatile("s_waitcnt vmcnt(0)" ::: "memory");
        }
    }
    __syncthreads();
}

__device__ __forceinline__ void phase_mixers(const Fr& F, int l) {
    const int G = F.G, nscan = 64, bx = blockIdx.x;
    const bool split = (G == 256);
    const int natt = split ? 192 : G, ab = split ? bx - nscan : bx;
    for (int it = bx; it < 64; it += G) { if (it < 32) gd_seq(RL(F), it); else hg_seq(RL(F), l, it - 32); __syncthreads(); }
    const bf16* Z = WSP(bf16, WS_ZH); bf16* Y = WSP(bf16, WS_AY);
    const bf16* MQ = WSP(bf16, WS_MQ); const bf16* MK = WSP(bf16, WS_MK); const bf16* MVT = WSP(bf16, WS_MVT); const bf16* NAVT = WSP(bf16, WS_NAVT); const bf16* KROPE = WSP(bf16, WS_KROPE);
    const int ntot = 512 + (l == 0 ? 32 : 0);
    const float sl_mla = 0.07216878364870322f * LOG2E, sl_na = 0.08838834764831845f * LOG2E;
    for (int k = 0; ; ++k) {
        int p, t0 = 0, nl = 64, pidx = -1;
        if (split && bx < 64) {
            if (bx < 32) { if (k >= 1) break; p = 256 + 64 + bx; } else { if (k >= 2) break; p = 256 + 2 * (bx - 32) + k; }
        } else if (split) {
            if (k == 0) p = ab;
            else if (k == 1) { const int su = ab / 3, part = ab - 3 * su; p = 192 + su; t0 = part * 23; nl = part == 2 ? 18 : 23; pidx = ab; }
            else if (k == 2) { if (ab >= 160) continue; p = 256 + 96 + ab; }
            else if (k == 3) { if (l != 0 || ab < 160) break; p = 512 + (ab - 160); }
            else break;
        } else { p = ab + k * natt; if (p >= ntot) break; }
        if (p < 256 || (p >= 512 && p < 528)) {
            const bool lat = p < 256; const int b_ = lat ? (p >> 6) : ((p - 512) >> 2), h_ = lat ? ((p >> 4) & 3) : (p & 3), qb_ = p & 15;
            attn_unit<192, false>(RL(F), MQ + h_ * 192, 768, lat ? b_ * SEQ + qb_ * 256 : NLAT + b_ * CTX, lat, MK + h_ * 128, 512, MVT + (size_t)h_ * 128 * RT,
                                  lat ? b_ * SEQ + t0 * 64 : 0, lat ? nl : 0, NLAT + b_ * CTX, lat ? ((pidx >= 0 && t0 < 46) ? nl : nl + 4) : 4, Y + 1024 + h_ * 128, sl_mla, 0, 0, nullptr, pidx);
        } else {
            const bool lat = p < 512; const int v_ = lat ? p - 256 : p - 528, b_ = lat ? (v_ >> 6) : (v_ >> 2), h_ = lat ? ((v_ >> 4) & 3) : (v_ & 3), rg_ = v_ & 15;
            const int lo_ = min(max(4 * rg_ - 4, 0), 56), hi_ = min(max(4 * rg_ + 3 - 4, 0), 56) + 7, nwin_ = lat ? hi_ - lo_ + 1 : 0;
            attn_unit<128, true>(RL(F), Z + C_NA + h_ * 128, ZP, lat ? b_ * SEQ + rg_ * 256 : NLAT + b_ * CTX, false, Z + C_NA + 512 + h_ * 128, ZP, NAVT + (size_t)h_ * 128 * RT,
                                 lat ? b_ * SEQ + lo_ * 64 : 0, nwin_, NLAT + b_ * CTX, nwin_ + 4, Y + 512 + h_ * 128, sl_na, lat ? lo_ : 0, lat ? 4 * rg_ : 0,
                                 lat ? inp(F, 11) + (size_t)(l * 4 + h_) * 15 * 31 : nullptr, -1);
        }
        __syncthreads();
    }
}

template <class Epi, bool OPAQUE_K = false>
__device__ __forceinline__ void run_gemm(const Fr& F, const bf16* A, const bf16* Bt, int M, int N, int K, const Epi& E, int coff = 0) {
    if (OPAQUE_K) asm volatile("" : "+s"(K));
    pg8::Gemm g{A, Bt, M, N, K, K, K}; pg8::StaticOrder S; S.init(M, N, F.G, (int)((blockIdx.x + (unsigned)coff) % (unsigned)F.G));
    pg8::gemm_phase<Epi, pg8::StaticOrder, true, true>((LAS unsigned char*)F.lds, g, S, E);
}

__device__ __forceinline__ void run_gemm_splitk(const Fr& F, const bf16* A, int lda, const bf16* Bt, int ldb, int M, int N, int K, int KS, const pg8::EpiCtxSplit& E) {
    pg8::Gemm g{A, Bt, M, N, K, lda, ldb}; pg8::SplitKOrder S; S.init(M, N, KS, F.G, (int)blockIdx.x);
    pg8::gemm_phase<pg8::EpiCtxSplit, pg8::SplitKOrder, true, true>((LAS unsigned char*)F.lds, g, S, E);
}

__global__ void __launch_bounds__(512, 2) mk_fwd(Args args) {
    extern __shared__ __attribute__((aligned(16))) unsigned char lds[];
    cg::grid_group grid = cg::this_grid();
    Fr F; F.kp = (kargp_t)__builtin_amdgcn_kernarg_segment_ptr(); F.out = args.out; F.ws = args.ws; F.lds = lds;
    F.tid = threadIdx.x; F.lane = F.tid & 63; F.wave = __builtin_amdgcn_readfirstlane(F.tid >> 6); F.G = gridDim.x;
    F.gw = blockIdx.x * 8 + F.wave; F.NGW = F.G * 8;
#define ADA WSP(float, WS_ADA)
#define AY WSP(bf16, WS_AY)
#define X WSP(float, WS_X)
#define ZH WSP(bf16, WS_ZH)
    unsigned* barw = (unsigned*)args.ws;
    if (blockIdx.x == 0) for (int i = threadIdx.x; i < 4096; i += 512) barw[i] = 0u;
    volatile LAS unsigned* bst = (volatile LAS unsigned*)((LAS unsigned char*)lds + 144000);
    if (threadIdx.x < 4) bst[threadIdx.x] = 0u;
    __syncthreads();

    phase_ada(RL(F)); __syncthreads(); { const Fr Fw = RL(F); phase_wconv(Fw, 0, 0, Fw.gw, Fw.NGW); }
    grid.sync();
    const XcdBarrier xb = xcd_barrier_post(barw, bst);
    phase_mod0(RL(F));
    xcd_barrier(xb);
    for (int l = 0; l < 2; ++l) {
        const int MR = (l == 0) ? RT : NLAT;
        run_gemm(F, AY, WSP(bf16, WS_WIN), RT, ZP, DM, pg8::EpiStore<0>{ZH, ZP});
        {
            const int rem = ((RT / 256) * (ZP / 256)) % F.G, first = rem == 0 ? 0 : rem;
            if ((int)blockIdx.x >= first) { __syncthreads(); const Fr Fw = RL(F); phase_wconv(Fw, l, 1, ((int)blockIdx.x - first) * 8 + Fw.wave, (F.G - first) * 8); }
        }
        xcd_barrier(xb);
        phase_prep(RL(F), l);
        xcd_barrier(xb);
        run_gemm<pg8::EpiStore<0>, true>(F, WSP(bf16, WS_QN), WSP(bf16, WS_WUQ), RT, 768, 384, pg8::EpiStore<0>{WSP(bf16, WS_MQ), 768});
        run_gemm<pg8::EpiStore<0>, true>(F, WSP(bf16, WS_CKVN), WSP(bf16, WS_WUK), RT, 512, 256, pg8::EpiStore<0>{WSP(bf16, WS_MK), 512}, F.G == 256 ? 48 : 0);
        run_gemm<pg8::EpiStore<0>, true>(F, WSP(bf16, WS_WUV), WSP(bf16, WS_CKVN), 512, RT, 256, pg8::EpiStore<0>{WSP(bf16, WS_MVT), RT}, F.G == 256 ? 168 : 0);
        phase_prepass(RL(F), l);
        xcd_barrier(xb);
        phase_mixers(RL(F), l);
        xcd_barrier(xb);
        phase_post(RL(F), l, MR);
        xcd_barrier(xb);
        if (l == 0) run_gemm(F, AY, WSP(bf16, WS_WOUT), RT, DM, DM, pg8::EpiResid{inp(F, 0), inp(F, 2), X, ADA + 2 * 2048, ALPHA_RES});
        else run_gemm(F, AY, WSP(bf16, WS_WOUT), NLAT, DM, DM, pg8::EpiResid{X, X, X, ADA + (size_t)5 * ADAW + 2 * 2048, ALPHA_RES});
        xcd_barrier(xb);
        phase_ln(RL(F), l, 1, MR);
        xcd_barrier(xb);
        run_gemm(F, AY, WSP(bf16, WS_WM1), MR, FF, DM, pg8::EpiStore<1>{ZH, FF});
        if (l == 0) {
            const int rem = ((MR / 256) * (FF / 256)) % F.G, first = rem;
            if ((int)blockIdx.x >= first) { __syncthreads(); const Fr Fw = RL(F); phase_wconv(Fw, 1, 0, ((int)blockIdx.x - first) * 8 + Fw.wave, (F.G - first) * 8); }
        }
        xcd_barrier(xb);
        run_gemm(F, ZH, WSP(bf16, WS_WM2), NLAT, DM, FF, pg8::EpiResid{X, X, X, ADA + (size_t)l * 5 * ADAW + 5 * 2048, 1.f});
        if (l == 0) {
            run_gemm_splitk(F, ZH + (size_t)NLAT * FF, FF, WSP(bf16, WS_WM2), FF, NCTX, DM, FF / 2, 2, pg8::EpiCtxSplit{X + (size_t)NLAT * DM, WSP(float, WS_PART), ADA + 4 * ADAW + 5 * 2048});
        }
        xcd_barrier(xb);
        phase_ln(RL(F), l, 2, MR);
        if (l == 0) xcd_barrier(xb);
    }
}
#undef ADA
#undef AY
#undef X
#undef ZH

extern "C" void kernel_launch(void* const* d_in, const int* in_sizes, int n_in, void* d_out, int out_size, void* d_ws, size_t ws_size, hipStream_t stream) {
    static int grid = 0;
    if (grid == 0) {
        int dev = 0, cus = 0, per_cu = 0;
        if (n_in != 26 || ws_size < WS_END) { fprintf(stderr, "kernel_launch: unexpected n_in %d / ws %zu (need %zu)\n", n_in, ws_size, (size_t)WS_END); grid = -1; return; }
        (void)hipGetDevice(&dev); (void)hipDeviceGetAttribute(&cus, hipDeviceAttributeMultiprocessorCount, dev);
        if (hipFuncSetAttribute((const void*)mk_fwd, hipFuncAttributeMaxDynamicSharedMemorySize, LDS_BYTES) != hipSuccess) { fprintf(stderr, "kernel_launch: hipFuncSetAttribute failed\n"); grid = -1; return; }
        if (hipOccupancyMaxActiveBlocksPerMultiprocessor(&per_cu, (const void*)mk_fwd, 512, LDS_BYTES) != hipSuccess || per_cu < 1) per_cu = 1;
        (void)hipGetLastError();
        grid = cus * 1;
        fprintf(stderr, "kernel_launch: grid %d (cus %d, occupancy query %d), ws %zu\n", grid, cus, per_cu, ws_size);
    }
    if (grid < 0) return;
    Args a{};
    for (int i = 0; i < 26; ++i) a.in[i] = (const float*)d_in[i];
    a.out = (float*)d_out; a.ws = (unsigned char*)d_ws;
    void* kargs[] = {&a};
    const hipError_t e = hipLaunchCooperativeKernel((const void*)mk_fwd, dim3(grid), dim3(512), kargs, LDS_BYTES, stream);
    if (e != hipSuccess) fprintf(stderr, "kernel_launch: cooperative launch failed: %s (grid %d)\n", hipGetErrorString(e), grid);
}
```

```cpp
#include <hip/hip_runtime.h>
#include <hip/hip_cooperative_groups.h>
#include <cstdio>
#include <cstdint>
namespace cg = cooperative_groups;
#define LAS __attribute__((address_space(3)))
typedef unsigned short bf16;
typedef unsigned v4u __attribute__((ext_vector_type(4)));
typedef unsigned v2u __attribute__((ext_vector_type(2)));
typedef float f32x4 __attribute__((ext_vector_type(4)));
typedef float f32x2 __attribute__((ext_vector_type(2)));
typedef short bf16x8 __attribute__((ext_vector_type(8)));

constexpr int DM = 2048, NBATCH = 4, SEQ = 4096, CTX = 256, NLAT = NBATCH * SEQ, NCTX = NBATCH * CTX, RT = NLAT + NCTX;
constexpr int ZC = 6864, ZP = 6912;
constexpr int C_GDN = 0, C_NA = 2064, C_MLA = 3600, C_HG = 4304;
constexpr int FF = 8192, ADAW = 12288;
constexpr float LOG2E = 1.4426950408889634f;
constexpr float ALPHA_RES = 1.4142135623730951f;

constexpr size_t MiB = 1u << 20;
constexpr size_t WS_ADA = 1 * MiB;
constexpr size_t WS_WIN = 2 * MiB, WS_WOUT = 29 * MiB, WS_WM1 = 37 * MiB, WS_WM2 = 69 * MiB, WS_WUQ = 101 * MiB, WS_WUK = 102 * MiB, WS_WUV = 102 * MiB + 512 * 1024;
constexpr size_t WS_AY = 104 * MiB;
constexpr size_t WS_X = 172 * MiB;
constexpr size_t WS_ZH = 308 * MiB;
constexpr size_t WS_GQKV = 580 * MiB;
constexpr size_t WS_QN = 631 * MiB, WS_CKVN = 644 * MiB, WS_MQ = 653 * MiB, WS_MK = 679 * MiB, WS_MVT = 696 * MiB, WS_NAVT = 713 * MiB, WS_KROPE = 730 * MiB, WS_GB = 733 * MiB;
constexpr size_t WS_ROPE = 735 * MiB;
constexpr size_t WS_HSC = 736 * MiB;
constexpr size_t WS_GSCAL = 753 * MiB;
constexpr size_t WS_HDL = 755 * MiB;
constexpr size_t WS_HQD = 538 * MiB;
constexpr size_t WS_HKE2 = 572 * MiB;
constexpr size_t WS_PO = WS_QN, WS_PML = 643 * MiB;
constexpr size_t WS_PART = 757 * MiB;
constexpr size_t WS_END = 765 * MiB;
static_assert(WS_PO + (size_t)192 * 256 * 128 * 2 <= WS_PML && WS_PML + (size_t)192 * 256 * 2 * 4 <= WS_CKVN, "split-KV partials");
static_assert(WS_ZH + (size_t)RT * ZP * 2 <= WS_HQD && WS_HQD + (size_t)2176 * 16384 <= WS_HKE2 && WS_HKE2 + (size_t)512 * 16384 <= WS_GQKV, "hgrn pre-pass buffers in the z/h tail");
static_assert(WS_WIN + (size_t)ZP * DM * 2 <= WS_WOUT && WS_WM2 + (size_t)DM * FF * 2 <= WS_WUQ && WS_WUQ + 768 * 384 * 2 <= WS_WUK, "weights map");
static_assert(WS_AY + (size_t)RT * DM * 2 <= WS_X && WS_X + (size_t)RT * DM * 4 <= WS_ZH && WS_ZH + (size_t)RT * FF * 2 <= WS_GQKV, "act map");
static_assert(WS_GQKV + (size_t)RT * 1536 * 2 <= WS_QN && WS_QN + (size_t)RT * 384 * 2 <= WS_CKVN && WS_CKVN + (size_t)RT * 256 * 2 <= WS_MQ && WS_MQ + (size_t)RT * 768 * 2 <= WS_MK, "mixer map");
static_assert(WS_MK + (size_t)RT * 512 * 2 <= WS_MVT && WS_MVT + (size_t)RT * 512 * 2 <= WS_NAVT && WS_NAVT + (size_t)RT * 512 * 2 <= WS_KROPE && WS_KROPE + (size_t)RT * 64 * 2 <= WS_GB && WS_GB + (size_t)RT * 16 * 4 <= WS_END, "mixer map 2");
constexpr size_t OUT_OG = 0, OUT_OH = 34 * MiB, OUT_GT = 68 * MiB, OUT_HKE = 102 * MiB;
static_assert(OUT_OH + (size_t)2 * RT * 512 * 2 <= OUT_GT && OUT_GT + (size_t)2176 * 2 * 8192 <= OUT_HKE && OUT_HKE + (size_t)1664 * 16384 <= (size_t)NLAT * DM * 4, "d_out scratch");

constexpr int LDS_BYTES = 147456;

__device__ __forceinline__ float bf2f(unsigned short u) { return __builtin_bit_cast(float, (unsigned)u << 16); }
__device__ __forceinline__ float bflo(unsigned w) { return __builtin_bit_cast(float, w << 16); }
__device__ __forceinline__ float bfhi(unsigned w) { return __builtin_bit_cast(float, w & 0xffff0000u); }
__device__ __forceinline__ unsigned f2bf(float f) { unsigned u = __builtin_bit_cast(unsigned, f); return (u + 0x7fffu + ((u >> 16) & 1u)) >> 16; }
__device__ __forceinline__ unsigned pk2(float lo, float hi) { return f2bf(lo) | (f2bf(hi) << 16); }
__device__ __forceinline__ float wave_sum(float v) {
#pragma unroll
    for (int o = 1; o < 64; o <<= 1) v += __shfl_xor(v, o);
    return v;
}
__device__ __forceinline__ float sigmoidf_(float x) { return __builtin_amdgcn_rcpf(1.f + __expf(-x)); }
__device__ __forceinline__ float siluf_(float x) { return x * __builtin_amdgcn_rcpf(1.f + __expf(-x)); }
#define LDS_WAIT() asm volatile("s_waitcnt vmcnt(0) lgkmcnt(0)" ::: "memory")
#define LDS_BARRIER() do { asm volatile("s_waitcnt lgkmcnt(0)" ::: "memory"); __builtin_amdgcn_s_barrier(); asm volatile("" ::: "memory"); } while (0)

namespace pg8 {
#define PG8_LAS __attribute__((address_space(3)))
typedef unsigned short bf16_t;
typedef short bf16x8 __attribute__((ext_vector_type(8)));
typedef float f32x4 __attribute__((ext_vector_type(4)));
typedef unsigned u32x4 __attribute__((ext_vector_type(4)));
constexpr int BM = 256, BK = 64, HALF = 128, HTB = HALF * BK * 2  , STAGE_BYTES = 8 * HTB, NXCD = 8, WGM = 8;

__host__ __device__ __forceinline__ int lds_byte(int r, int c) { const int st = (r >> 4) * 2 + (c >> 5), rr = r & 15, cc = c & 31, ob = rr * 64 + cc * 2; return st * 1024 + (ob ^ (((ob >> 9) & 1) << 5)); }
__host__ __device__ __forceinline__ void stage_rc(int b, int& R, int& C) { const int st = b / 1024, sb = b % 1024, swz = sb ^ (((sb >> 9) & 1) << 5); R = (st >> 1) * 16 + swz / 64; C = (st & 1) * 32 + (swz % 64) / 2; }
__host__ __device__ __forceinline__ int perm32(int rho) { const int n = rho >> 4, i = rho & 15; return 8 * (i >> 2) + 4 * n + (i & 3); }

struct Unit { int pm, pn, ks; };
struct Gemm { const bf16_t* A; const bf16_t* Bt; int M, N, K, lda, ldb; };

struct StaticOrder {
    int nM, nN, nwg, G, c;
    __host__ __device__ void init(int M, int N, int G_, int c_) { nM = M / BM; nN = N / BM; nwg = nM * nN; G = G_; c = c_; }
    __host__ __device__ bool next(int i, Unit& u) const {
        const long L = (long)i * G + c; if (L >= nwg) return false;
        int wgid = (int)L; { const int q = nwg / NXCD, r = nwg % NXCD, xcd = wgid % NXCD, off = wgid / NXCD; wgid = (xcd < r ? xcd * (q + 1) : r * (q + 1) + (xcd - r) * q) + off; }
        const int nig = WGM * nN, gid = wgid / nig, fm = gid * WGM, gsz = (nM - fm) < WGM ? (nM - fm) : WGM;
        u.pm = fm + ((wgid % nig) % gsz); u.pn = (wgid % nig) / gsz; u.ks = 0; return true;
    }
    __device__ __forceinline__ void a_ready(const Unit&) const {}
    __device__ __forceinline__ void done(const Unit&) const {}
};

struct SplitKOrder {
    int nM, nN, KS, nwg, G, c;
    __host__ __device__ void init(int M, int N, int KS_, int G_, int c_) { nM = M / BM; nN = N / BM; KS = KS_; nwg = nM * nN * KS; G = G_; c = c_; }
    __host__ __device__ bool next(int i, Unit& u) const {
        const long L = (long)i * G + c; if (L >= nwg) return false;
        const int t = (int)L; u.ks = t % KS; const int r = t / KS; u.pm = r % nM; u.pn = r / nM; return true;
    }
    __device__ __forceinline__ void a_ready(const Unit&) const {}
    __device__ __forceinline__ void done(const Unit&) const {}
};

template <class Epi, class Sched, bool ALIGN_EPI = false, bool SP2 = false>
__device__ __forceinline__ void gemm_phase(PG8_LAS unsigned char* lds, const Gemm g, const Sched& S, const Epi& E) {
    int tid_ = threadIdx.x; asm volatile("" : "+v"(tid_));
    const int tid = tid_, wid = __builtin_amdgcn_readfirstlane(tid >> 6), lane = tid & 63, wr = wid >> 2, wc = wid & 3, fr = lane & 15, fq = lane >> 4;
    const int K = g.K, nt = K / BK;
    unsigned voffA[2], voffB[2];
#pragma unroll
    for (int i = 0; i < 2; ++i) { int R, C; stage_rc(tid * 16 + i * 8192, R, C); const int Rb = Epi::PERM ? ((R & ~31) + perm32(R & 31)) : R;
        voffA[i] = (unsigned)(R * g.lda + C) * 2u; voffB[i] = (unsigned)(Rb * g.ldb + C) * 2u; }
    const size_t kstep = (size_t)(BK * 2);
    const size_t hstepA = (size_t)HALF * g.lda * 2, hstepB = (size_t)HALF * g.ldb * 2;
    const size_t tstepA = 2 * hstepA, tstepB = 2 * hstepB, sstep = (size_t)K * 2;
    const unsigned ldsw = (unsigned)wid * 1024u;
    const int aoff = lds_byte(wr * 64 + fr, fq * 8), boff = lds_byte(wc * 32 + fr, fq * 8);
#define PG8_SA(b, h) (((b) * 2 + (h)) * HTB)
#define PG8_SB(b, h) ((4 + (b) * 2 + (h)) * HTB)
#define PG8_STAGE(bufoff, gbase, voff) do { _Pragma("unroll") for (int _i = 0; _i < 2; ++_i) \
        __builtin_amdgcn_global_load_lds((const unsigned*)((const char*)(gbase) + (voff)[_i]), (PG8_LAS unsigned*)(lds + (bufoff) + ldsw + _i * 8192), 16, 0, 0); } while (0)
#define PG8_LDA(dst, b, h) do { _Pragma("unroll") for (int m = 0; m < 4; ++m) _Pragma("unroll") for (int k = 0; k < 2; ++k) dst[m][k] = *(const PG8_LAS bf16x8*)(lds + PG8_SA(b, h) + aoff + m * 2048 + k * 1024); } while (0)
#define PG8_LDB(dst, b, h) do { _Pragma("unroll") for (int n = 0; n < 2; ++n) _Pragma("unroll") for (int k = 0; k < 2; ++k) dst[n][k] = *(const PG8_LAS bf16x8*)(lds + PG8_SB(b, h) + boff + n * 2048 + k * 1024); } while (0)
#define PG8_MMA(ai, bj, At, Bt) do { __builtin_amdgcn_s_setprio(1); _Pragma("unroll") for (int m = 0; m < 4; ++m) _Pragma("unroll") for (int n = 0; n < 2; ++n) _Pragma("unroll") for (int k = 0; k < 2; ++k) \
        acc[ai][bj][m][n] = __builtin_amdgcn_mfma_f32_16x16x32_bf16(Bt[n][k], At[m][k], acc[ai][bj][m][n], 0, 0, 0); __builtin_amdgcn_s_setprio(0); } while (0)
#define PG8_WAIT_V(n) asm volatile("s_waitcnt vmcnt(" #n ")" ::: "memory")
#define PG8_WAIT_L(n) asm volatile("s_waitcnt lgkmcnt(" #n ")" ::: "memory")
#define PG8_BAR __builtin_amdgcn_s_barrier()
#define PG8_SCHED __builtin_amdgcn_sched_barrier(0)
    Unit cur, nxt; int ui = 0;
    if (!S.next(0, cur)) return;
    f32x4 acc[2][2][4][2];
#pragma unroll
    for (int a = 0; a < 2; ++a)
#pragma unroll
        for (int b = 0; b < 2; ++b)
#pragma unroll
            for (int m = 0; m < 4; ++m)
#pragma unroll
                for (int n = 0; n < 2; ++n) acc[a][b][m][n] = (f32x4){0.f, 0.f, 0.f, 0.f};
    bf16x8 At[4][2], B0[2][2], B1[2][2];
    const char* cA = (const char*)g.A + (size_t)cur.pm * tstepA + (size_t)cur.ks * sstep; const char* cB = (const char*)g.Bt + (size_t)cur.pn * tstepB + (size_t)cur.ks * sstep;
    S.a_ready(cur);
    if constexpr (SP2) {
        PG8_STAGE(PG8_SB(0, 0), cB, voffB); PG8_STAGE(PG8_SB(0, 1), cB + hstepB, voffB); PG8_STAGE(PG8_SA(0, 0), cA, voffA); PG8_STAGE(PG8_SA(0, 1), cA + hstepA, voffA);
        if (wr == 1) PG8_BAR;
        PG8_WAIT_V(2); PG8_BAR;
        PG8_STAGE(PG8_SB(1, 0), cB + kstep, voffB); PG8_STAGE(PG8_SA(1, 0), cA + kstep, voffA); PG8_STAGE(PG8_SB(1, 1), cB + hstepB + kstep, voffB);
        PG8_WAIT_V(6); PG8_BAR;
    } else {
        PG8_STAGE(PG8_SB(0, 0), cB, voffB); PG8_STAGE(PG8_SA(0, 0), cA, voffA); PG8_STAGE(PG8_SB(0, 1), cB + hstepB, voffB); PG8_STAGE(PG8_SA(0, 1), cA + hstepA, voffA);
        if (wr == 1) PG8_BAR;
        PG8_WAIT_V(4); PG8_BAR;
        PG8_STAGE(PG8_SB(1, 0), cB + kstep, voffB); PG8_STAGE(PG8_SA(1, 0), cA + kstep, voffA); PG8_STAGE(PG8_SB(1, 1), cB + hstepB + kstep, voffB);
        PG8_WAIT_V(6); PG8_BAR;
    }
    for (;;) {
        const bool has_next = S.next(ui + 1, nxt);
        const char* nA = has_next ? (const char*)g.A + (size_t)nxt.pm * tstepA + (size_t)nxt.ks * sstep : cA; const char* nB = has_next ? (const char*)g.Bt + (size_t)nxt.pn * tstepB + (size_t)nxt.ks * sstep : cB;
        for (int t = 0; t < nt; t += 2) {
            const bool last = (t == nt - 2);
            const char* a1 = cA + (size_t)(t + 1) * kstep;
            const char* a2 = last ? nA : cA + (size_t)(t + 2) * kstep; const char* b2 = last ? nB : cB + (size_t)(t + 2) * kstep;
            const char* a3 = a2 + kstep; const char* b3 = b2 + kstep;
            if (last && has_next) S.a_ready(nxt);
            if constexpr (SP2) {
            PG8_LDB(B0, 0, 0); PG8_LDB(B1, 0, 1); PG8_SCHED; PG8_LDA(At, 0, 0); PG8_STAGE(PG8_SA(1, 1), a1 + hstepA, voffA);
            PG8_WAIT_V(8); PG8_WAIT_L(0); PG8_BAR; PG8_MMA(0, 0, At, B0); PG8_MMA(0, 1, At, B1); PG8_BAR; PG8_SCHED;
            PG8_LDA(At, 0, 1); PG8_STAGE(PG8_SB(0, 0), b2, voffB); PG8_STAGE(PG8_SB(0, 1), b2 + hstepB, voffB); PG8_STAGE(PG8_SA(0, 0), a2, voffA);
            PG8_WAIT_V(8); PG8_WAIT_L(0); PG8_BAR; PG8_MMA(1, 0, At, B0); PG8_MMA(1, 1, At, B1); PG8_BAR; PG8_SCHED;
            PG8_LDB(B0, 1, 0); PG8_LDB(B1, 1, 1); PG8_SCHED; PG8_LDA(At, 1, 0); PG8_STAGE(PG8_SA(0, 1), a2 + hstepA, voffA);
            PG8_WAIT_V(8); PG8_WAIT_L(0); PG8_BAR; PG8_MMA(0, 0, At, B0); PG8_MMA(0, 1, At, B1); PG8_BAR; PG8_SCHED;
            PG8_LDA(At, 1, 1); PG8_STAGE(PG8_SB(1, 0), b3, voffB); PG8_STAGE(PG8_SB(1, 1), b3 + hstepB, voffB); PG8_STAGE(PG8_SA(1, 0), a3, voffA);
            PG8_WAIT_V(8); PG8_WAIT_L(0); PG8_BAR; PG8_MMA(1, 0, At, B0); PG8_MMA(1, 1, At, B1); PG8_BAR; PG8_SCHED;
            } else {
            PG8_LDB(B0, 0, 0); PG8_SCHED; PG8_LDA(At, 0, 0); PG8_STAGE(PG8_SA(1, 1), a1 + hstepA, voffA);
            PG8_WAIT_L(8); PG8_BAR; PG8_WAIT_L(0); PG8_MMA(0, 0, At, B0); PG8_BAR; PG8_SCHED;
            PG8_LDB(B1, 0, 1); PG8_STAGE(PG8_SB(0, 0), b2, voffB);
            PG8_BAR; PG8_WAIT_L(0); PG8_MMA(0, 1, At, B1); PG8_BAR;
            PG8_LDA(At, 0, 1); PG8_STAGE(PG8_SA(0, 0), a2, voffA);
            PG8_BAR; PG8_WAIT_L(0); PG8_MMA(1, 0, At, B0); PG8_BAR; PG8_SCHED;
            PG8_STAGE(PG8_SB(0, 1), b2 + hstepB, voffB);
            PG8_WAIT_V(6); PG8_BAR; PG8_MMA(1, 1, At, B1); PG8_BAR;
            PG8_LDB(B0, 1, 0); PG8_SCHED; PG8_LDA(At, 1, 0); PG8_STAGE(PG8_SA(0, 1), a2 + hstepA, voffA);
            PG8_WAIT_L(8); PG8_BAR; PG8_WAIT_L(0); PG8_MMA(0, 0, At, B0); PG8_BAR; PG8_SCHED;
            PG8_LDB(B1, 1, 1); PG8_STAGE(PG8_SB(1, 0), b3, voffB);
            PG8_BAR; PG8_WAIT_L(0); PG8_MMA(0, 1, At, B1); PG8_BAR;
            PG8_LDA(At, 1, 1); PG8_STAGE(PG8_SA(1, 0), a3, voffA);
            PG8_BAR; PG8_WAIT_L(0); PG8_MMA(1, 0, At, B0); PG8_BAR; PG8_SCHED;
            PG8_STAGE(PG8_SB(1, 1), b3 + hstepB, voffB);
            PG8_WAIT_V(6); PG8_BAR; PG8_MMA(1, 1, At, B1); PG8_BAR;
            }
        }
        if constexpr (ALIGN_EPI) { if (wr == 0) PG8_BAR; }
        if constexpr (!Epi::AFTER_DRAIN) { E(acc, cur, wr, wc, fr, fq); S.done(cur); }
        if (!has_next) break;
#pragma unroll
        for (int a = 0; a < 2; ++a)
#pragma unroll
            for (int b = 0; b < 2; ++b)
#pragma unroll
                for (int m = 0; m < 4; ++m)
#pragma unroll
                    for (int n = 0; n < 2; ++n) acc[a][b][m][n] = (f32x4){0.f, 0.f, 0.f, 0.f};
        cur = nxt; cA = nA; cB = nB; ++ui;
        if constexpr (ALIGN_EPI) { if (wr == 1) PG8_BAR; }
    }
    PG8_WAIT_V(0);
    if constexpr (!ALIGN_EPI) { if (wr == 0) PG8_BAR; }
    PG8_BAR;
    if constexpr (Epi::AFTER_DRAIN) { E.fused(acc, cur, wr, wc, fr, fq, lds, wid, lane); S.done(cur); }
#undef PG8_SA
#undef PG8_SB
#undef PG8_STAGE
#undef PG8_LDA
#undef PG8_LDB
#undef PG8_MMA
#undef PG8_WAIT_V
#undef PG8_WAIT_L
#undef PG8_BAR
#undef PG8_SCHED
}
}

namespace pg8 {
__device__ __forceinline__ unsigned cvt_pk_bf16(float lo, float hi) { unsigned r; asm volatile("v_cvt_pk_bf16_f32 %0, %1, %2" : "=v"(r) : "v"(lo), "v"(hi)); return r; }
template <int ACT> struct EpiStore {
    static constexpr bool PERM = true, AFTER_DRAIN = false;
    bf16_t* O; int ldc;
    __device__ __forceinline__ void operator()(const f32x4 (&acc)[2][2][4][2], const Unit& u, int wr, int wc, int fr, int fq) const {
        const int row0 = u.pm * BM + wr * 64 + fr, col0 = u.pn * BM + wc * 32 + 8 * fq;
#pragma unroll
        for (int ai = 0; ai < 2; ++ai)
#pragma unroll
            for (int m = 0; m < 4; ++m) { bf16_t* rowp = O + (size_t)(row0 + ai * HALF + m * 16) * ldc + col0;
#pragma unroll
                for (int bj = 0; bj < 2; ++bj) { f32x4 v0 = acc[ai][bj][m][0], v1 = acc[ai][bj][m][1];
                    if (ACT == 1) {
#pragma unroll
                        for (int j = 0; j < 4; ++j) { float a = fmaxf(v0[j], 0.f), b = fmaxf(v1[j], 0.f); v0[j] = a * a; v1[j] = b * b; } }
                    u32x4 w; w.x = cvt_pk_bf16(v0[0], v0[1]); w.y = cvt_pk_bf16(v0[2], v0[3]); w.z = cvt_pk_bf16(v1[0], v1[1]); w.w = cvt_pk_bf16(v1[2], v1[3]);
                    *(u32x4*)(rowp + bj * HALF) = w; } }
    }
};
struct EpiResid {
    static constexpr bool PERM = false, AFTER_DRAIN = false;
    const float* xlat; const float* xctx; float* out; const float* gbase; float alpha;
    __device__ __forceinline__ void operator()(const f32x4 (&acc)[2][2][4][2], const Unit& u, int wr, int wc, int fr, int fq) const {
#pragma unroll
        for (int ai = 0; ai < 2; ++ai)
#pragma unroll
            for (int m = 0; m < 4; ++m) {
                const int row = u.pm * BM + ai * HALF + wr * 64 + m * 16 + fr;
                const int v = row < NLAT ? (row >> 12) : 4;
                const float* xin = row < NLAT ? xlat + (size_t)row * DM : xctx + (size_t)(row - NLAT) * DM;
                const float* g = gbase + (size_t)v * ADAW;
                float* op = out + (size_t)row * DM;
#pragma unroll
                for (int bj = 0; bj < 2; ++bj)
#pragma unroll
                    for (int n = 0; n < 2; ++n) { const int col = u.pn * BM + bj * HALF + wc * 32 + n * 16 + fq * 4;
                        const f32x4 x4 = *(const f32x4*)(xin + col), g4 = *(const f32x4*)(g + col);
                        *(f32x4*)(op + col) = x4 * alpha + g4 * acc[ai][bj][m][n]; }
            }
    }
};
struct EpiCtxSplit {
    static constexpr bool PERM = false, AFTER_DRAIN = false;
    float* out; float* part; const float* g;
    __device__ __forceinline__ void operator()(const f32x4 (&acc)[2][2][4][2], const Unit& u, int wr, int wc, int fr, int fq) const {
#pragma unroll
        for (int ai = 0; ai < 2; ++ai)
#pragma unroll
            for (int m = 0; m < 4; ++m) {
                const size_t ro = (size_t)(u.pm * BM + ai * HALF + wr * 64 + m * 16 + fr) * DM;
#pragma unroll
                for (int bj = 0; bj < 2; ++bj)
#pragma unroll
                    for (int n = 0; n < 2; ++n) { const int col = u.pn * BM + bj * HALF + wc * 32 + n * 16 + fq * 4; const f32x4 v = *(const f32x4*)(g + col) * acc[ai][bj][m][n];
                        if (u.ks == 0) *(f32x4*)(out + ro + col) = *(const f32x4*)(out + ro + col) + v; else *(f32x4*)(part + ro + col) = v; }
            }
    }
};
}

struct Args { const float* in[26]; float* out; unsigned char* ws; };
typedef const float* cfp_t;
typedef const __attribute__((address_space(4))) cfp_t* kargp_t;
struct Fr {
    kargp_t kp; float* out; unsigned char* ws; unsigned char* lds;
    int tid, lane, wave, G, gw, NGW;
};
__device__ __forceinline__ const float* inp(const Fr& F, int k) { kargp_t p = F.kp; asm volatile("" : "+s"(p)); return p[k]; }
#define WSP(T, off) ((T*)(F.ws + (off)))
__device__ __forceinline__ Fr RL(const Fr& F0) { Fr F = F0; int t = threadIdx.x; asm volatile("" : "+v"(t)); F.tid = t; F.lane = t & 63; F.wave = __builtin_amdgcn_readfirstlane(t >> 6); F.gw = blockIdx.x * 8 + F.wave; return F; }

__device__ __forceinline__ void phase_ada(const Fr& F) {
    float* sl = (float*)F.lds;
    float* red = sl + 5 * 2048;
    float* ADA = WSP(float, WS_ADA);
    const float* p_c = inp(F, 1); const float* p_cc = inp(F, 3); const float* p_wada = inp(F, 4); const float* p_bada = inp(F, 5);
    for (int i = F.tid; i < 5 * 2048; i += 512) { const float c = (i < 4 * 2048) ? p_c[i] : p_cc[i - 4 * 2048]; sl[i] = siluf_(c); }
    __syncthreads();
    for (int it = blockIdx.x; it < 2 * 384; it += F.G) {
        const int l = it / 384, n0 = (it % 384) * 32, c4 = (F.tid & 7) * 4, ks = F.tid >> 3;
        const float* W = p_wada + (size_t)l * DM * ADAW + n0 + c4;
        f32x4 a0 = (f32x4){0.f, 0.f, 0.f, 0.f}, a1 = a0, a2 = a0, a3 = a0, a4 = a0;
        const int k0 = ks * 32;
#pragma unroll 16
        for (int k = 0; k < 32; ++k) { const f32x4 wv = *(const f32x4*)(W + (size_t)(k0 + k) * ADAW);
            a0 += wv * sl[k0 + k]; a1 += wv * sl[2048 + k0 + k]; a2 += wv * sl[4096 + k0 + k]; a3 += wv * sl[6144 + k0 + k]; a4 += wv * sl[8192 + k0 + k]; }
        *(f32x4*)(red + (ks * 5 + 0) * 32 + c4) = a0; *(f32x4*)(red + (ks * 5 + 1) * 32 + c4) = a1; *(f32x4*)(red + (ks * 5 + 2) * 32 + c4) = a2;
        *(f32x4*)(red + (ks * 5 + 3) * 32 + c4) = a3; *(f32x4*)(red + (ks * 5 + 4) * 32 + c4) = a4;
        __syncthreads();
        if (F.tid < 160) { const int v = F.tid >> 5, ln = F.tid & 31; float s = 0.f;
#pragma unroll 16
            for (int ww = 0; ww < 64; ++ww) s += red[(ww * 5 + v) * 32 + ln];
            ADA[((size_t)l * 5 + v) * ADAW + n0 + ln] = s + p_bada[(size_t)l * ADAW + n0 + ln]; }
        __syncthreads();
    }
    {
        f32x2* RP = WSP(f32x2, WS_ROPE);
        for (int e = blockIdx.x * 512 + F.tid; e < SEQ * 32; e += F.G * 512) { const int t = e >> 5, i = e & 31; const int pos = i < 16 ? (t >> 6) : (t & 63);
            const float freq = exp2f(-(float)(i & 15) * 0.8304820237218406f)  ; float sn, cs; sincosf((float)pos * freq, &sn, &cs); RP[e] = (f32x2){cs, sn}; }
    }
}

__device__ __forceinline__ void transpose_item(const float* W, int K, int N, int NP, bf16* WT, float* scr, int item, int lane) {
    const int nblk = NP / 32, kb = item / nblk, nb = item % nblk, k0 = 64 * kb, n0 = 32 * nb;
    const int l8 = lane & 7, kr = lane >> 3, nn = n0 + 4 * l8; const bool ok = nn < N;
    f32x4 wv[8];
#pragma unroll
    for (int i = 0; i < 8; ++i) { const int kk = 8 * i + kr; wv[i] = ok ? *(const f32x4*)(W + (size_t)(k0 + kk) * N + nn) : (f32x4){0.f, 0.f, 0.f, 0.f}; }
#pragma unroll
    for (int i = 0; i < 8; ++i) { const int kk = 8 * i + kr; float* d = scr + kk * 33 + 4 * l8; d[0] = wv[i][0]; d[1] = wv[i][1]; d[2] = wv[i][2]; d[3] = wv[i][3]; }
    LDS_WAIT();
    const int c = lane & 7;
#pragma unroll
    for (int j = 0; j < 4; ++j) { const int n = (lane >> 3) + 8 * j; const float* s = scr + (8 * c) * 33 + n;
        v4u o; o.x = pk2(s[0 * 33], s[1 * 33]); o.y = pk2(s[2 * 33], s[3 * 33]); o.z = pk2(s[4 * 33], s[5 * 33]); o.w = pk2(s[6 * 33], s[7 * 33]);
        *(v4u*)(WT + (size_t)(n0 + n) * K + k0 + 8 * c) = o; }
    LDS_WAIT();
}
__device__ __forceinline__ void phase_wconv(const Fr& F, int l, int mode, int w0, int nw) {
    float* scr = (float*)F.lds + F.wave * (64 * 33);
    constexpr int I_IN = 32 * 216, I_OUT = 32 * 64, I_M1 = 32 * 256, I_M2 = 128 * 64, I_UQ = 6 * 24, I_UK = 4 * 16, I_UV = 4 * 16;
    constexpr int NIT = I_IN + I_OUT + I_M1 + I_M2 + I_UQ + I_UK + I_UV;
    for (int q = w0; ; q += nw) {
        int it;
        if (mode == 0) { if (q >= I_IN + I_UQ + I_UK + I_UV) break; it = q < I_IN ? q : q + I_OUT + I_M1 + I_M2; }
        else { if (q >= I_OUT + I_M1 + I_M2) break; it = I_IN + q; }
        int r = it;
        if (r < I_IN) { transpose_item(inp(F, 6) + (size_t)l * DM * ZC, DM, ZC, ZP, WSP(bf16, WS_WIN), scr, r, F.lane); continue; } r -= I_IN;
        if (r < I_OUT) { transpose_item(inp(F, 19) + (size_t)l * DM * DM, DM, DM, DM, WSP(bf16, WS_WOUT), scr, r, F.lane); continue; } r -= I_OUT;
        if (r < I_M1) { transpose_item(inp(F, 22) + (size_t)l * DM * FF, DM, FF, FF, WSP(bf16, WS_WM1), scr, r, F.lane); continue; } r -= I_M1;
        if (r < I_M2) { transpose_item(inp(F, 23) + (size_t)l * FF * DM, FF, DM, DM, WSP(bf16, WS_WM2), scr, r, F.lane); continue; } r -= I_M2;
        if (r < I_UQ) { transpose_item(inp(F, 14) + (size_t)l * 384 * 768, 384, 768, 768, WSP(bf16, WS_WUQ), scr, r, F.lane); continue; } r -= I_UQ;
        if (r < I_UK) { transpose_item(inp(F, 15) + (size_t)l * 256 * 512, 256, 512, 512, WSP(bf16, WS_WUK), scr, r, F.lane); continue; } r -= I_UK;
        transpose_item(inp(F, 16) + (size_t)l * 256 * 512, 256, 512, 512, WSP(bf16, WS_WUV), scr, r, F.lane);
    }
}

__device__ __forceinline__ void phase_mod0(const Fr& F) {
    const float* ADA = WSP(float, WS_ADA); bf16* AY = WSP(bf16, WS_AY);
    const float* p_x = inp(F, 0); const float* p_ctx = inp(F, 2);
    f32x4 xv[8], xn[8];
    if (F.gw < RT) { const float* xr = F.gw < NLAT ? p_x + (size_t)F.gw * DM : p_ctx + (size_t)(F.gw - NLAT) * DM;
#pragma unroll
        for (int j = 0; j < 8; ++j) xv[j] = *(const f32x4*)(xr + j * 256 + F.lane * 4); }
    for (int row = F.gw; row < RT; row += F.NGW) {
        { const int rn = row + F.NGW; if (rn < RT) { const float* xr = rn < NLAT ? p_x + (size_t)rn * DM : p_ctx + (size_t)(rn - NLAT) * DM;
#pragma unroll
            for (int j = 0; j < 8; ++j) xn[j] = *(const f32x4*)(xr + j * 256 + F.lane * 4); } }
        const int v = row < NLAT ? (row >> 12) : 4;
        const float* sh = ADA + (size_t)v * ADAW; const float* sc = sh + 2048;
#pragma unroll
        for (int j = 0; j < 8; ++j) { const int col = j * 256 + F.lane * 4;
            const f32x4 x = xv[j], s1 = *(const f32x4*)(sc + col), s0 = *(const f32x4*)(sh + col);
            const f32x4 y = x * (s1 + 1.f) + s0;
            v2u o; o.x = pk2(y[0], y[1]); o.y = pk2(y[2], y[3]);
            *(v2u*)(AY + (size_t)row * DM + col) = o;
            if (row >= NLAT) *(f32x4*)(WSP(float, WS_X) + (size_t)row * DM + col) = x * ALPHA_RES; }
#pragma unroll
        for (int j = 0; j < 8; ++j) xv[j] = xn[j];
    }
}

__device__ __forceinline__ void phase_ln(const Fr& F, int l, int which, int nrows) {
    const float* ADA = WSP(float, WS_ADA); bf16* AY = WSP(bf16, WS_AY); float* X = WSP(float, WS_X);
    const float* lw = (which == 1 ? inp(F, 20) : inp(F, 24)) + (size_t)l * DM; const float* lb = (which == 1 ? inp(F, 21) : inp(F, 25)) + (size_t)l * DM;
    const bool last = (which == 2 && l == 1);
    const size_t aoff = which == 1 ? ((size_t)l * 5 * ADAW + 3 * 2048) : ((size_t)(l + 1) * 5 * ADAW);
    f32x4 v[8], vn[8];
    if (F.gw < nrows) {
#pragma unroll
        for (int j = 0; j < 8; ++j) v[j] = *(const f32x4*)(X + (size_t)F.gw * DM + j * 256 + F.lane * 4); }
    for (int row = F.gw; row < nrows; row += F.NGW) {
        float* xr = X + (size_t)row * DM;
        if (row + F.NGW < nrows) {
#pragma unroll
            for (int j = 0; j < 8; ++j) vn[j] = *(const f32x4*)(xr + (size_t)F.NGW * DM + j * 256 + F.lane * 4); }
        float s = 0.f;
#pragma unroll
        for (int j = 0; j < 8; ++j) {
            if (which == 2 && l == 0 && row >= NLAT) v[j] = v[j] + *(const f32x4*)(WSP(float, WS_PART) + (size_t)(row - NLAT) * DM + j * 256 + F.lane * 4);
            s += (v[j][0] + v[j][1]) + (v[j][2] + v[j][3]); }
        const float mean = wave_sum(s) * (1.f / DM); float s2 = 0.f;
#pragma unroll
        for (int j = 0; j < 8; ++j) { v[j] = v[j] - mean; s2 += (v[j][0] * v[j][0] + v[j][1] * v[j][1]) + (v[j][2] * v[j][2] + v[j][3] * v[j][3]); }
        const float rstd = 1.f / sqrtf(wave_sum(s2) * (1.f / DM) + 1e-5f);
        const int vi = row < NLAT ? (row >> 12) : 4;
        const float* sh = ADA + aoff + (size_t)vi * ADAW; const float* sc = sh + 2048;
#pragma unroll
        for (int j = 0; j < 8; ++j) { const int col = j * 256 + F.lane * 4;
            const f32x4 y = v[j] * rstd * *(const f32x4*)(lw + col) + *(const f32x4*)(lb + col);
            if (last) { *(f32x4*)(F.out + (size_t)row * DM + col) = y; }
            else { *(f32x4*)(xr + col) = (which == 1) ? y * ALPHA_RES : y;
                const f32x4 a = y * (*(const f32x4*)(sc + col) + 1.f) + *(const f32x4*)(sh + col);
                v2u o; o.x = pk2(a[0], a[1]); o.y = pk2(a[2], a[3]);
                *(v2u*)(AY + (size_t)row * DM + col) = o; }
        }
#pragma unroll
        for (int j = 0; j < 8; ++j) v[j] = vn[j];
    }
}

__device__ __forceinline__ void phase_prep(const Fr& F, int l) {
    const bf16* Z = WSP(bf16, WS_ZH); bf16* GQKV = WSP(bf16, WS_GQKV); float* GB = WSP(float, WS_GB);
    bf16* QN = WSP(bf16, WS_QN); bf16* CKVN = WSP(bf16, WS_CKVN); bf16* KROPE = WSP(bf16, WS_KROPE);
    const float* cw = inp(F, 7) + (size_t)l * 5 * 1536;
    const float* p_alog = inp(F, 8); const float* p_dtb = inp(F, 9); const float* p_qnw = inp(F, 12); const float* p_kvnw = inp(F, 13);
    f32x4 cwr[3][5][2];
#pragma unroll
    for (int g = 0; g < 3; ++g)
#pragma unroll
        for (int i = 0; i < 5; ++i) { cwr[g][i][0] = *(const f32x4*)(cw + i * 1536 + g * 512 + F.lane * 8); cwr[g][i][1] = *(const f32x4*)(cw + i * 1536 + g * 512 + F.lane * 8 + 4); }
    for (int row = F.gw; row < RT; row += F.NGW) {
        const bf16* zr = Z + (size_t)row * ZP;
#pragma unroll
      for (int g = 0; g < 4; ++g) {
        if (g < 3) {
            int t, len; if (row < NLAT) { t = row & 4095; len = SEQ; } else { t = (row - NLAT) & 255; len = CTX; }
            const int c0 = g * 512 + F.lane * 8;
            float acc[8];
#pragma unroll
            for (int j = 0; j < 8; ++j) acc[j] = 0.f;
#pragma unroll
            for (int i = 0; i < 5; ++i) { const int tt = t + i - 2; const bool okt = (tt >= 0 && tt < len);
                {
                    v4u zv = *(const v4u*)(zr + (okt ? (ptrdiff_t)(i - 2) * ZP : (ptrdiff_t)0) + c0); if (!okt) zv = (v4u){0u, 0u, 0u, 0u};
                    const f32x4 w0 = cwr[g][i][0], w1 = cwr[g][i][1];
                    acc[0] += bflo(zv.x) * w0[0]; acc[1] += bfhi(zv.x) * w0[1]; acc[2] += bflo(zv.y) * w0[2]; acc[3] += bfhi(zv.y) * w0[3];
                    acc[4] += bflo(zv.z) * w1[0]; acc[5] += bfhi(zv.z) * w1[1]; acc[6] += bflo(zv.w) * w1[2]; acc[7] += bfhi(zv.w) * w1[3]; } }
            float ss = 0.f;
#pragma unroll
            for (int j = 0; j < 8; ++j) { acc[j] = siluf_(acc[j]); ss += acc[j] * acc[j]; }
            if (g < 2) {
                ss += __shfl_xor(ss, 1); ss += __shfl_xor(ss, 2); ss += __shfl_xor(ss, 4); ss += __shfl_xor(ss, 8);
                float inv = 1.f / sqrtf(ss + 1e-6f); if (g == 0) inv *= 0.08838834764831845f;
#pragma unroll
                for (int j = 0; j < 8; ++j) acc[j] *= inv;
            }
            v4u o; o.x = pk2(acc[0], acc[1]); o.y = pk2(acc[2], acc[3]); o.z = pk2(acc[4], acc[5]); o.w = pk2(acc[6], acc[7]);
            *(v4u*)(GQKV + (size_t)row * 1536 + c0) = o;
            if (g == 0 && F.lane < 16) {
                float r;
                if (F.lane < 8) { const float a = bf2f(zr[2048 + F.lane]); const float x = a + p_dtb[l * 8 + F.lane];
                    const float ee = __expf(-fabsf(x)); const float l1p = (ee < 0.03f) ? ee * (1.f - ee * (0.5f - ee * 0.33333333f)) : __logf(1.f + ee); const float sp = fmaxf(x, 0.f) + l1p;     r = -__expf(p_alog[l * 8 + F.lane]) * sp; }
                else r = sigmoidf_(bf2f(zr[2056 + F.lane - 8]));
                GB[(size_t)row * 16 + F.lane] = r;
            }
        } else {
            {
                const unsigned* p = (const unsigned*)(zr + C_MLA + F.lane * 6); const unsigned w0 = p[0], w1 = p[1], w2 = p[2];
                float x[6] = {bflo(w0), bfhi(w0), bflo(w1), bfhi(w1), bflo(w2), bfhi(w2)};
                float ss = 0.f;
#pragma unroll
                for (int j = 0; j < 6; ++j) ss += x[j] * x[j];
                const float inv = 1.f / sqrtf(wave_sum(ss) * (1.f / 384.f) + 1e-6f);
                const float* nw = p_qnw + l * 384 + F.lane * 6;
                unsigned* q = (unsigned*)(QN + (size_t)row * 384 + F.lane * 6);
                q[0] = pk2(x[0] * inv * nw[0], x[1] * inv * nw[1]); q[1] = pk2(x[2] * inv * nw[2], x[3] * inv * nw[3]); q[2] = pk2(x[4] * inv * nw[4], x[5] * inv * nw[5]);
            }
            {
                const v2u w = *(const v2u*)(zr + C_MLA + 384 + F.lane * 4);
                float x[4] = {bflo(w.x), bfhi(w.x), bflo(w.y), bfhi(w.y)};
                const float ss = x[0] * x[0] + x[1] * x[1] + x[2] * x[2] + x[3] * x[3];
                const float inv = 1.f / sqrtf(wave_sum(ss) * (1.f / 256.f) + 1e-6f);
                const float* nw = p_kvnw + l * 256 + F.lane * 4;
                v2u o; o.x = pk2(x[0] * inv * nw[0], x[1] * inv * nw[1]); o.y = pk2(x[2] * inv * nw[2], x[3] * inv * nw[3]);
                *(v2u*)(CKVN + (size_t)row * 256 + F.lane * 4) = o;
            }
            {
                const float x = bf2f(zr[C_MLA + 640 + F.lane]);
                const float pr = __shfl_xor(x, 1);
                float o = x;
                if (row < NLAT) { const int t = row & 4095, i = F.lane >> 1; const f32x2 rc = WSP(const f32x2, WS_ROPE)[t * 32 + i]; const float cs = rc[0], sn = rc[1];
                    o = (F.lane & 1) ? (pr * sn + x * cs) : (x * cs - pr * sn); }
                KROPE[(size_t)row * 64 + F.lane] = (bf16)f2bf(o);
            }
        }
      }
    }
    { bf16* NAVT = WSP(bf16, WS_NAVT);
      for (int tile = F.gw; tile < (RT / 64) * 8; tile += F.NGW) {
        const int r0 = (tile >> 3) * 64, c0 = (tile & 7) * 64;
        const bf16* zr = Z + (size_t)(r0 + F.lane) * ZP + C_NA + 1024 + c0;
        v4u v[8];
#pragma unroll
        for (int j = 0; j < 8; ++j) v[j] = *(const v4u*)(zr + 8 * j);
        bf16* dst = NAVT + (size_t)c0 * RT + r0 + F.lane;
#pragma unroll
        for (int j = 0; j < 8; ++j) {
            dst[(size_t)(8 * j + 0) * RT] = (bf16)(v[j].x & 0xffffu); dst[(size_t)(8 * j + 1) * RT] = (bf16)(v[j].x >> 16);
            dst[(size_t)(8 * j + 2) * RT] = (bf16)(v[j].y & 0xffffu); dst[(size_t)(8 * j + 3) * RT] = (bf16)(v[j].y >> 16);
            dst[(size_t)(8 * j + 4) * RT] = (bf16)(v[j].z & 0xffffu); dst[(size_t)(8 * j + 5) * RT] = (bf16)(v[j].z >> 16);
            dst[(size_t)(8 * j + 6) * RT] = (bf16)(v[j].w & 0xffffu); dst[(size_t)(8 * j + 7) * RT] = (bf16)(v[j].w >> 16); }
      } }
}

__device__ __forceinline__ void phase_post(const Fr& F, int l, int nrows) {
    const bf16* Z = WSP(bf16, WS_ZH); bf16* Y = WSP(bf16, WS_AY);
    const bf16* OG = (const bf16*)((const unsigned char*)F.out + OUT_OG); const bf16* OH = (const bf16*)((const unsigned char*)F.out + OUT_OH);
    const float* p_gnw = inp(F, 10) + l * 128; const float* p_hnw = inp(F, 18) + l * 128;
    if (F.G - 64 == 192) {
        const bf16* PO = WSP(bf16, WS_PO); const float* PML = WSP(float, WS_PML);
        for (int it = F.gw; it < 64 * 256; it += F.NGW) { const int su = it >> 8, r = it & 255, u = 192 + su, hh = (u >> 4) & 3, qb = u & 15;
            float m[3], lv[3];
#pragma unroll
            for (int p = 0; p < 3; ++p) { m[p] = PML[((size_t)(su * 3 + p) * 256 + r) * 2]; lv[p] = PML[((size_t)(su * 3 + p) * 256 + r) * 2 + 1]; }
            const float M = fmaxf(m[0], fmaxf(m[1], m[2]));
            float L = 0.f, o0 = 0.f, o1 = 0.f;
#pragma unroll
            for (int p = 0; p < 3; ++p) { const float wp = __builtin_amdgcn_exp2f(m[p] - M); L += wp * lv[p];
                const unsigned pv = *(const unsigned*)(PO + ((size_t)(su * 3 + p) * 256 + r) * 128 + F.lane * 2); o0 += wp * bflo(pv); o1 += wp * bfhi(pv); }
            const float inv = 1.f / L;
            *(unsigned*)(Y + (size_t)(3 * SEQ + qb * 256 + r) * DM + 1024 + hh * 128 + F.lane * 2) = pk2(o0 * inv, o1 * inv); }
    }
    for (int row = F.gw; row < nrows; row += F.NGW) {
#pragma unroll
      for (int which = 0; which < 2; ++which) {
        const bf16* O = which ? OH : OG;
        const v4u a = *(const v4u*)(O + (size_t)row * 512 + F.lane * 8), b = *(const v4u*)(O + (size_t)(RT + row) * 512 + F.lane * 8);
        const v4u gz = *(const v4u*)(Z + (size_t)row * ZP + (which ? (C_HG + 4 * 512) : 1536) + F.lane * 8);
        float o[8] = {bflo(a.x) + bflo(b.x), bfhi(a.x) + bfhi(b.x), bflo(a.y) + bflo(b.y), bfhi(a.y) + bfhi(b.y), bflo(a.z) + bflo(b.z), bfhi(a.z) + bfhi(b.z), bflo(a.w) + bflo(b.w), bfhi(a.w) + bfhi(b.w)};
        const float gt[8] = {bflo(gz.x), bfhi(gz.x), bflo(gz.y), bfhi(gz.y), bflo(gz.z), bfhi(gz.z), bflo(gz.w), bfhi(gz.w)};
        float ss = 0.f;
#pragma unroll
        for (int j = 0; j < 8; ++j) ss += o[j] * o[j];
        ss += __shfl_xor(ss, 1); ss += __shfl_xor(ss, 2); ss += __shfl_xor(ss, 4); ss += __shfl_xor(ss, 8);
        const float inv = 1.f / sqrtf(ss * (1.f / 128.f) + 1e-6f);
        const float* nw = (which ? p_hnw : p_gnw) + (F.lane & 15) * 8;
#pragma unroll
        for (int j = 0; j < 8; ++j) o[j] = o[j] * inv * nw[j] * siluf_(gt[j]);
        v4u w; w.x = pk2(o[0], o[1]); w.y = pk2(o[2], o[3]); w.z = pk2(o[4], o[5]); w.w = pk2(o[6], o[7]);
        *(v4u*)(Y + (size_t)row * DM + (which ? 1536 : 0) + F.lane * 8) = w;
      }
    }
}

constexpr int SC_PR = 0, SC_VS = 64 * 288 * 4, SC_SC = SC_VS + 64 * 64 * 4, SC_OB = SC_SC + 64 * 16, SC_END = SC_OB + 64 * 64 * 4;
static_assert(SC_END <= 131072, "scan LDS");
template <int CTRL> __device__ __forceinline__ float dppf(float v) { return __builtin_bit_cast(float, __builtin_amdgcn_update_dpp(0, __builtin_bit_cast(int, v), CTRL, 0xF, 0xF, true)); }
__device__ __forceinline__ float reduce8(float v) { v += dppf<0xB1>(v); v += dppf<0x4E>(v); v += dppf<0x141>(v); return v; }

template <bool GDN>
__device__ __forceinline__ void scan_item(const Fr& F, int l, int item) {
    const int chain = item >> 1, ch = item & 1, b = chain >> 3, h = (chain >> 1) & 3, dir = chain & 1;
    const int tid = F.tid, slice = tid & 7, cl = tid >> 3;
    float* PR = (float*)(F.lds + SC_PR); float* VS = (float*)(F.lds + SC_VS); f32x4* SC = (f32x4*)(F.lds + SC_SC); float* OB = (float*)(F.lds + SC_OB);
    const bf16* Z = WSP(bf16, WS_ZH); const bf16* GQKV = WSP(bf16, WS_GQKV); const float* GB = WSP(float, WS_GB);
    bf16* O = (bf16*)((unsigned char*)F.out + (GDN ? OUT_OG : OUT_OH)) + (size_t)dir * RT * 512 + h * 128 + ch * 64;
    const bf16* srcA; const bf16* srcB; const bf16* srcV; int pitch;
    if (GDN) { pitch = 1536; srcA = GQKV + 512 + h * 128; srcB = GQKV + h * 128; srcV = GQKV + 1024 + h * 128 + ch * 64; }
    else { pitch = ZP; srcA = Z + C_HG + 512 * (1 + dir) + h * 128; srcB = Z + C_HG + h * 128; srcV = Z + C_HG + 3 * 512 + h * 128 + ch * 64; }
    float lbv[2][8];
    if (!GDN) { const float* p_lb = inp(F, 17);
#pragma unroll
        for (int i = 0; i < 2; ++i) { const int d0 = ((tid + 512 * i) & 15) * 8;
#pragma unroll
            for (int j = 0; j < 8; ++j) lbv[i][j] = (l == 0) ? 0.f : sigmoidf_(p_lb[512 + h * 128 + d0 + j] - p_lb[h * 128 + d0 + j]); }
    }
    float S[16];
#pragma unroll
    for (int j = 0; j < 16; ++j) S[j] = 0.f;
    v4u ra[2], rb[2], rv; float rg = 0.f, rbeta = 0.f;
    constexpr int NCH = (CTX + SEQ) / 64;
    int base = 0, sgn = 1;
#define SCAN_ROWS(c) do { const int gs = (c) * 64; if (gs < CTX) { base = NLAT + b * CTX + (dir ? (CTX - 1 - gs) : gs); } else { const int t = gs - CTX; base = b * SEQ + (dir ? (SEQ - 1 - t) : t); } sgn = dir ? -1 : 1; } while (0)
#define SCAN_LOAD() do { _Pragma("unroll") for (int i = 0; i < 2; ++i) { const int p = tid + 512 * i, s = p >> 4, d0 = (p & 15) * 8; const size_t ro = (size_t)(base + sgn * s) * pitch + d0; \
        ra[i] = *(const v4u*)(srcA + ro); rb[i] = *(const v4u*)(srcB + ro); } \
        { const int s = tid >> 3, c0 = (tid & 7) * 8; rv = *(const v4u*)(srcV + (size_t)(base + sgn * s) * pitch + c0); } \
        if (GDN && tid < 64) { const size_t ro = (size_t)(base + sgn * tid) * 16 + dir * 4 + h; rg = GB[ro]; rbeta = GB[ro + 8]; } } while (0)
#define SCAN_STORE() do { _Pragma("unroll") for (int i = 0; i < 2; ++i) { const int p = tid + 512 * i, s = p >> 4, d0 = (p & 15) * 8; \
        float av[8] = {bflo(ra[i].x), bfhi(ra[i].x), bflo(ra[i].y), bfhi(ra[i].y), bflo(ra[i].z), bfhi(ra[i].z), bflo(ra[i].w), bfhi(ra[i].w)}; \
        float bv[8] = {bflo(rb[i].x), bfhi(rb[i].x), bflo(rb[i].y), bfhi(rb[i].y), bflo(rb[i].z), bfhi(rb[i].z), bflo(rb[i].w), bfhi(rb[i].w)}; \
        if (!GDN) { _Pragma("unroll") for (int j = 0; j < 8; ++j) { av[j] = lbv[i][j] + (1.f - lbv[i][j]) * sigmoidf_(av[j]); bv[j] = siluf_(bv[j]) * 0.08838834764831845f; } } \
        float* dst = PR + s * 288 + (d0 >> 4) * 36 + (d0 & 15) * 2; \
        _Pragma("unroll") for (int j = 0; j < 4; ++j) *(f32x4*)(dst + 4 * j) = (f32x4){av[2 * j], bv[2 * j], av[2 * j + 1], bv[2 * j + 1]}; } \
        { const int s = tid >> 3, c0 = (tid & 7) * 8; float* dv = VS + s * 64 + c0; \
          *(f32x4*)dv = (f32x4){bflo(rv.x), bfhi(rv.x), bflo(rv.y), bfhi(rv.y)}; *(f32x4*)(dv + 4) = (f32x4){bflo(rv.z), bfhi(rv.z), bflo(rv.w), bfhi(rv.w)}; } \
        if (GDN && tid < 64) { float* sc = (float*)(SC + tid); sc[0] = __expf(rg); sc[1] = rbeta; } } while (0)
#define SCAN_QK() do { if (GDN) { _Pragma("unroll") for (int e = 0; e < 8; ++e) { const int s = F.wave * 8 + e; const f32x4 kq = *(const f32x4*)(PR + s * 288 + (F.lane >> 3) * 36 + (F.lane & 7) * 4); \
        const float d = wave_sum(kq[0] * kq[1] + kq[2] * kq[3]); if (F.lane == 0) ((float*)(SC + s))[2] = d; } } } while (0)

    SCAN_ROWS(0); SCAN_LOAD(); SCAN_STORE(); __syncthreads(); SCAN_QK(); __syncthreads();
    const float* prs = PR + slice * 36;
    for (int c = 0; c < NCH; ++c) {
        const int obase = base, osgn = sgn;
        if (c + 1 < NCH) { SCAN_ROWS(c + 1); SCAN_LOAD(); }
        f32x4 cur[8];
#pragma unroll
        for (int i = 0; i < 8; ++i) cur[i] = *(const f32x4*)(prs + i * 4);
        f32x4 scv = SC[0]; float vv = VS[cl];
#pragma unroll 2
        for (int s = 0; s < 64; ++s) {
            f32x4 nxt[8]; f32x4 nsc; float nvv;
            const int sn = (s + 1) & 63;
#pragma unroll
            for (int i = 0; i < 8; ++i) nxt[i] = *(const f32x4*)(prs + sn * 288 + i * 4);
            nsc = SC[sn]; nvv = VS[sn * 64 + cl];
            float o;
            if (GDN) {
                float pk = 0.f, pq = 0.f;
#pragma unroll
                for (int i = 0; i < 8; ++i) { pk += cur[i][0] * S[2 * i]; pq += cur[i][1] * S[2 * i]; pk += cur[i][2] * S[2 * i + 1]; pq += cur[i][3] * S[2 * i + 1]; }
                pk = reduce8(pk); pq = reduce8(pq);
                const float a = scv[0], u = scv[1] * (vv - a * pk);
                o = a * pq + scv[2] * u;
#pragma unroll
                for (int i = 0; i < 8; ++i) { S[2 * i] = a * S[2 * i] + cur[i][0] * u; S[2 * i + 1] = a * S[2 * i + 1] + cur[i][2] * u; }
            } else {
                float po = 0.f;
#pragma unroll
                for (int i = 0; i < 8; ++i) { const float f0 = cur[i][0], f1 = cur[i][2];
                    S[2 * i] = f0 * S[2 * i] + (1.f - f0) * vv; S[2 * i + 1] = f1 * S[2 * i + 1] + (1.f - f1) * vv;
                    po += cur[i][1] * S[2 * i]; po += cur[i][3] * S[2 * i + 1]; }
                o = reduce8(po);
            }
            if (slice == 0) OB[s * 64 + cl] = o;
#pragma unroll
            for (int i = 0; i < 8; ++i) cur[i] = nxt[i];
            scv = nsc; vv = nvv;
        }
        __syncthreads();
        {
            const int s = tid >> 3, c0 = (tid & 7) * 8; const float* ob = OB + s * 64 + c0;
            const f32x4 x0 = *(const f32x4*)ob, x1 = *(const f32x4*)(ob + 4);
            v4u w; w.x = pk2(x0[0], x0[1]); w.y = pk2(x0[2], x0[3]); w.z = pk2(x1[0], x1[1]); w.w = pk2(x1[2], x1[3]);
            *(v4u*)(O + (size_t)(obase + osgn * s) * 512 + c0) = w;
        }
        if (c + 1 < NCH) SCAN_STORE();
        __syncthreads();
        if (c + 1 < NCH) SCAN_QK();
        __syncthreads();
    }
#undef SCAN_ROWS
#undef SCAN_LOAD
#undef SCAN_STORE
#undef SCAN_QK
}

__device__ __forceinline__ unsigned cvtpk(float lo, float hi) { unsigned r; asm volatile("v_cvt_pk_bf16_f32 %0, %1, %2" : "=v"(r) : "v"(lo), "v"(hi)); return r; }
template <int DQK, bool NA>
__device__ __forceinline__ void attn_unit(const Fr& F, const bf16* Qh, int qpitch, int qrow0, bool qrope,
                                          const bf16* K1h, int k1pitch, const bf16* Vth,
                                          int kbase0, int n0, int kbase1, int ntiles, bf16* Yh, float sl2, int lo, int qgr, const float* rpbh, int pidx) {
    const bf16* K2 = WSP(bf16, WS_KROPE);
    constexpr int NDC = DQK / 32, KPB = (DQK + 16) * 2, KBUF = 64 * KPB, VPB = 160, VBUF = 128 * VPB,     BUF = KBUF + VBUF, PPR = DQK / 8, NKP = 64 * PPR / 512;
    static_assert(2 * BUF + 2048 <= 131072, "attn LDS");
    unsigned char* lds = F.lds;
    float* bt = (float*)(lds + 2 * BUF);
    const int tid = F.tid, lane = F.lane, w = F.wave, r16 = lane & 15, quad = lane >> 4;
    if (NA) { for (int i = tid; i < 15 * 32; i += 512) { const int dr = i >> 5, dc = i & 31; bt[i] = (rpbh != nullptr && dc < 31) ? rpbh[dr * 31 + dc] * LOG2E : 0.f; } }
    bf16x8 qf[2][NDC];
#pragma unroll
    for (int n = 0; n < 2; ++n) { const int row = qrow0 + w * 32 + n * 16 + r16;
#pragma unroll
        for (int dc = 0; dc < NDC; ++dc) qf[n][dc] = *(const bf16x8*)(Qh + (size_t)row * qpitch + dc * 32 + quad * 8);
        if (!NA && qrope) { const int t = row & 4095;
#pragma unroll
            for (int dc = 4; dc < NDC; ++dc) {
#pragma unroll
                for (int jj = 0; jj < 4; ++jj) { const f32x2 rc = WSP(const f32x2, WS_ROPE)[t * 32 + (dc - 4) * 16 + quad * 4 + jj]; const float cs = rc[0], sn = rc[1];
                    const float x1 = bf2f((unsigned short)qf[n][dc][2 * jj]), x2 = bf2f((unsigned short)qf[n][dc][2 * jj + 1]);
                    qf[n][dc][2 * jj] = (short)f2bf(x1 * cs - x2 * sn); qf[n][dc][2 * jj + 1] = (short)f2bf(x1 * sn + x2 * cs); } } }
    }
    f32x4 o[8][2];
#pragma unroll
    for (int dt = 0; dt < 8; ++dt) { o[dt][0] = (f32x4){0.f, 0.f, 0.f, 0.f}; o[dt][1] = (f32x4){0.f, 0.f, 0.f, 0.f}; }
    float mrun[2] = {-1e30f, -1e30f}, lsum[2] = {0.f, 0.f};
    v4u kreg[NKP], vreg[2];
    const int gr = qgr + (w >> 1);
    const int w0 = min(max(gr - 4, 0), 56);
#define AT_KROW(i) ((i) < n0 ? kbase0 + 64 * (i) : kbase1 + 64 * ((i) - n0))
#define AT_LOADK(i) do { const int kr0 = AT_KROW(i); _Pragma("unroll") for (int x = 0; x < NKP; ++x) { const int p = tid + 512 * x, key = p / PPR, pc = p % PPR; \
        const bf16* src = (pc < 16) ? K1h + (size_t)(kr0 + key) * k1pitch + pc * 8 : K2 + (size_t)(kr0 + key) * 64 + (pc - 16) * 8; kreg[x] = *(const v4u*)src; } } while (0)
#define AT_LOADV(i) do { const int kr0 = AT_KROW(i); _Pragma("unroll") for (int x = 0; x < 2; ++x) { const int p = tid + 512 * x, d = p >> 3, pc = p & 7; vreg[x] = *(const v4u*)(Vth + (size_t)d * RT + kr0 + pc * 8); } } while (0)
#define AT_STOREK(buf) do { _Pragma("unroll") for (int x = 0; x < NKP; ++x) { const int p = tid + 512 * x, key = p / PPR, pc = p % PPR; \
        const int slot = (key & 32) + ((key >> 2) & 1) * 16 + ((key & 31) >> 3) * 4 + (key & 3); *(v4u*)(lds + (buf) * BUF + slot * KPB + pc * 16) = kreg[x]; } } while (0)
#define AT_STOREV(buf) do { _Pragma("unroll") for (int x = 0; x < 2; ++x) { const int p = tid + 512 * x, d = p >> 3, pc = p & 7; *(v4u*)(lds + (buf) * BUF + KBUF + d * VPB + pc * 16) = vreg[x]; } } while (0)
    AT_LOADK(0); AT_LOADV(0); AT_STOREK(0); AT_STOREV(0); __syncthreads();
    for (int i = 0; i < ntiles; ++i) {
        int tid = F.tid; asm volatile("" : "+v"(tid));
        if (i + 1 < ntiles) AT_LOADK(i + 1);
        const bool win = NA && (i < n0);
        const int kr = lo + i;
        const bool active = !win || (kr >= w0 && kr < w0 + 8);
        const unsigned char* kb = lds + (i & 1) * BUF; const unsigned char* vb = kb + KBUF;
#pragma unroll
        for (int sub = 0; sub < 2; ++sub) {
            if (sub == 1 && i + 1 < ntiles) { AT_STOREK((i + 1) & 1); AT_LOADV(i + 1); }
            if (active) {
                f32x4 s[2][2];
                __builtin_amdgcn_s_setprio(1);
#pragma unroll
                for (int t = 0; t < 2; ++t) { s[t][0] = (f32x4){0.f, 0.f, 0.f, 0.f}; s[t][1] = (f32x4){0.f, 0.f, 0.f, 0.f};
                    if (!NA && t == 1) asm volatile("" ::: "memory");
#pragma unroll
                    for (int dc = 0; dc < NDC; ++dc) { const bf16x8 a = *(const bf16x8*)(kb + (sub * 32 + t * 16 + r16) * KPB + dc * 64 + quad * 16);
                        s[t][0] = __builtin_amdgcn_mfma_f32_16x16x32_bf16(a, qf[0][dc], s[t][0], 0, 0, 0);
                        s[t][1] = __builtin_amdgcn_mfma_f32_16x16x32_bf16(a, qf[1][dc], s[t][1], 0, 0, 0); } }
                __builtin_amdgcn_s_setprio(0);
                bf16x8 pb[2];
#pragma unroll
                for (int n = 0; n < 2; ++n) {
                    float mx = -1e30f;
                    const int qc = (w & 1) * 32 + n * 16 + r16; const int c0 = min(max(qc - 8, 0), 48);
#pragma unroll
                    for (int t = 0; t < 2; ++t)
#pragma unroll
                        for (int j = 0; j < 4; ++j) { float x = s[t][n][j] * sl2;
                            if (win) { const int kc = sub * 32 + quad * 8 + t * 4 + j; const bool ok = (kc >= c0) && (kc < c0 + 16);
                                const int dcc = min(max(kc - qc + 15, 0), 30); const float bb = bt[(kr - gr + 7) * 32 + dcc]; x = ok ? x + bb : -1e30f; }
                            s[t][n][j] = x; mx = fmaxf(mx, x); }
                    mx = fmaxf(mx, __shfl_xor(mx, 16)); mx = fmaxf(mx, __shfl_xor(mx, 32));
                    const float mnew = fmaxf(mrun[n], mx), alpha = __builtin_amdgcn_exp2f(mrun[n] - mnew); mrun[n] = mnew;
                    float ps = 0.f;
#pragma unroll
                    for (int t = 0; t < 2; ++t)
#pragma unroll
                        for (int j = 0; j < 4; ++j) { const float p = __builtin_amdgcn_exp2f(s[t][n][j] - mnew); s[t][n][j] = p; ps += p; }
                    lsum[n] = lsum[n] * alpha + ps;
#pragma unroll
                    for (int dt = 0; dt < 8; ++dt) o[dt][n] = o[dt][n] * alpha;
                    v4u u; u.x = cvtpk(s[0][n][0], s[0][n][1]); u.y = cvtpk(s[0][n][2], s[0][n][3]); u.z = cvtpk(s[1][n][0], s[1][n][1]); u.w = cvtpk(s[1][n][2], s[1][n][3]);
                    pb[n] = __builtin_bit_cast(bf16x8, u);
                }
                __builtin_amdgcn_s_setprio(1);
#pragma unroll
                for (int dt = 0; dt < 8; ++dt) { const bf16x8 a = *(const bf16x8*)(vb + (dt * 16 + r16) * VPB + sub * 64 + quad * 16);
                    o[dt][0] = __builtin_amdgcn_mfma_f32_16x16x32_bf16(a, pb[0], o[dt][0], 0, 0, 0);
                    o[dt][1] = __builtin_amdgcn_mfma_f32_16x16x32_bf16(a, pb[1], o[dt][1], 0, 0, 0); }
                __builtin_amdgcn_s_setprio(0);
            }
        }
        if (i + 1 < ntiles) AT_STOREV((i + 1) & 1);
        __syncthreads();
    }
#pragma unroll
    for (int n = 0; n < 2; ++n) { float lt = lsum[n]; lt += __shfl_xor(lt, 16); lt += __shfl_xor(lt, 32);
        const bool part = (pidx >= 0); const float inv = part ? 1.f : 1.f / lt;
        bf16* PO = WSP(bf16, WS_PO) + (size_t)pidx * 256 * 128; float* PML = WSP(float, WS_PML) + (size_t)pidx * 512;
        const int rl = w * 32 + n * 16 + r16, row = qrow0 + rl;
        bf16* dst = part ? PO + (size_t)rl * 128 + quad * 4 : Yh + (size_t)row * DM + quad * 4;
#pragma unroll
        for (int dt = 0; dt < 8; ++dt) { const f32x4 v = o[dt][n] * inv; v2u u; u.x = cvtpk(v[0], v[1]); u.y = cvtpk(v[2], v[3]); *(v2u*)(dst + dt * 16) = u; }
        if (part && quad == 0) { PML[rl * 2] = mrun[n]; PML[rl * 2 + 1] = lt; } }
#undef AT_KROW
#undef AT_LOADK
#undef AT_LOADV
#undef AT_STOREK
#undef AT_STOREV
}


typedef short s16x4 __attribute__((ext_vector_type(4)));
typedef short v4i16_t __attribute__((ext_vector_type(4)));
__device__ __forceinline__ s16x4 ldtr(const unsigned char* p) { return __builtin_bit_cast(s16x4, __builtin_amdgcn_ds_read_tr16_b64_v4i16((LAS v4i16_t*)p)); }
__device__ __forceinline__ bf16x8 cat8(s16x4 a, s16x4 b) { return __builtin_shufflevector(a, b, 0, 1, 2, 3, 4, 5, 6, 7); }
__device__ __forceinline__ bf16x8 pack8(f32x4 a, f32x4 b) { v4u u; u.x = cvtpk(a[0], a[1]); u.y = cvtpk(a[2], a[3]); u.z = cvtpk(b[0], b[1]); u.w = cvtpk(b[2], b[3]); return __builtin_bit_cast(bf16x8, u); }
constexpr int NCHK = (CTX + SEQ) / 64;
__device__ __forceinline__ int chunk_row_lo(int b, int dir, int c) {
    const int gs = c * 64;
    if (gs < CTX) return NLAT + b * CTX + (dir ? (CTX - 64 - gs) : gs);
    const int t = gs - CTX; return b * SEQ + (dir ? (SEQ - 64 - t) : t);
}

__device__ __forceinline__ void hg_lb(const Fr& F, int l, int h, float (&lbv)[8]) {
    const float* p_lb = inp(F, 17); const int d0 = (F.tid & 15) * 8;
#pragma unroll
    for (int j = 0; j < 8; ++j) lbv[j] = (l == 0) ? 0.f : sigmoidf_(p_lb[512 + h * 128 + d0 + j] - p_lb[h * 128 + d0 + j]);
}
__device__ __forceinline__ void hg_load_qf(const Fr& F, int cid, v4u (&ra)[2], v4u (&rb)[2]) {
    const int chain = cid / NCHK, c = cid % NCHK, b = chain >> 3, h = (chain >> 1) & 3, dir = chain & 1; const int row_lo = chunk_row_lo(b, dir, c);
    const bf16* Z = WSP(bf16, WS_ZH);
#pragma unroll
    for (int i = 0; i < 2; ++i) { const int p = F.tid + 512 * i, m = p >> 4, d0 = (p & 15) * 8;
        const bf16* zr = Z + (size_t)(row_lo + m) * ZP + C_HG + h * 128 + d0; ra[i] = *(const v4u*)(zr + 512 * (1 + dir)); rb[i] = *(const v4u*)zr; }
}
__device__ __forceinline__ void hg_compute_qf(const float (&lbv)[8], const v4u (&ra)[2], const v4u (&rb)[2], float (&qv)[2][8], float (&fv)[2][8]) {
#pragma unroll
    for (int i = 0; i < 2; ++i) { const v4u a = ra[i], b = rb[i];
        const float av[8] = {bflo(a.x), bfhi(a.x), bflo(a.y), bfhi(a.y), bflo(a.z), bfhi(a.z), bflo(a.w), bfhi(a.w)};
        const float bv[8] = {bflo(b.x), bfhi(b.x), bflo(b.y), bfhi(b.y), bflo(b.z), bfhi(b.z), bflo(b.w), bfhi(b.w)};
#pragma unroll
        for (int j = 0; j < 8; ++j) { const float lb = lbv[j]; fv[i][j] = lb + (1.f - lb) * sigmoidf_(av[j]); qv[i][j] = siluf_(bv[j]) * 0.08838834764831845f; } }
}
template <int LP> __device__ __forceinline__ void time_cumsum(const Fr& F, float* Lm, float* SEG, int dir) {
    const int d = F.tid & 127, seg = F.tid >> 7;
    float s = 0.f;
#pragma unroll
    for (int i = 0; i < 16; ++i) { const int t = seg * 16 + i, m = dir ? 63 - t : t; s += Lm[m * LP + d]; Lm[m * LP + d] = s; }
    SEG[seg * 128 + d] = s;
    LDS_BARRIER();
    float off = 0.f;
#pragma unroll
    for (int j = 0; j < 3; ++j) if (j < seg) off += SEG[j * 128 + d];
    if (seg > 0) {
#pragma unroll
        for (int i = 0; i < 16; ++i) { const int t = seg * 16 + i, m = dir ? 63 - t : t; Lm[m * LP + d] += off; } }
    LDS_BARRIER();
}
constexpr int HP = 132;
__device__ __forceinline__ void hg_scores(const Fr& F, int l, int cid, int cid_next, v4u (&ra)[2], v4u (&rb)[2]) {
    const int chain = cid / NCHK, h = (chain >> 1) & 3, dir = chain & 1;
    float* Q_ = (float*)F.lds; float* K_ = Q_ + 64 * HP; float* L_ = K_ + 64 * HP; float* SEG = L_ + 64 * HP;
    bf16* SCG = WSP(bf16, WS_HSC) + (size_t)cid * 4096;
    float qv[2][8], fv[2][8];
    {
        float lbv[8];
        hg_lb(F, l, h, lbv);
        hg_compute_qf(lbv, ra, rb, qv, fv);
        if (cid_next < 32 * NCHK) hg_load_qf(F, cid_next, ra, rb);
#pragma unroll
        for (int i = 0; i < 2; ++i) { const int p = F.tid + 512 * i, m = p >> 4, d0 = (p & 15) * 8;
#pragma unroll
            for (int j = 0; j < 8; ++j) { Q_[m * HP + d0 + j] = qv[i][j]; K_[m * HP + d0 + j] = 1.f - fv[i][j]; L_[m * HP + d0 + j] = __logf(fv[i][j]); } }
    }
    LDS_BARRIER();
    time_cumsum<HP>(F, L_, SEG, dir);
    {
        const int mlast = dir ? 0 : 63;
        bf16* QDG = WSP(bf16, WS_HQD) + (size_t)cid * 8192;
        bf16* KEG = (cid < 1664) ? (bf16*)((unsigned char*)F.out + OUT_HKE) + (size_t)cid * 8192 : WSP(bf16, WS_HKE2) + (size_t)(cid - 1664) * 8192;
#pragma unroll
        for (int i = 0; i < 2; ++i) { const int p = F.tid + 512 * i, m = p >> 4, d0 = (p & 15) * 8;
            float qd[8], ke[8];
#pragma unroll
            for (int j = 0; j < 8; ++j) { const float Lv = L_[m * HP + d0 + j], Lt = L_[mlast * HP + d0 + j]; qd[j] = qv[i][j] * __expf(Lv); ke[j] = (1.f - fv[i][j]) * __expf(Lt - Lv); }
            v4u o; o.x = cvtpk(qd[0], qd[1]); o.y = cvtpk(qd[2], qd[3]); o.z = cvtpk(qd[4], qd[5]); o.w = cvtpk(qd[6], qd[7]); *(v4u*)(QDG + m * 128 + d0) = o;
            o.x = cvtpk(ke[0], ke[1]); o.y = cvtpk(ke[2], ke[3]); o.z = cvtpk(ke[4], ke[5]); o.w = cvtpk(ke[6], ke[7]); *(v4u*)(KEG + m * 128 + d0) = o; }
        if (F.tid < 128) WSP(float, WS_HDL)[(size_t)cid * 128 + F.tid] = __expf(L_[mlast * HP + F.tid]);
    }
    const int lane = F.lane, r16 = lane & 15, quad = lane >> 4;
    for (int p = F.wave; p < 16; p += 8) {
        int ip, jp;
        if (p < 10) { ip = (p >= 6) ? 3 : (p >= 3) ? 2 : (p >= 1) ? 1 : 0; jp = p - ip * (ip + 1) / 2; }
        else { const int r = p - 10; ip = (r >= 5) ? 2 : (r >= 3) ? 1 : 0; jp = (r >= 5) ? 3 : (r >= 3) ? (r - 3 + 2) : (r + 1); }
        const int i = dir ? 3 - ip : ip, j = dir ? 3 - jp : jp;
        f32x4 acc = (f32x4){0.f, 0.f, 0.f, 0.f};
        if (p < 10) {
            const int mt = 16 * i + r16, ms = 16 * j + r16, mref = dir ? 16 * i + 15 : 16 * i;
#pragma unroll
            for (int dk = 0; dk < 4; ++dk) { const int d0 = dk * 32 + quad * 8;
                float av[8], bv[8];
#pragma unroll
                for (int hh = 0; hh < 2; ++hh) { const f32x4 q4 = *(const f32x4*)(Q_ + mt * HP + d0 + 4 * hh), lt = *(const f32x4*)(L_ + mt * HP + d0 + 4 * hh), lr = *(const f32x4*)(L_ + mref * HP + d0 + 4 * hh);
                    const f32x4 k4 = *(const f32x4*)(K_ + ms * HP + d0 + 4 * hh), ls = *(const f32x4*)(L_ + ms * HP + d0 + 4 * hh);
#pragma unroll
                    for (int e = 0; e < 4; ++e) { av[4 * hh + e] = q4[e] * __expf(lt[e] - lr[e]); bv[4 * hh + e] = k4[e] * __expf(fminf(lr[e] - ls[e], 85.f)); } }
                v4u ua, ub; ua.x = cvtpk(av[0], av[1]); ua.y = cvtpk(av[2], av[3]); ua.z = cvtpk(av[4], av[5]); ua.w = cvtpk(av[6], av[7]);
                ub.x = cvtpk(bv[0], bv[1]); ub.y = cvtpk(bv[2], bv[3]); ub.z = cvtpk(bv[4], bv[5]); ub.w = cvtpk(bv[6], bv[7]);
                acc = __builtin_amdgcn_mfma_f32_16x16x32_bf16(__builtin_bit_cast(bf16x8, ua), __builtin_bit_cast(bf16x8, ub), acc, 0, 0, 0); }
        }
        const int ms = 16 * j + r16;
#pragma unroll
        for (int e = 0; e < 4; ++e) { const int mt = 16 * i + 4 * quad + e; const bool ok = (p < 10) && (dir ? (ms >= mt) : (ms <= mt));
            SCG[mt * 64 + ms] = (bf16)f2bf(ok ? acc[e] : 0.f); }
    }
    LDS_BARRIER();
}

constexpr int HS_DL = 0, HS_QD = 512, HS_KE = HS_QD + 64 * 272, HS_V = HS_KE + 64 * 272, HS_SC = HS_V + 64 * 272, HS_END = HS_SC + 64 * 144;
static_assert(HS_END <= 131072, "hgrn seq LDS");
__device__ __forceinline__ void hg_seq(const Fr& F, int l, int chain) {
    const int b = chain >> 3, h = (chain >> 1) & 3, dir = chain & 1;
    const int tid = F.tid, lane = F.lane, w = F.wave, r16 = lane & 15, quad = lane >> 4, tq = (lane & 15) >> 2, tp = lane & 3;
    unsigned char* lds = F.lds;
    float* DL = (float*)(lds + HS_DL);
    const bf16* Z = WSP(bf16, WS_ZH);
    bf16* O = (bf16*)((unsigned char*)F.out + OUT_OH) + (size_t)dir * RT * 512 + h * 128 + 16 * w + r16;
    f32x4 S[8];
#pragma unroll
    for (int dt = 0; dt < 8; ++dt) S[dt] = (f32x4){0.f, 0.f, 0.f, 0.f};
    v4u rQ[2], rK[2], rV[2], rS; float rD = 0.f;
#define HS_LOAD(c) do { const int cid = chain * NCHK + (c); const int rl = chunk_row_lo(b, dir, (c)); \
        const bf16* QDG = WSP(bf16, WS_HQD) + (size_t)cid * 8192; \
        const bf16* KEG = (cid < 1664) ? (const bf16*)((const unsigned char*)F.out + OUT_HKE) + (size_t)cid * 8192 : WSP(bf16, WS_HKE2) + (size_t)(cid - 1664) * 8192; \
        _Pragma("unroll") for (int i = 0; i < 2; ++i) { const int p = tid + 512 * i, m = p >> 4, d0 = (p & 15) * 8; rQ[i] = *(const v4u*)(QDG + m * 128 + d0); rK[i] = *(const v4u*)(KEG + m * 128 + d0); \
            rV[i] = *(const v4u*)(Z + (size_t)(rl + m) * ZP + C_HG + 3 * 512 + h * 128 + d0); } \
        rS = *(const v4u*)(WSP(bf16, WS_HSC) + (size_t)cid * 4096 + tid * 8); \
        if (tid < 128) rD = WSP(float, WS_HDL)[(size_t)cid * 128 + tid]; } while (0)
    HS_LOAD(0);
    for (int c = 0; c < NCHK; ++c) {
        const int row_lo = chunk_row_lo(b, dir, c);
#pragma unroll
        for (int i = 0; i < 2; ++i) { const int p = tid + 512 * i, m = p >> 4, d0 = (p & 15) * 8;
            *(v4u*)(lds + HS_QD + m * 272 + d0 * 2) = rQ[i]; *(v4u*)(lds + HS_KE + m * 272 + d0 * 2) = rK[i]; *(v4u*)(lds + HS_V + m * 272 + d0 * 2) = rV[i]; }
        { const int m = tid >> 3, c0 = (tid & 7) * 8; *(v4u*)(lds + HS_SC + m * 144 + c0 * 2) = rS; }
        if (tid < 128) DL[tid] = rD;
        if (c + 1 < NCHK) HS_LOAD(c + 1);
        LDS_BARRIER();
        bf16x8 vb[2], sb[4];
#pragma unroll
        for (int ks = 0; ks < 2; ++ks) { const unsigned char* p0 = lds + HS_V + (32 * ks + 8 * quad + tq) * 272 + (16 * w + 4 * tp) * 2; vb[ks] = cat8(ldtr(p0), ldtr(p0 + 4 * 272)); }
#pragma unroll
        for (int ks = 0; ks < 4; ++ks) sb[ks] = pack8(S[2 * ks], S[2 * ks + 1]);
#pragma unroll
        for (int i = 0; i < 4; ++i) {
            f32x4 acc = (f32x4){0.f, 0.f, 0.f, 0.f};
            const unsigned char* qrow = lds + HS_QD + (16 * i + r16) * 272;
#pragma unroll
            for (int ks = 0; ks < 4; ++ks) { const bf16x8 a = cat8(*(const s16x4*)(qrow + (32 * ks + 4 * quad) * 2), *(const s16x4*)(qrow + (32 * ks + 16 + 4 * quad) * 2));
                acc = __builtin_amdgcn_mfma_f32_16x16x32_bf16(a, sb[ks], acc, 0, 0, 0); }
            const unsigned char* srow = lds + HS_SC + (16 * i + r16) * 144;
#pragma unroll
            for (int ks = 0; ks < 2; ++ks) { const bf16x8 a = *(const bf16x8*)(srow + (32 * ks + 8 * quad) * 2); acc = __builtin_amdgcn_mfma_f32_16x16x32_bf16(a, vb[ks], acc, 0, 0, 0); }
#pragma unroll
            for (int e = 0; e < 4; ++e) O[(size_t)(row_lo + 16 * i + 4 * quad + e) * 512] = (bf16)f2bf(acc[e]);
        }
#pragma unroll
        for (int dt = 0; dt < 8; ++dt) {
            const f32x4 dl = *(const f32x4*)(DL + 16 * dt + 4 * quad);
            f32x4 acc = S[dt] * dl;
#pragma unroll
            for (int ks = 0; ks < 2; ++ks) { const unsigned char* p0 = lds + HS_KE + (32 * ks + 8 * quad + tq) * 272 + (16 * dt + 4 * tp) * 2;
                acc = __builtin_amdgcn_mfma_f32_16x16x32_bf16(cat8(ldtr(p0), ldtr(p0 + 4 * 272)), vb[ks], acc, 0, 0, 0); }
            S[dt] = acc;
        }
        LDS_BARRIER();
    }
#undef HS_LOAD
}

__device__ __forceinline__ void gd_pre(const Fr& F, int cid) {
    const int chain = cid / NCHK, c = cid % NCHK, b = chain >> 3, h = (chain >> 1) & 3, dir = chain & 1;
    const int row_lo = chunk_row_lo(b, dir, c), lane = F.lane, r16 = lane & 15, quad = lane >> 4;
    float* Af = (float*)(F.lds + F.wave * 16896);
    float* cumL = Af + 4096; float* betaL = cumL + 64;
    const bf16* GQKV = WSP(bf16, WS_GQKV); const float* GB = WSP(float, WS_GB);
    bf16* T1G = (bf16*)((unsigned char*)F.out + OUT_GT) + (size_t)cid * 2 * 4096; bf16* ATG = T1G + 4096;
    float* SCL = WSP(float, WS_GSCAL) + (size_t)cid * 132;
    const float g = GB[(size_t)(row_lo + lane) * 16 + dir * 4 + h], beta = GB[(size_t)(row_lo + lane) * 16 + 8 + dir * 4 + h];
    float cum = g;
#pragma unroll
    for (int off = 1; off < 64; off <<= 1) { const float v = dir ? __shfl_down(cum, off) : __shfl_up(cum, off); const bool ok = dir ? (lane + off < 64) : (lane >= off); if (ok) cum += v; }
    cumL[lane] = cum; betaL[lane] = beta;
    const float last = __shfl(cum, dir ? 0 : 63);
    SCL[lane] = __expf(cum); SCL[64 + lane] = __expf(last - cum); if (lane == 0) SCL[128] = __expf(last);
    LDS_WAIT();
#pragma unroll 1
    for (int i = 0; i < 4; ++i) {
        bf16x8 qf[4], kfi[4];
#pragma unroll
        for (int dk = 0; dk < 4; ++dk) { const bf16* gr = GQKV + (size_t)(row_lo + 16 * i + r16) * 1536 + h * 128 + dk * 32 + quad * 8; qf[dk] = *(const bf16x8*)gr; kfi[dk] = *(const bf16x8*)(gr + 512); }
#pragma unroll 1
        for (int j2 = 0; j2 < 2; ++j2) {
            bf16x8 kfj[2][4];
#pragma unroll
            for (int jj = 0; jj < 2; ++jj)
#pragma unroll
                for (int dk = 0; dk < 4; ++dk) kfj[jj][dk] = *(const bf16x8*)(GQKV + (size_t)(row_lo + 16 * (2 * j2 + jj) + r16) * 1536 + 512 + h * 128 + dk * 32 + quad * 8);
#pragma unroll
            for (int jj = 0; jj < 2; ++jj) { const int j = 2 * j2 + jj;
                f32x4 kk = (f32x4){0.f, 0.f, 0.f, 0.f}, qk = (f32x4){0.f, 0.f, 0.f, 0.f};
#pragma unroll
                for (int dk = 0; dk < 4; ++dk) { kk = __builtin_amdgcn_mfma_f32_16x16x32_bf16(kfi[dk], kfj[jj][dk], kk, 0, 0, 0); qk = __builtin_amdgcn_mfma_f32_16x16x32_bf16(qf[dk], kfj[jj][dk], qk, 0, 0, 0); }
                const int ms = 16 * j + r16, s = dir ? 63 - ms : ms; const float cs = cumL[ms];
#pragma unroll
                for (int e = 0; e < 4; ++e) { const int mt = 16 * i + 4 * quad + e, t = dir ? 63 - mt : mt;
                    const float dec = __expf(fminf(cumL[mt] - cs, 0.f));
                    Af[t * 64 + s] = (s < t) ? betaL[mt] * kk[e] * dec : 0.f;
                    ATG[mt * 64 + ms] = (bf16)f2bf((s <= t) ? qk[e] * dec : 0.f); } }
        }
    }
    LDS_WAIT();
    for (int t = 0; t < 64; ++t) {
        float v0 = (t == lane) ? 1.f : 0.f, v1 = 0.f, v2 = 0.f, v3 = 0.f;
        for (int s0 = 0; s0 < t; s0 += 16) {
            f32x4 a[4]; float ts[16];
#pragma unroll
            for (int x = 0; x < 4; ++x) a[x] = *(const f32x4*)(Af + t * 64 + s0 + 4 * x);
#pragma unroll
            for (int x = 0; x < 16; ++x) ts[x] = Af[(s0 + x) * 64 + lane];
#pragma unroll
            for (int x = 0; x < 4; ++x) {
                v0 -= (s0 + 4 * x + 0 < t) ? a[x][0] * ts[4 * x + 0] : 0.f; v1 -= (s0 + 4 * x + 1 < t) ? a[x][1] * ts[4 * x + 1] : 0.f;
                v2 -= (s0 + 4 * x + 2 < t) ? a[x][2] * ts[4 * x + 2] : 0.f; v3 -= (s0 + 4 * x + 3 < t) ? a[x][3] * ts[4 * x + 3] : 0.f; }
        }
        const float v = (v0 + v1) + (v2 + v3);
        Af[t * 64 + lane] = v;
    }
    LDS_WAIT();
    const int msl = dir ? 63 - lane : lane; const float bs = betaL[msl];
    for (int t = 0; t < 64; ++t) { const int mt = dir ? 63 - t : t; const float tv = Af[t * 64 + lane]; T1G[mt * 64 + msl] = (bf16)f2bf(tv * bs); }
    LDS_WAIT();
}

constexpr int GS_T1 = 0, GS_T2 = 9216, GS_AT = 18432, GS_K = 27648, GS_Q = GS_K + 17408, GS_V = GS_Q + 17408, GS_W = GS_V + 17408, GS_SCL = GS_W + 17408, GS_END = GS_SCL + 1024;
static_assert(GS_END <= 131072, "gdn seq LDS");
__device__ __forceinline__ void gd_seq(const Fr& F, int chain) {
    const int b = chain >> 3, h = (chain >> 1) & 3, dir = chain & 1;
    const int tid = F.tid, lane = F.lane, w = F.wave, r16 = lane & 15, quad = lane >> 4, tq = (lane & 15) >> 2, tp = lane & 3;
    unsigned char* lds = F.lds;
    const bf16* GQKV = WSP(bf16, WS_GQKV);
    const bf16* TG = (const bf16*)((const unsigned char*)F.out + OUT_GT) + (size_t)chain * NCHK * 2 * 4096;
    const float* SCG = WSP(float, WS_GSCAL) + (size_t)chain * NCHK * 132;
    float* SCL = (float*)(lds + GS_SCL);
    bf16* O = (bf16*)((unsigned char*)F.out + OUT_OG) + (size_t)dir * RT * 512 + h * 128 + 16 * w + r16;
    f32x4 S[8];
#pragma unroll
    for (int dt = 0; dt < 8; ++dt) S[dt] = (f32x4){0.f, 0.f, 0.f, 0.f};
    v4u rT[2], rK[2], rQ[2], rV[2]; f32x4 rE[2]; float rS = 0.f;
#define GS_LOAD(c) do { const int rl = chunk_row_lo(b, dir, (c)); \
        _Pragma("unroll") for (int x = 0; x < 2; ++x) rT[x] = *(const v4u*)(TG + ((size_t)(c) * 2 + x) * 4096 + tid * 8); \
        rE[0] = *(const f32x4*)(SCG + (size_t)(c) * 132 + (tid & 7) * 8); rE[1] = *(const f32x4*)(SCG + (size_t)(c) * 132 + (tid & 7) * 8 + 4); \
        _Pragma("unroll") for (int i = 0; i < 2; ++i) { const int p = tid + 512 * i, m = p >> 4, d0 = (p & 15) * 8; const bf16* gr = GQKV + (size_t)(rl + m) * 1536 + h * 128 + d0; \
            rQ[i] = *(const v4u*)gr; rK[i] = *(const v4u*)(gr + 512); rV[i] = *(const v4u*)(gr + 1024); } \
        if (tid < 132) rS = SCG[(size_t)(c) * 132 + tid]; } while (0)
    GS_LOAD(0);
    for (int c = 0; c < NCHK; ++c) {
        const int row_lo = chunk_row_lo(b, dir, c);
        { const int m = tid >> 3, c0 = (tid & 7) * 8;
          *(v4u*)(lds + GS_T1 + m * 144 + c0 * 2) = rT[0]; *(v4u*)(lds + GS_AT + m * 144 + c0 * 2) = rT[1];
          v4u t2; t2.x = cvtpk(-bflo(rT[0].x) * rE[0][0], -bfhi(rT[0].x) * rE[0][1]); t2.y = cvtpk(-bflo(rT[0].y) * rE[0][2], -bfhi(rT[0].y) * rE[0][3]);
          t2.z = cvtpk(-bflo(rT[0].z) * rE[1][0], -bfhi(rT[0].z) * rE[1][1]); t2.w = cvtpk(-bflo(rT[0].w) * rE[1][2], -bfhi(rT[0].w) * rE[1][3]);
          *(v4u*)(lds + GS_T2 + m * 144 + c0 * 2) = t2; }
#pragma unroll
        for (int i = 0; i < 2; ++i) { const int p = tid + 512 * i, m = p >> 4, d0 = (p & 15) * 8;
            *(v4u*)(lds + GS_K + m * 272 + d0 * 2) = rK[i]; *(v4u*)(lds + GS_Q + m * 272 + d0 * 2) = rQ[i]; *(v4u*)(lds + GS_V + m * 272 + d0 * 2) = rV[i]; }
        if (tid < 132) SCL[tid] = rS;
        if (c + 1 < NCHK) GS_LOAD(c + 1);
        LDS_BARRIER();
        {
            bf16x8 kb[2];
#pragma unroll
            for (int ks = 0; ks < 2; ++ks) { const unsigned char* p0 = lds + GS_K + (32 * ks + 8 * quad + tq) * 272 + (16 * w + 4 * tp) * 2; kb[ks] = cat8(ldtr(p0), ldtr(p0 + 4 * 272)); }
#pragma unroll
            for (int i = 0; i < 4; ++i) { f32x4 acc = (f32x4){0.f, 0.f, 0.f, 0.f};
                const unsigned char* trow = lds + GS_T2 + (16 * i + r16) * 144;
#pragma unroll
                for (int ks = 0; ks < 2; ++ks) acc = __builtin_amdgcn_mfma_f32_16x16x32_bf16(*(const bf16x8*)(trow + (32 * ks + 8 * quad) * 2), kb[ks], acc, 0, 0, 0);
#pragma unroll
                for (int e = 0; e < 4; ++e) *(bf16*)(lds + GS_W + (16 * i + 4 * quad + e) * 272 + (16 * w + r16) * 2) = (bf16)f2bf(acc[e]); }
        }
        LDS_BARRIER();
        {
            bf16x8 vb[2], sb[4];
#pragma unroll
            for (int ks = 0; ks < 2; ++ks) { const unsigned char* p0 = lds + GS_V + (32 * ks + 8 * quad + tq) * 272 + (16 * w + 4 * tp) * 2; vb[ks] = cat8(ldtr(p0), ldtr(p0 + 4 * 272)); }
#pragma unroll
            for (int ks = 0; ks < 4; ++ks) sb[ks] = pack8(S[2 * ks], S[2 * ks + 1]);
            f32x4 vn[4];
#pragma unroll
            for (int i = 0; i < 4; ++i) { f32x4 acc = (f32x4){0.f, 0.f, 0.f, 0.f};
                const unsigned char* trow = lds + GS_T1 + (16 * i + r16) * 144;
#pragma unroll
                for (int ks = 0; ks < 2; ++ks) acc = __builtin_amdgcn_mfma_f32_16x16x32_bf16(*(const bf16x8*)(trow + (32 * ks + 8 * quad) * 2), vb[ks], acc, 0, 0, 0);
                const unsigned char* wrow = lds + GS_W + (16 * i + r16) * 272;
#pragma unroll
                for (int ks = 0; ks < 4; ++ks) acc = __builtin_amdgcn_mfma_f32_16x16x32_bf16(cat8(*(const s16x4*)(wrow + (32 * ks + 4 * quad) * 2), *(const s16x4*)(wrow + (32 * ks + 16 + 4 * quad) * 2)), sb[ks], acc, 0, 0, 0);
                vn[i] = acc; }
            bf16x8 vnb[2];
#pragma unroll
            for (int ks = 0; ks < 2; ++ks) vnb[ks] = pack8(vn[2 * ks], vn[2 * ks + 1]);
#pragma unroll
            for (int i = 0; i < 4; ++i) { f32x4 acc = (f32x4){0.f, 0.f, 0.f, 0.f};
                const unsigned char* qrow = lds + GS_Q + (16 * i + r16) * 272;
#pragma unroll
                for (int ks = 0; ks < 4; ++ks) acc = __builtin_amdgcn_mfma_f32_16x16x32_bf16(cat8(*(const s16x4*)(qrow + (32 * ks + 4 * quad) * 2), *(const s16x4*)(qrow + (32 * ks + 16 + 4 * quad) * 2)), sb[ks], acc, 0, 0, 0);
                acc = acc * *(const f32x4*)(SCL + 16 * i + 4 * quad);
                const unsigned char* arow = lds + GS_AT + (16 * i + r16) * 144;
#pragma unroll
                for (int ks = 0; ks < 2; ++ks) acc = __builtin_amdgcn_mfma_f32_16x16x32_bf16(cat8(*(const s16x4*)(arow + (32 * ks + 4 * quad) * 2), *(const s16x4*)(arow + (32 * ks + 16 + 4 * quad) * 2)), vnb[ks], acc, 0, 0, 0);
#pragma unroll
                for (int e = 0; e < 4; ++e) O[(size_t)(row_lo + 16 * i + 4 * quad + e) * 512] = (bf16)f2bf(acc[e]); }
#pragma unroll
            for (int i = 0; i < 4; ++i) vn[i] = vn[i] * *(const f32x4*)(SCL + 64 + 16 * i + 4 * quad);
#pragma unroll
            for (int ks = 0; ks < 2; ++ks) vnb[ks] = pack8(vn[2 * ks], vn[2 * ks + 1]);
            const float elast = SCL[128];
#pragma unroll
            for (int dt = 0; dt < 8; ++dt) { f32x4 acc = S[dt] * elast;
#pragma unroll
                for (int ks = 0; ks < 2; ++ks) { const unsigned char* p0 = lds + GS_K + (32 * ks + 4 * quad + tq) * 272 + (16 * dt + 4 * tp) * 2;
                    acc = __builtin_amdgcn_mfma_f32_16x16x32_bf16(cat8(ldtr(p0), ldtr(p0 + 16 * 272)), vnb[ks], acc, 0, 0, 0); }
                S[dt] = acc; }
        }
        LDS_BARRIER();
    }
#undef GS_LOAD
}

__device__ __forceinline__ void phase_prepass(const Fr& F, int l) {
    {
        const int N = 32 * NCHK, bx = blockIdx.x; int c0, cstep, cend;
        if (F.G == 256) { if (bx < 240) { c0 = bx; cstep = 240; cend = N - 64; } else { c0 = N - 64 + (bx - 240); cstep = 16; cend = N; } }
        else { c0 = bx; cstep = F.G; cend = N; }
        v4u ra[2], rb[2]; if (c0 < cend) hg_load_qf(F, c0, ra, rb);
        for (int cid = c0; cid < cend; cid += cstep) hg_scores(F, l, cid, (cid + cstep < cend) ? cid + cstep : N, ra, rb);
    }
    __syncthreads();
    for (int cid = (F.G - 1 - (int)blockIdx.x) * 8 + F.wave; cid < 32 * NCHK; cid += F.NGW) gd_pre(F, cid);
    __syncthreads();
}

#define XB_TMO      128
#define XB_XCNT(j)  (256  + 64 * (j))
#define XB_XSUB(j)  (1280 + 64 * (j))
#define XB_XGEN(j)  (2304 + 64 * (j))
#define XB_TOP      3328
#define XB_TOPGEN   3392
#define XCD_BAR_WORDS 3456
#define XB_SPIN_CAP (1u << 18)

__device__ __forceinline__ unsigned xb_ld(unsigned* p)              { return __hip_atomic_load(p, __ATOMIC_RELAXED, __HIP_MEMORY_SCOPE_AGENT); }
__device__ __forceinline__ unsigned xb_add(unsigned* p, unsigned v) { return __hip_atomic_fetch_add(p, v, __ATOMIC_RELAXED, __HIP_MEMORY_SCOPE_AGENT); }
__device__ __forceinline__ unsigned xb_xcc_id() { return (unsigned)__builtin_amdgcn_s_getreg((3 << 11) | 20) & 0xFu; }
#define XB_SPIN(cond, bar) do { unsigned _sp = 0; while (cond) { __builtin_amdgcn_s_sleep(1); \
    if ((++_sp & 255u) == 0u) { if (xb_ld(&(bar)[XB_TMO])) break; if (_sp > XB_SPIN_CAP) { atomicAdd(&(bar)[XB_TMO], 1u); break; } } } } while (0)

struct XcdBarrier {
    unsigned* bar; unsigned x;
    volatile LAS unsigned* st;
};

__device__ __forceinline__ XcdBarrier xcd_barrier_post(unsigned* bar, volatile LAS unsigned* st) {
    XcdBarrier b; b.bar = bar; b.x = xb_xcc_id(); b.st = st;
    if (threadIdx.x == 0) (void)xb_add(&bar[XB_XCNT(b.x)], 1u);
    return b;
}
__device__ __forceinline__ void xcd_barrier_complete(unsigned* bar, unsigned x, unsigned& nloc, unsigned& nx) {
    const unsigned G = gridDim.x * gridDim.y * gridDim.z;
    unsigned sum, cnt, mine, sp = 0u;
    for (;;) {
        sum = 0u; cnt = 0u; mine = 0u;
#pragma unroll
        for (unsigned j = 0; j < 16; ++j) { const unsigned c = xb_ld(&bar[XB_XCNT(j)]); sum += c; cnt += (c > 0u) ? 1u : 0u; mine = (j == x) ? c : mine; }
        if (sum == G) break;
        __builtin_amdgcn_s_sleep(1);
        if ((++sp & 255u) == 0u) { if (xb_ld(&bar[XB_TMO])) break; if (sp > XB_SPIN_CAP) { atomicAdd(&bar[XB_TMO], 1u); break; } }
    }
    nloc = mine > 0u ? mine : 1u; nx = cnt > 0u ? cnt : 1u;
}

__device__ __forceinline__ void xcd_barrier(const XcdBarrier& b) {
    asm volatile("s_waitcnt vmcnt(0)" ::: "memory");
    __syncthreads();
    if (threadIdx.x == 0) {
        unsigned* bar = b.bar;
        __builtin_amdgcn_s_waitcnt(0);
        unsigned nloc = b.st[0], nx = b.st[1];
        if (nloc == 0u) { xcd_barrier_complete(bar, b.x, nloc, nx); b.st[0] = nloc; b.st[1] = nx; }
        const unsigned old = xb_add(&bar[XB_XSUB(b.x)], 1u);
        const unsigned gen = old / nloc;
        if (old + 1u == (gen + 1u) * nloc) {
            __builtin_amdgcn_fence(__ATOMIC_RELEASE, "agent");
            asm volatile("s_waitcnt vmcnt(0)" ::: "memory");
            const unsigned og = xb_add(&bar[XB_TOP], 1u);
            const unsigned tg = og / nx;
            if (og + 1u == (tg + 1u) * nx) xb_add(&bar[XB_TOPGEN], 1u);
            else XB_SPIN(xb_ld(&bar[XB_TOPGEN]) == tg, bar);
            __builtin_amdgcn_fence(__ATOMIC_ACQUIRE, "agent");
            xb_add(&bar[XB_XGEN(b.x)], 1u);
            asm volatile("s_waitcnt vmcnt(0)" ::: "memory");
        } else {
            XB_SPIN(xb_ld(&bar[XB_XGEN(b.x)]) == gen, bar);
            __builtin_amdgcn_fence(__ATOMIC_ACQUIRE, "agent");
            asm volatile("s_waitcnt vmcnt(0)" ::: "memory");
        }
    }
    __syncthreads();
}

__device__ __forceinline__ void phase_mixers(const Fr& F, int l) {
    const int G = F.G, nscan = 64, bx = blockIdx.x;
    const bool split = (G == 256);
    const int natt = split ? 192 : G, ab = split ? bx - nscan : bx;
    for (int it = bx; it < 64; it += G) { if (it < 32) gd_seq(RL(F), it); else hg_seq(RL(F), l, it - 32); __syncthreads(); }
    const bf16* Z = WSP(bf16, WS_ZH); bf16* Y = WSP(bf16, WS_AY);
    const bf16* MQ = WSP(bf16, WS_MQ); const bf16* MK = WSP(bf16, WS_MK); const bf16* MVT = WSP(bf16, WS_MVT); const bf16* NAVT = WSP(bf16, WS_NAVT); const bf16* KROPE = WSP(bf16, WS_KROPE);
    const int ntot = 512 + (l == 0 ? 32 : 0);
    const float sl_mla = 0.07216878364870322f * LOG2E, sl_na = 0.08838834764831845f * LOG2E;
    for (int k = 0; ; ++k) {
        int p, t0 = 0, nl = 64, pidx = -1;
        if (split && bx < 64) {
            if (bx < 32) { if (k >= 1) break; p = 256 + 64 + bx; } else { if (k >= 2) break; p = 256 + 2 * (bx - 32) + k; }
        } else if (split) {
            if (k == 0) p = ab;
            else if (k == 1) { const int su = ab / 3, part = ab - 3 * su; p = 192 + su; t0 = part * 23; nl = part == 2 ? 18 : 23; pidx = ab; }
            else if (k == 2) { if (ab >= 160) continue; p = 256 + 96 + ab; }
            else if (k == 3) { if (l != 0 || ab < 160) break; p = 512 + (ab - 160); }
            else break;
        } else { p = ab + k * natt; if (p >= ntot) break; }
        if (p < 256 || (p >= 512 && p < 528)) {
            const bool lat = p < 256; const int b_ = lat ? (p >> 6) : ((p - 512) >> 2), h_ = lat ? ((p >> 4) & 3) : (p & 3), qb_ = p & 15;
            attn_unit<192, false>(RL(F), MQ + h_ * 192, 768, lat ? b_ * SEQ + qb_ * 256 : NLAT + b_ * CTX, lat, MK + h_ * 128, 512, MVT + (size_t)h_ * 128 * RT,
                                  lat ? b_ * SEQ + t0 * 64 : 0, lat ? nl : 0, NLAT + b_ * CTX, lat ? ((pidx >= 0 && t0 < 46) ? nl : nl + 4) : 4, Y + 1024 + h_ * 128, sl_mla, 0, 0, nullptr, pidx);
        } else {
            const bool lat = p < 512; const int v_ = lat ? p - 256 : p - 528, b_ = lat ? (v_ >> 6) : (v_ >> 2), h_ = lat ? ((v_ >> 4) & 3) : (v_ & 3), rg_ = v_ & 15;
            const int lo_ = min(max(4 * rg_ - 4, 0), 56), hi_ = min(max(4 * rg_ + 3 - 4, 0), 56) + 7, nwin_ = lat ? hi_ - lo_ + 1 : 0;
            attn_unit<128, true>(RL(F), Z + C_NA + h_ * 128, ZP, lat ? b_ * SEQ + rg_ * 256 : NLAT + b_ * CTX, false, Z + C_NA + 512 + h_ * 128, ZP, NAVT + (size_t)h_ * 128 * RT,
                                 lat ? b_ * SEQ + lo_ * 64 : 0, nwin_, NLAT + b_ * CTX, nwin_ + 4, Y + 512 + h_ * 128, sl_na, lat ? lo_ : 0, lat ? 4 * rg_ : 0,
                                 lat ? inp(F, 11) + (size_t)(l * 4 + h_) * 15 * 31 : nullptr, -1);
        }
        __syncthreads();
    }
}

template <class Epi, bool OPAQUE_K = false>
__device__ __forceinline__ void run_gemm(const Fr& F, const bf16* A, const bf16* Bt, int M, int N, int K, const Epi& E) {
    if (OPAQUE_K) asm volatile("" : "+s"(K));
    pg8::Gemm g{A, Bt, M, N, K, K, K}; pg8::StaticOrder S; S.init(M, N, F.G, (int)blockIdx.x);
    pg8::gemm_phase<Epi, pg8::StaticOrder, true, true>((LAS unsigned char*)F.lds, g, S, E);
}

__device__ __forceinline__ void run_gemm_splitk(const Fr& F, const bf16* A, int lda, const bf16* Bt, int ldb, int M, int N, int K, int KS, const pg8::EpiCtxSplit& E) {
    pg8::Gemm g{A, Bt, M, N, K, lda, ldb}; pg8::SplitKOrder S; S.init(M, N, KS, F.G, (int)blockIdx.x);
    pg8::gemm_phase<pg8::EpiCtxSplit, pg8::SplitKOrder, true, true>((LAS unsigned char*)F.lds, g, S, E);
}

__global__ void __launch_bounds__(512, 2) mk_fwd(Args args) {
    extern __shared__ __attribute__((aligned(16))) unsigned char lds[];
    cg::grid_group grid = cg::this_grid();
    Fr F; F.kp = (kargp_t)__builtin_amdgcn_kernarg_segment_ptr(); F.out = args.out; F.ws = args.ws; F.lds = lds;
    F.tid = threadIdx.x; F.lane = F.tid & 63; F.wave = __builtin_amdgcn_readfirstlane(F.tid >> 6); F.G = gridDim.x;
    F.gw = blockIdx.x * 8 + F.wave; F.NGW = F.G * 8;
#define ADA WSP(float, WS_ADA)
#define AY WSP(bf16, WS_AY)
#define X WSP(float, WS_X)
#define ZH WSP(bf16, WS_ZH)
    unsigned* barw = (unsigned*)args.ws;
    if (blockIdx.x == 0) for (int i = threadIdx.x; i < 4096; i += 512) barw[i] = 0u;
    volatile LAS unsigned* bst = (volatile LAS unsigned*)((LAS unsigned char*)lds + 144000);
    if (threadIdx.x < 4) bst[threadIdx.x] = 0u;
    __syncthreads();

    phase_ada(RL(F)); __syncthreads(); { const Fr Fw = RL(F); phase_wconv(Fw, 0, 0, Fw.gw, Fw.NGW); }
    grid.sync();
    const XcdBarrier xb = xcd_barrier_post(barw, bst);
    phase_mod0(RL(F));
    xcd_barrier(xb);
    for (int l = 0; l < 2; ++l) {
        const int MR = (l == 0) ? RT : NLAT;
        run_gemm(F, AY, WSP(bf16, WS_WIN), RT, ZP, DM, pg8::EpiStore<0>{ZH, ZP});
        {
            const int rem = ((RT / 256) * (ZP / 256)) % F.G, first = rem == 0 ? 0 : rem;
            if ((int)blockIdx.x >= first) { __syncthreads(); const Fr Fw = RL(F); phase_wconv(Fw, l, 1, ((int)blockIdx.x - first) * 8 + Fw.wave, (F.G - first) * 8); }
        }
        xcd_barrier(xb);
        phase_prep(RL(F), l);
        xcd_barrier(xb);
        run_gemm<pg8::EpiStore<0>, true>(F, WSP(bf16, WS_QN), WSP(bf16, WS_WUQ), RT, 768, 384, pg8::EpiStore<0>{WSP(bf16, WS_MQ), 768});
        run_gemm<pg8::EpiStore<0>, true>(F, WSP(bf16, WS_CKVN), WSP(bf16, WS_WUK), RT, 512, 256, pg8::EpiStore<0>{WSP(bf16, WS_MK), 512});
        run_gemm<pg8::EpiStore<0>, true>(F, WSP(bf16, WS_WUV), WSP(bf16, WS_CKVN), 512, RT, 256, pg8::EpiStore<0>{WSP(bf16, WS_MVT), RT});
        phase_prepass(RL(F), l);
        xcd_barrier(xb);
        phase_mixers(RL(F), l);
        xcd_barrier(xb);
        phase_post(RL(F), l, MR);
        xcd_barrier(xb);
        if (l == 0) run_gemm(F, AY, WSP(bf16, WS_WOUT), RT, DM, DM, pg8::EpiResid{inp(F, 0), inp(F, 2), X, ADA + 2 * 2048, ALPHA_RES});
        else run_gemm(F, AY, WSP(bf16, WS_WOUT), NLAT, DM, DM, pg8::EpiResid{X, X, X, ADA + (size_t)5 * ADAW + 2 * 2048, ALPHA_RES});
        xcd_barrier(xb);
        phase_ln(RL(F), l, 1, MR);
        xcd_barrier(xb);
        run_gemm(F, AY, WSP(bf16, WS_WM1), MR, FF, DM, pg8::EpiStore<1>{ZH, FF});
        if (l == 0) {
            const int rem = ((MR / 256) * (FF / 256)) % F.G, first = rem;
            if ((int)blockIdx.x >= first) { __syncthreads(); const Fr Fw = RL(F); phase_wconv(Fw, 1, 0, ((int)blockIdx.x - first) * 8 + Fw.wave, (F.G - first) * 8); }
        }
        xcd_barrier(xb);
        run_gemm(F, ZH, WSP(bf16, WS_WM2), NLAT, DM, FF, pg8::EpiResid{X, X, X, ADA + (size_t)l * 5 * ADAW + 5 * 2048, 1.f});
        if (l == 0) {
            run_gemm_splitk(F, ZH + (size_t)NLAT * FF, FF, WSP(bf16, WS_WM2), FF, NCTX, DM, FF / 2, 2, pg8::EpiCtxSplit{X + (size_t)NLAT * DM, WSP(float, WS_PART), ADA + 4 * ADAW + 5 * 2048});
        }
        xcd_barrier(xb);
        phase_ln(RL(F), l, 2, MR);
        if (l == 0) xcd_barrier(xb);
    }
}
#undef ADA
#undef AY
#undef X
#undef ZH

extern "C" void kernel_launch(void* const* d_in, const int* in_sizes, int n_in, void* d_out, int out_size, void* d_ws, size_t ws_size, hipStream_t stream) {
    static int grid = 0;
    if (grid == 0) {
        int dev = 0, cus = 0, per_cu = 0;
        if (n_in != 26 || ws_size < WS_END) { fprintf(stderr, "kernel_launch: unexpected n_in %d / ws %zu (need %zu)\n", n_in, ws_size, (size_t)WS_END); grid = -1; return; }
        (void)hipGetDevice(&dev); (void)hipDeviceGetAttribute(&cus, hipDeviceAttributeMultiprocessorCount, dev);
        if (hipFuncSetAttribute((const void*)mk_fwd, hipFuncAttributeMaxDynamicSharedMemorySize, LDS_BYTES) != hipSuccess) { fprintf(stderr, "kernel_launch: hipFuncSetAttribute failed\n"); grid = -1; return; }
        if (hipOccupancyMaxActiveBlocksPerMultiprocessor(&per_cu, (const void*)mk_fwd, 512, LDS_BYTES) != hipSuccess || per_cu < 1) per_cu = 1;
        (void)hipGetLastError();
        grid = cus * 1;
        fprintf(stderr, "kernel_launch: grid %d (cus %d, occupancy query %d), ws %zu\n", grid, cus, per_cu, ws_size);
    }
    if (grid < 0) return;
    Args a{};
    for (int i = 0; i < 26; ++i) a.in[i] = (const float*)d_in[i];
    a.out = (float*)d_out; a.ws = (unsigned char*)d_ws;
    void* kargs[] = {&a};
    const hipError_t e = hipLaunchCooperativeKernel((const void*)mk_fwd, dim3(grid), dim3(512), kargs, LDS_BYTES, stream);
    if (e != hipSuccess) fprintf(stderr, "kernel_launch: cooperative launch failed: %s (grid %d)\n", hipGetErrorString(e), grid);
}
```

```cpp
#include <hip/hip_runtime.h>
#include <hip/hip_cooperative_groups.h>
#include <cstdio>
#include <cstdint>
namespace cg = cooperative_groups;
#define LAS __attribute__((address_space(3)))
typedef unsigned short bf16;
typedef unsigned v4u __attribute__((ext_vector_type(4)));
typedef unsigned v2u __attribute__((ext_vector_type(2)));
typedef float f32x4 __attribute__((ext_vector_type(4)));
typedef float f32x2 __attribute__((ext_vector_type(2)));
typedef short bf16x8 __attribute__((ext_vector_type(8)));

constexpr int DM = 2048, NBATCH = 4, SEQ = 4096, CTX = 256, NLAT = NBATCH * SEQ, NCTX = NBATCH * CTX, RT = NLAT + NCTX;
constexpr int ZC = 6864, ZP = 6912;
constexpr int C_GDN = 0, C_NA = 2064, C_MLA = 3600, C_HG = 4304;
constexpr int FF = 8192, ADAW = 12288;
constexpr float LOG2E = 1.4426950408889634f;
constexpr float ALPHA_RES = 1.4142135623730951f;

constexpr size_t MiB = 1u << 20;
constexpr size_t WS_ADA = 1 * MiB;
constexpr size_t WS_WIN = 2 * MiB, WS_WOUT = 29 * MiB, WS_WM1 = 37 * MiB, WS_WM2 = 69 * MiB, WS_WUQ = 101 * MiB, WS_WUK = 102 * MiB, WS_WUV = 102 * MiB + 512 * 1024;
constexpr size_t WS_AY = 104 * MiB;
constexpr size_t WS_X = 172 * MiB;
constexpr size_t WS_ZH = 308 * MiB;
constexpr size_t WS_GQKV = 580 * MiB;
constexpr size_t WS_QN = 631 * MiB, WS_CKVN = 644 * MiB, WS_MQ = 653 * MiB, WS_MK = 679 * MiB, WS_MVT = 696 * MiB, WS_NAVT = 713 * MiB, WS_KROPE = 730 * MiB, WS_GB = 733 * MiB;
constexpr size_t WS_ROPE = 735 * MiB;
constexpr size_t WS_HSC = 736 * MiB;
constexpr size_t WS_GSCAL = 753 * MiB;
constexpr size_t WS_HDL = 755 * MiB;
constexpr size_t WS_HQD = 538 * MiB;
constexpr size_t WS_HKE2 = 572 * MiB;
constexpr size_t WS_PO = WS_QN, WS_PML = 643 * MiB;
constexpr size_t WS_PART = 757 * MiB;
constexpr size_t WS_END = 765 * MiB;
static_assert(WS_PO + (size_t)192 * 256 * 128 * 2 <= WS_PML && WS_PML + (size_t)192 * 256 * 2 * 4 <= WS_CKVN, "split-KV partials");
static_assert(WS_ZH + (size_t)RT * ZP * 2 <= WS_HQD && WS_HQD + (size_t)2176 * 16384 <= WS_HKE2 && WS_HKE2 + (size_t)512 * 16384 <= WS_GQKV, "hgrn pre-pass buffers in the z/h tail");
static_assert(WS_WIN + (size_t)ZP * DM * 2 <= WS_WOUT && WS_WM2 + (size_t)DM * FF * 2 <= WS_WUQ && WS_WUQ + 768 * 384 * 2 <= WS_WUK, "weights map");
static_assert(WS_AY + (size_t)RT * DM * 2 <= WS_X && WS_X + (size_t)RT * DM * 4 <= WS_ZH && WS_ZH + (size_t)RT * FF * 2 <= WS_GQKV, "act map");
static_assert(WS_GQKV + (size_t)RT * 1536 * 2 <= WS_QN && WS_QN + (size_t)RT * 384 * 2 <= WS_CKVN && WS_CKVN + (size_t)RT * 256 * 2 <= WS_MQ && WS_MQ + (size_t)RT * 768 * 2 <= WS_MK, "mixer map");
static_assert(WS_MK + (size_t)RT * 512 * 2 <= WS_MVT && WS_MVT + (size_t)RT * 512 * 2 <= WS_NAVT && WS_NAVT + (size_t)RT * 512 * 2 <= WS_KROPE && WS_KROPE + (size_t)RT * 64 * 2 <= WS_GB && WS_GB + (size_t)RT * 16 * 4 <= WS_END, "mixer map 2");
constexpr size_t OUT_OG = 0, OUT_OH = 34 * MiB, OUT_GT = 68 * MiB, OUT_HKE = 102 * MiB;
static_assert(OUT_OH + (size_t)2 * RT * 512 * 2 <= OUT_GT && OUT_GT + (size_t)2176 * 2 * 8192 <= OUT_HKE && OUT_HKE + (size_t)1664 * 16384 <= (size_t)NLAT * DM * 4, "d_out scratch");

constexpr int LDS_BYTES = 147456;

__device__ __forceinline__ float bf2f(unsigned short u) { return __builtin_bit_cast(float, (unsigned)u << 16); }
__device__ __forceinline__ float bflo(unsigned w) { return __builtin_bit_cast(float, w << 16); }
__device__ __forceinline__ float bfhi(unsigned w) { return __builtin_bit_cast(float, w & 0xffff0000u); }
__device__ __forceinline__ unsigned f2bf(float f) { unsigned u = __builtin_bit_cast(unsigned, f); return (u + 0x7fffu + ((u >> 16) & 1u)) >> 16; }
__device__ __forceinline__ unsigned pk2(float lo, float hi) { return f2bf(lo) | (f2bf(hi) << 16); }
__device__ __forceinline__ float wave_sum(float v) {
#pragma unroll
    for (int o = 1; o < 64; o <<= 1) v += __shfl_xor(v, o);
    return v;
}
__device__ __forceinline__ float sigmoidf_(float x) { return __builtin_amdgcn_rcpf(1.f + __expf(-x)); }
__device__ __forceinline__ float siluf_(float x) { return x * __builtin_amdgcn_rcpf(1.f + __expf(-x)); }
#define LDS_WAIT() asm volatile("s_waitcnt vmcnt(0) lgkmcnt(0)" ::: "memory")
#define LDS_BARRIER() do { asm volatile("s_waitcnt lgkmcnt(0)" ::: "memory"); __builtin_amdgcn_s_barrier(); asm volatile("" ::: "memory"); } while (0)

namespace pg8 {
#define PG8_LAS __attribute__((address_space(3)))
typedef unsigned short bf16_t;
typedef short bf16x8 __attribute__((ext_vector_type(8)));
typedef float f32x4 __attribute__((ext_vector_type(4)));
typedef unsigned u32x4 __attribute__((ext_vector_type(4)));
constexpr int BM = 256, BK = 64, HALF = 128, HTB = HALF * BK * 2  , STAGE_BYTES = 8 * HTB, NXCD = 8, WGM = 8;

__host__ __device__ __forceinline__ int lds_byte(int r, int c) { const int st = (r >> 4) * 2 + (c >> 5), rr = r & 15, cc = c & 31, ob = rr * 64 + cc * 2; return st * 1024 + (ob ^ (((ob >> 9) & 1) << 5)); }
__host__ __device__ __forceinline__ void stage_rc(int b, int& R, int& C) { const int st = b / 1024, sb = b % 1024, swz = sb ^ (((sb >> 9) & 1) << 5); R = (st >> 1) * 16 + swz / 64; C = (st & 1) * 32 + (swz % 64) / 2; }
__host__ __device__ __forceinline__ int perm32(int rho) { const int n = rho >> 4, i = rho & 15; return 8 * (i >> 2) + 4 * n + (i & 3); }

struct Unit { int pm, pn, ks; };
struct Gemm { const bf16_t* A; const bf16_t* Bt; int M, N, K, lda, ldb; };

struct StaticOrder {
    int nM, nN, nwg, G, c;
    __host__ __device__ void init(int M, int N, int G_, int c_) { nM = M / BM; nN = N / BM; nwg = nM * nN; G = G_; c = c_; }
    __host__ __device__ bool next(int i, Unit& u) const {
        const long L = (long)i * G + c; if (L >= nwg) return false;
        int wgid = (int)L; { const int q = nwg / NXCD, r = nwg % NXCD, xcd = wgid % NXCD, off = wgid / NXCD; wgid = (xcd < r ? xcd * (q + 1) : r * (q + 1) + (xcd - r) * q) + off; }
        const int nig = WGM * nN, gid = wgid / nig, fm = gid * WGM, gsz = (nM - fm) < WGM ? (nM - fm) : WGM;
        u.pm = fm + ((wgid % nig) % gsz); u.pn = (wgid % nig) / gsz; u.ks = 0; return true;
    }
    __device__ __forceinline__ void a_ready(const Unit&) const {}
    __device__ __forceinline__ void done(const Unit&) const {}
};

struct SplitKOrder {
    int nM, nN, KS, nwg, G, c;
    __host__ __device__ void init(int M, int N, int KS_, int G_, int c_) { nM = M / BM; nN = N / BM; KS = KS_; nwg = nM * nN * KS; G = G_; c = c_; }
    __host__ __device__ bool next(int i, Unit& u) const {
        const long L = (long)i * G + c; if (L >= nwg) return false;
        const int t = (int)L; u.ks = t % KS; const int r = t / KS; u.pm = r % nM; u.pn = r / nM; return true;
    }
    __device__ __forceinline__ void a_ready(const Unit&) const {}
    __device__ __forceinline__ void done(const Unit&) const {}
};

template <class Epi, class Sched, bool ALIGN_EPI = false, bool SP2 = false>
__device__ __forceinline__ void gemm_phase(PG8_LAS unsigned char* lds, const Gemm g, const Sched& S, const Epi& E) {
    int tid_ = threadIdx.x; asm volatile("" : "+v"(tid_));
    const int tid = tid_, wid = __builtin_amdgcn_readfirstlane(tid >> 6), lane = tid & 63, wr = wid >> 2, wc = wid & 3, fr = lane & 15, fq = lane >> 4;
    const int K = g.K, nt = K / BK;
    unsigned voffA[2], voffB[2];
#pragma unroll
    for (int i = 0; i < 2; ++i) { int R, C; stage_rc(tid * 16 + i * 8192, R, C); const int Rb = Epi::PERM ? ((R & ~31) + perm32(R & 31)) : R;
        voffA[i] = (unsigned)(R * g.lda + C) * 2u; voffB[i] = (unsigned)(Rb * g.ldb + C) * 2u; }
    const size_t kstep = (size_t)(BK * 2);
    const size_t hstepA = (size_t)HALF * g.lda * 2, hstepB = (size_t)HALF * g.ldb * 2;
    const size_t tstepA = 2 * hstepA, tstepB = 2 * hstepB, sstep = (size_t)K * 2;
    const unsigned ldsw = (unsigned)wid * 1024u;
    const int aoff = lds_byte(wr * 64 + fr, fq * 8), boff = lds_byte(wc * 32 + fr, fq * 8);
#define PG8_SA(b, h) (((b) * 2 + (h)) * HTB)
#define PG8_SB(b, h) ((4 + (b) * 2 + (h)) * HTB)
#define PG8_STAGE(bufoff, gbase, voff) do { _Pragma("unroll") for (int _i = 0; _i < 2; ++_i) \
        __builtin_amdgcn_global_load_lds((const unsigned*)((const char*)(gbase) + (voff)[_i]), (PG8_LAS unsigned*)(lds + (bufoff) + ldsw + _i * 8192), 16, 0, 0); } while (0)
#define PG8_LDA(dst, b, h) do { _Pragma("unroll") for (int m = 0; m < 4; ++m) _Pragma("unroll") for (int k = 0; k < 2; ++k) dst[m][k] = *(const PG8_LAS bf16x8*)(lds + PG8_SA(b, h) + aoff + m * 2048 + k * 1024); } while (0)
#define PG8_LDB(dst, b, h) do { _Pragma("unroll") for (int n = 0; n < 2; ++n) _Pragma("unroll") for (int k = 0; k < 2; ++k) dst[n][k] = *(const PG8_LAS bf16x8*)(lds + PG8_SB(b, h) + boff + n * 2048 + k * 1024); } while (0)
#define PG8_MMA(ai, bj, At, Bt) do { __builtin_amdgcn_s_setprio(1); _Pragma("unroll") for (int m = 0; m < 4; ++m) _Pragma("unroll") for (int n = 0; n < 2; ++n) _Pragma("unroll") for (int k = 0; k < 2; ++k) \
        acc[ai][bj][m][n] = __builtin_amdgcn_mfma_f32_16x16x32_bf16(Bt[n][k], At[m][k], acc[ai][bj][m][n], 0, 0, 0); __builtin_amdgcn_s_setprio(0); } while (0)
#define PG8_WAIT_V(n) asm volatile("s_waitcnt vmcnt(" #n ")" ::: "memory")
#define PG8_WAIT_L(n) asm volatile("s_waitcnt lgkmcnt(" #n ")" ::: "memory")
#define PG8_BAR __builtin_amdgcn_s_barrier()
#define PG8_SCHED __builtin_amdgcn_sched_barrier(0)
    Unit cur, nxt; int ui = 0;
    if (!S.next(0, cur)) return;
    f32x4 acc[2][2][4][2];
#pragma unroll
    for (int a = 0; a < 2; ++a)
#pragma unroll
        for (int b = 0; b < 2; ++b)
#pragma unroll
            for (int m = 0; m < 4; ++m)
#pragma unroll
                for (int n = 0; n < 2; ++n) acc[a][b][m][n] = (f32x4){0.f, 0.f, 0.f, 0.f};
    bf16x8 At[4][2], B0[2][2], B1[2][2];
    const char* cA = (const char*)g.A + (size_t)cur.pm * tstepA + (size_t)cur.ks * sstep; const char* cB = (const char*)g.Bt + (size_t)cur.pn * tstepB + (size_t)cur.ks * sstep;
    S.a_ready(cur);
    if constexpr (SP2) {
        PG8_STAGE(PG8_SB(0, 0), cB, voffB); PG8_STAGE(PG8_SB(0, 1), cB + hstepB, voffB); PG8_STAGE(PG8_SA(0, 0), cA, voffA); PG8_STAGE(PG8_SA(0, 1), cA + hstepA, voffA);
        if (wr == 1) PG8_BAR;
        PG8_WAIT_V(2); PG8_BAR;
        PG8_STAGE(PG8_SB(1, 0), cB + kstep, voffB); PG8_STAGE(PG8_SA(1, 0), cA + kstep, voffA); PG8_STAGE(PG8_SB(1, 1), cB + hstepB + kstep, voffB);
        PG8_WAIT_V(6); PG8_BAR;
    } else {
        PG8_STAGE(PG8_SB(0, 0), cB, voffB); PG8_STAGE(PG8_SA(0, 0), cA, voffA); PG8_STAGE(PG8_SB(0, 1), cB + hstepB, voffB); PG8_STAGE(PG8_SA(0, 1), cA + hstepA, voffA);
        if (wr == 1) PG8_BAR;
        PG8_WAIT_V(4); PG8_BAR;
        PG8_STAGE(PG8_SB(1, 0), cB + kstep, voffB); PG8_STAGE(PG8_SA(1, 0), cA + kstep, voffA); PG8_STAGE(PG8_SB(1, 1), cB + hstepB + kstep, voffB);
        PG8_WAIT_V(6); PG8_BAR;
    }
    for (;;) {
        const bool has_next = S.next(ui + 1, nxt);
        const char* nA = has_next ? (const char*)g.A + (size_t)nxt.pm * tstepA + (size_t)nxt.ks * sstep : cA; const char* nB = has_next ? (const char*)g.Bt + (size_t)nxt.pn * tstepB + (size_t)nxt.ks * sstep : cB;
        for (int t = 0; t < nt; t += 2) {
            const bool last = (t == nt - 2);
            const char* a1 = cA + (size_t)(t + 1) * kstep;
            const char* a2 = last ? nA : cA + (size_t)(t + 2) * kstep; const char* b2 = last ? nB : cB + (size_t)(t + 2) * kstep;
            const char* a3 = a2 + kstep; const char* b3 = b2 + kstep;
            if (last && has_next) S.a_ready(nxt);
            if constexpr (SP2) {
            PG8_LDB(B0, 0, 0); PG8_LDB(B1, 0, 1); PG8_SCHED; PG8_LDA(At, 0, 0); PG8_STAGE(PG8_SA(1, 1), a1 + hstepA, voffA);
            PG8_WAIT_V(8); PG8_WAIT_L(0); PG8_BAR; PG8_MMA(0, 0, At, B0); PG8_MMA(0, 1, At, B1); PG8_BAR; PG8_SCHED;
            PG8_LDA(At, 0, 1); PG8_STAGE(PG8_SB(0, 0), b2, voffB); PG8_STAGE(PG8_SB(0, 1), b2 + hstepB, voffB); PG8_STAGE(PG8_SA(0, 0), a2, voffA);
            PG8_WAIT_V(8); PG8_WAIT_L(0); PG8_BAR; PG8_MMA(1, 0, At, B0); PG8_MMA(1, 1, At, B1); PG8_BAR; PG8_SCHED;
            PG8_LDB(B0, 1, 0); PG8_LDB(B1, 1, 1); PG8_SCHED; PG8_LDA(At, 1, 0); PG8_STAGE(PG8_SA(0, 1), a2 + hstepA, voffA);
            PG8_WAIT_V(8); PG8_WAIT_L(0); PG8_BAR; PG8_MMA(0, 0, At, B0); PG8_MMA(0, 1, At, B1); PG8_BAR; PG8_SCHED;
            PG8_LDA(At, 1, 1); PG8_STAGE(PG8_SB(1, 0), b3, voffB); PG8_STAGE(PG8_SB(1, 1), b3 + hstepB, voffB); PG8_STAGE(PG8_SA(1, 0), a3, voffA);
            PG8_WAIT_V(8); PG8_WAIT_L(0); PG8_BAR; PG8_MMA(1, 0, At, B0); PG8_MMA(1, 1, At, B1); PG8_BAR; PG8_SCHED;
            } else {
            PG8_LDB(B0, 0, 0); PG8_SCHED; PG8_LDA(At, 0, 0); PG8_STAGE(PG8_SA(1, 1), a1 + hstepA, voffA);
            PG8_WAIT_L(8); PG8_BAR; PG8_WAIT_L(0); PG8_MMA(0, 0, At, B0); PG8_BAR; PG8_SCHED;
            PG8_LDB(B1, 0, 1); PG8_STAGE(PG8_SB(0, 0), b2, voffB);
            PG8_BAR; PG8_WAIT_L(0); PG8_MMA(0, 1, At, B1); PG8_BAR;
            PG8_LDA(At, 0, 1); PG8_STAGE(PG8_SA(0, 0), a2, voffA);
            PG8_BAR; PG8_WAIT_L(0); PG8_MMA(1, 0, At, B0); PG8_BAR; PG8_SCHED;
            PG8_STAGE(PG8_SB(0, 1), b2 + hstepB, voffB);
            PG8_WAIT_V(6); PG8_BAR; PG8_MMA(1, 1, At, B1); PG8_BAR;
            PG8_LDB(B0, 1, 0); PG8_SCHED; PG8_LDA(At, 1, 0); PG8_STAGE(PG8_SA(0, 1), a2 + hstepA, voffA);
            PG8_WAIT_L(8); PG8_BAR; PG8_WAIT_L(0); PG8_MMA(0, 0, At, B0); PG8_BAR; PG8_SCHED;
            PG8_LDB(B1, 1, 1); PG8_STAGE(PG8_SB(1, 0), b3, voffB);
            PG8_BAR; PG8_WAIT_L(0); PG8_MMA(0, 1, At, B1); PG8_BAR;
            PG8_LDA(At, 1, 1); PG8_STAGE(PG8_SA(1, 0), a3, voffA);
            PG8_BAR; PG8_WAIT_L(0); PG8_MMA(1, 0, At, B0); PG8_BAR; PG8_SCHED;
            PG8_STAGE(PG8_SB(1, 1), b3 + hstepB, voffB);
            PG8_WAIT_V(6); PG8_BAR; PG8_MMA(1, 1, At, B1); PG8_BAR;
            }
        }
        if constexpr (ALIGN_EPI) { if (wr == 0) PG8_BAR; }
        if constexpr (!Epi::AFTER_DRAIN) { E(acc, cur, wr, wc, fr, fq); S.done(cur); }
        if (!has_next) break;
#pragma unroll
        for (int a = 0; a < 2; ++a)
#pragma unroll
            for (int b = 0; b < 2; ++b)
#pragma unroll
                for (int m = 0; m < 4; ++m)
#pragma unroll
                    for (int n = 0; n < 2; ++n) acc[a][b][m][n] = (f32x4){0.f, 0.f, 0.f, 0.f};
        cur = nxt; cA = nA; cB = nB; ++ui;
        if constexpr (ALIGN_EPI) { if (wr == 1) PG8_BAR; }
    }
    PG8_WAIT_V(0);
    if constexpr (!ALIGN_EPI) { if (wr == 0) PG8_BAR; }
    PG8_BAR;
    if constexpr (Epi::AFTER_DRAIN) { E.fused(acc, cur, wr, wc, fr, fq, lds, wid, lane); S.done(cur); }
#undef PG8_SA
#undef PG8_SB
#undef PG8_STAGE
#undef PG8_LDA
#undef PG8_LDB
#undef PG8_MMA
#undef PG8_WAIT_V
#undef PG8_WAIT_L
#undef PG8_BAR
#undef PG8_SCHED
}
}

namespace pg8 {
__device__ __forceinline__ unsigned cvt_pk_bf16(float lo, float hi) { unsigned r; asm volatile("v_cvt_pk_bf16_f32 %0, %1, %2" : "=v"(r) : "v"(lo), "v"(hi)); return r; }
template <int ACT> struct EpiStore {
    static constexpr bool PERM = true, AFTER_DRAIN = false;
    bf16_t* O; int ldc;
    __device__ __forceinline__ void operator()(const f32x4 (&acc)[2][2][4][2], const Unit& u, int wr, int wc, int fr, int fq) const {
        const int row0 = u.pm * BM + wr * 64 + fr, col0 = u.pn * BM + wc * 32 + 8 * fq;
#pragma unroll
        for (int ai = 0; ai < 2; ++ai)
#pragma unroll
            for (int m = 0; m < 4; ++m) { bf16_t* rowp = O + (size_t)(row0 + ai * HALF + m * 16) * ldc + col0;
#pragma unroll
                for (int bj = 0; bj < 2; ++bj) { f32x4 v0 = acc[ai][bj][m][0], v1 = acc[ai][bj][m][1];
                    if (ACT == 1) {
#pragma unroll
                        for (int j = 0; j < 4; ++j) { float a = fmaxf(v0[j], 0.f), b = fmaxf(v1[j], 0.f); v0[j] = a * a; v1[j] = b * b; } }
                    u32x4 w; w.x = cvt_pk_bf16(v0[0], v0[1]); w.y = cvt_pk_bf16(v0[2], v0[3]); w.z = cvt_pk_bf16(v1[0], v1[1]); w.w = cvt_pk_bf16(v1[2], v1[3]);
                    *(u32x4*)(rowp + bj * HALF) = w; } }
    }
};
struct EpiResid {
    static constexpr bool PERM = false, AFTER_DRAIN = false;
    const float* xlat; const float* xctx; float* out; const float* gbase; float alpha;
    __device__ __forceinline__ void operator()(const f32x4 (&acc)[2][2][4][2], const Unit& u, int wr, int wc, int fr, int fq) const {
#pragma unroll
        for (int ai = 0; ai < 2; ++ai)
#pragma unroll
            for (int m = 0; m < 4; ++m) {
                const int row = u.pm * BM + ai * HALF + wr * 64 + m * 16 + fr;
                const int v = row < NLAT ? (row >> 12) : 4;
                const float* xin = row < NLAT ? xlat + (size_t)row * DM : xctx + (size_t)(row - NLAT) * DM;
                const float* g = gbase + (size_t)v * ADAW;
                float* op = out + (size_t)row * DM;
#pragma unroll
                for (int bj = 0; bj < 2; ++bj)
#pragma unroll
                    for (int n = 0; n < 2; ++n) { const int col = u.pn * BM + bj * HALF + wc * 32 + n * 16 + fq * 4;
                        const f32x4 x4 = *(const f32x4*)(xin + col), g4 = *(const f32x4*)(g + col);
                        *(f32x4*)(op + col) = x4 * alpha + g4 * acc[ai][bj][m][n]; }
            }
    }
};
struct EpiCtxSplit {
    static constexpr bool PERM = false, AFTER_DRAIN = false;
    float* out; float* part; const float* g;
    __device__ __forceinline__ void operator()(const f32x4 (&acc)[2][2][4][2], const Unit& u, int wr, int wc, int fr, int fq) const {
#pragma unroll
        for (int ai = 0; ai < 2; ++ai)
#pragma unroll
            for (int m = 0; m < 4; ++m) {
                const size_t ro = (size_t)(u.pm * BM + ai * HALF + wr * 64 + m * 16 + fr) * DM;
#pragma unroll
                for (int bj = 0; bj < 2; ++bj)
#pragma unroll
                    for (int n = 0; n < 2; ++n) { const int col = u.pn * BM + bj * HALF + wc * 32 + n * 16 + fq * 4; const f32x4 v = *(const f32x4*)(g + col) * acc[ai][bj][m][n];
                        if (u.ks == 0) *(f32x4*)(out + ro + col) = *(const f32x4*)(out + ro + col) + v; else *(f32x4*)(part + ro + col) = v; }
            }
    }
};
}

struct Args { const float* in[26]; float* out; unsigned char* ws; };
typedef const float* cfp_t;
typedef const __attribute__((address_space(4))) cfp_t* kargp_t;
struct Fr {
    kargp_t kp; float* out; unsigned char* ws; unsigned char* lds;
    int tid, lane, wave, G, gw, NGW;
};
__device__ __forceinline__ const float* inp(const Fr& F, int k) { kargp_t p = F.kp; asm volatile("" : "+s"(p)); return p[k]; }
#define WSP(T, off) ((T*)(F.ws + (off)))
__device__ __forceinline__ Fr RL(const Fr& F0) { Fr F = F0; int t = threadIdx.x; asm volatile("" : "+v"(t)); F.tid = t; F.lane = t & 63; F.wave = __builtin_amdgcn_readfirstlane(t >> 6); F.gw = blockIdx.x * 8 + F.wave; return F; }

__device__ __forceinline__ void phase_ada(const Fr& F) {
    float* sl = (float*)F.lds;
    float* red = sl + 5 * 2048;
    float* ADA = WSP(float, WS_ADA);
    const float* p_c = inp(F, 1); const float* p_cc = inp(F, 3); const float* p_wada = inp(F, 4); const float* p_bada = inp(F, 5);
    for (int i = F.tid; i < 5 * 2048; i += 512) { const float c = (i < 4 * 2048) ? p_c[i] : p_cc[i - 4 * 2048]; sl[i] = siluf_(c); }
    __syncthreads();
    for (int it = blockIdx.x; it < 2 * 384; it += F.G) {
        const int l = it / 384, n0 = (it % 384) * 32, c4 = (F.tid & 7) * 4, ks = F.tid >> 3;
        const float* W = p_wada + (size_t)l * DM * ADAW + n0 + c4;
        f32x4 a0 = (f32x4){0.f, 0.f, 0.f, 0.f}, a1 = a0, a2 = a0, a3 = a0, a4 = a0;
        const int k0 = ks * 32;
#pragma unroll 16
        for (int k = 0; k < 32; ++k) { const f32x4 wv = *(const f32x4*)(W + (size_t)(k0 + k) * ADAW);
            a0 += wv * sl[k0 + k]; a1 += wv * sl[2048 + k0 + k]; a2 += wv * sl[4096 + k0 + k]; a3 += wv * sl[6144 + k0 + k]; a4 += wv * sl[8192 + k0 + k]; }
        *(f32x4*)(red + (ks * 5 + 0) * 32 + c4) = a0; *(f32x4*)(red + (ks * 5 + 1) * 32 + c4) = a1; *(f32x4*)(red + (ks * 5 + 2) * 32 + c4) = a2;
        *(f32x4*)(red + (ks * 5 + 3) * 32 + c4) = a3; *(f32x4*)(red + (ks * 5 + 4) * 32 + c4) = a4;
        __syncthreads();
        if (F.tid < 160) { const int v = F.tid >> 5, ln = F.tid & 31; float s = 0.f;
#pragma unroll 16
            for (int ww = 0; ww < 64; ++ww) s += red[(ww * 5 + v) * 32 + ln];
            ADA[((size_t)l * 5 + v) * ADAW + n0 + ln] = s + p_bada[(size_t)l * ADAW + n0 + ln]; }
        __syncthreads();
    }
    {
        f32x2* RP = WSP(f32x2, WS_ROPE);
        for (int e = blockIdx.x * 512 + F.tid; e < SEQ * 32; e += F.G * 512) { const int t = e >> 5, i = e & 31; const int pos = i < 16 ? (t >> 6) : (t & 63);
            const float freq = exp2f(-(float)(i & 15) * 0.8304820237218406f)  ; float sn, cs; sincosf((float)pos * freq, &sn, &cs); RP[e] = (f32x2){cs, sn}; }
    }
}

__device__ __forceinline__ void transpose_item(const float* W, int K, int N, int NP, bf16* WT, float* scr, int item, int lane) {
    const int nblk = NP / 32, kb = item / nblk, nb = item % nblk, k0 = 64 * kb, n0 = 32 * nb;
    const int l8 = lane & 7, kr = lane >> 3, nn = n0 + 4 * l8; const bool ok = nn < N;
    f32x4 wv[8];
#pragma unroll
    for (int i = 0; i < 8; ++i) { const int kk = 8 * i + kr; wv[i] = ok ? *(const f32x4*)(W + (size_t)(k0 + kk) * N + nn) : (f32x4){0.f, 0.f, 0.f, 0.f}; }
#pragma unroll
    for (int i = 0; i < 8; ++i) { const int kk = 8 * i + kr; float* d = scr + kk * 33 + 4 * l8; d[0] = wv[i][0]; d[1] = wv[i][1]; d[2] = wv[i][2]; d[3] = wv[i][3]; }
    LDS_WAIT();
    const int c = lane & 7;
#pragma unroll
    for (int j = 0; j < 4; ++j) { const int n = (lane >> 3) + 8 * j; const float* s = scr + (8 * c) * 33 + n;
        v4u o; o.x = pk2(s[0 * 33], s[1 * 33]); o.y = pk2(s[2 * 33], s[3 * 33]); o.z = pk2(s[4 * 33], s[5 * 33]); o.w = pk2(s[6 * 33], s[7 * 33]);
        *(v4u*)(WT + (size_t)(n0 + n) * K + k0 + 8 * c) = o; }
    LDS_WAIT();
}
__device__ __forceinline__ void phase_wconv(const Fr& F, int l, int mode, int w0, int nw) {
    float* scr = (float*)F.lds + F.wave * (64 * 33);
    constexpr int I_IN = 32 * 216, I_OUT = 32 * 64, I_M1 = 32 * 256, I_M2 = 128 * 64, I_UQ = 6 * 24, I_UK = 4 * 16, I_UV = 4 * 16;
    constexpr int NIT = I_IN + I_OUT + I_M1 + I_M2 + I_UQ + I_UK + I_UV;
    for (int q = w0; ; q += nw) {
        int it;
        if (mode == 0) { if (q >= I_IN + I_UQ + I_UK + I_UV) break; it = q < I_IN ? q : q + I_OUT + I_M1 + I_M2; }
        else { if (q >= I_OUT + I_M1 + I_M2) break; it = I_IN + q; }
        int r = it;
        if (r < I_IN) { transpose_item(inp(F, 6) + (size_t)l * DM * ZC, DM, ZC, ZP, WSP(bf16, WS_WIN), scr, r, F.lane); continue; } r -= I_IN;
        if (r < I_OUT) { transpose_item(inp(F, 19) + (size_t)l * DM * DM, DM, DM, DM, WSP(bf16, WS_WOUT), scr, r, F.lane); continue; } r -= I_OUT;
        if (r < I_M1) { transpose_item(inp(F, 22) + (size_t)l * DM * FF, DM, FF, FF, WSP(bf16, WS_WM1), scr, r, F.lane); continue; } r -= I_M1;
        if (r < I_M2) { transpose_item(inp(F, 23) + (size_t)l * FF * DM, FF, DM, DM, WSP(bf16, WS_WM2), scr, r, F.lane); continue; } r -= I_M2;
        if (r < I_UQ) { transpose_item(inp(F, 14) + (size_t)l * 384 * 768, 384, 768, 768, WSP(bf16, WS_WUQ), scr, r, F.lane); continue; } r -= I_UQ;
        if (r < I_UK) { transpose_item(inp(F, 15) + (size_t)l * 256 * 512, 256, 512, 512, WSP(bf16, WS_WUK), scr, r, F.lane); continue; } r -= I_UK;
        transpose_item(inp(F, 16) + (size_t)l * 256 * 512, 256, 512, 512, WSP(bf16, WS_WUV), scr, r, F.lane);
    }
}

__device__ __forceinline__ void phase_mod0(const Fr& F) {
    const float* ADA = WSP(float, WS_ADA); bf16* AY = WSP(bf16, WS_AY);
    const float* p_x = inp(F, 0); const float* p_ctx = inp(F, 2);
    f32x4 xv[8], xn[8];
    if (F.gw < RT) { const float* xr = F.gw < NLAT ? p_x + (size_t)F.gw * DM : p_ctx + (size_t)(F.gw - NLAT) * DM;
#pragma unroll
        for (int j = 0; j < 8; ++j) xv[j] = *(const f32x4*)(xr + j * 256 + F.lane * 4); }
    for (int row = F.gw; row < RT; row += F.NGW) {
        { const int rn = row + F.NGW; if (rn < RT) { const float* xr = rn < NLAT ? p_x + (size_t)rn * DM : p_ctx + (size_t)(rn - NLAT) * DM;
#pragma unroll
            for (int j = 0; j < 8; ++j) xn[j] = *(const f32x4*)(xr + j * 256 + F.lane * 4); } }
        const int v = row < NLAT ? (row >> 12) : 4;
        const float* sh = ADA + (size_t)v * ADAW; const float* sc = sh + 2048;
#pragma unroll
        for (int j = 0; j < 8; ++j) { const int col = j * 256 + F.lane * 4;
            const f32x4 x = xv[j], s1 = *(const f32x4*)(sc + col), s0 = *(const f32x4*)(sh + col);
            const f32x4 y = x * (s1 + 1.f) + s0;
            v2u o; o.x = pk2(y[0], y[1]); o.y = pk2(y[2], y[3]);
            *(v2u*)(AY + (size_t)row * DM + col) = o;
            if (row >= NLAT) *(f32x4*)(WSP(float, WS_X) + (size_t)row * DM + col) = x * ALPHA_RES; }
#pragma unroll
        for (int j = 0; j < 8; ++j) xv[j] = xn[j];
    }
}

__device__ __forceinline__ void phase_ln(const Fr& F, int l, int which, int nrows) {
    const float* ADA = WSP(float, WS_ADA); bf16* AY = WSP(bf16, WS_AY); float* X = WSP(float, WS_X);
    const float* lw = (which == 1 ? inp(F, 20) : inp(F, 24)) + (size_t)l * DM; const float* lb = (which == 1 ? inp(F, 21) : inp(F, 25)) + (size_t)l * DM;
    const bool last = (which == 2 && l == 1);
    const size_t aoff = which == 1 ? ((size_t)l * 5 * ADAW + 3 * 2048) : ((size_t)(l + 1) * 5 * ADAW);
    f32x4 v[8], vn[8], lwr[8], lbr[8];
#pragma unroll
    for (int j = 0; j < 8; ++j) { lwr[j] = *(const f32x4*)(lw + j * 256 + F.lane * 4); lbr[j] = *(const f32x4*)(lb + j * 256 + F.lane * 4); }
    if (F.gw < nrows) {
#pragma unroll
        for (int j = 0; j < 8; ++j) v[j] = *(const f32x4*)(X + (size_t)F.gw * DM + j * 256 + F.lane * 4); }
    for (int row = F.gw; row < nrows; row += F.NGW) {
        float* xr = X + (size_t)row * DM;
        if (row + F.NGW < nrows) {
#pragma unroll
            for (int j = 0; j < 8; ++j) vn[j] = *(const f32x4*)(xr + (size_t)F.NGW * DM + j * 256 + F.lane * 4); }
        float s = 0.f;
#pragma unroll
        for (int j = 0; j < 8; ++j) {
            if (which == 2 && l == 0 && row >= NLAT) v[j] = v[j] + *(const f32x4*)(WSP(float, WS_PART) + (size_t)(row - NLAT) * DM + j * 256 + F.lane * 4);
            s += (v[j][0] + v[j][1]) + (v[j][2] + v[j][3]); }
        const float mean = wave_sum(s) * (1.f / DM); float s2 = 0.f;
#pragma unroll
        for (int j = 0; j < 8; ++j) { v[j] = v[j] - mean; s2 += (v[j][0] * v[j][0] + v[j][1] * v[j][1]) + (v[j][2] * v[j][2] + v[j][3] * v[j][3]); }
        const float rstd = 1.f / sqrtf(wave_sum(s2) * (1.f / DM) + 1e-5f);
        const int vi = row < NLAT ? (row >> 12) : 4;
        const float* sh = ADA + aoff + (size_t)vi * ADAW; const float* sc = sh + 2048;
#pragma unroll
        for (int j = 0; j < 8; ++j) { const int col = j * 256 + F.lane * 4;
            const f32x4 y = v[j] * rstd * lwr[j] + lbr[j];
            if (last) { *(f32x4*)(F.out + (size_t)row * DM + col) = y; }
            else { *(f32x4*)(xr + col) = (which == 1) ? y * ALPHA_RES : y;
                const f32x4 a = y * (*(const f32x4*)(sc + col) + 1.f) + *(const f32x4*)(sh + col);
                v2u o; o.x = pk2(a[0], a[1]); o.y = pk2(a[2], a[3]);
                *(v2u*)(AY + (size_t)row * DM + col) = o; }
        }
#pragma unroll
        for (int j = 0; j < 8; ++j) v[j] = vn[j];
    }
}

__device__ __forceinline__ void phase_prep(const Fr& F, int l) {
    const bf16* Z = WSP(bf16, WS_ZH); bf16* GQKV = WSP(bf16, WS_GQKV); float* GB = WSP(float, WS_GB);
    bf16* QN = WSP(bf16, WS_QN); bf16* CKVN = WSP(bf16, WS_CKVN); bf16* KROPE = WSP(bf16, WS_KROPE);
    const float* cw = inp(F, 7) + (size_t)l * 5 * 1536;
    const float* p_alog = inp(F, 8); const float* p_dtb = inp(F, 9); const float* p_qnw = inp(F, 12); const float* p_kvnw = inp(F, 13);
    f32x4 cwr[3][5][2];
#pragma unroll
    for (int g = 0; g < 3; ++g)
#pragma unroll
        for (int i = 0; i < 5; ++i) { cwr[g][i][0] = *(const f32x4*)(cw + i * 1536 + g * 512 + F.lane * 8); cwr[g][i][1] = *(const f32x4*)(cw + i * 1536 + g * 512 + F.lane * 8 + 4); }
    for (int row = F.gw; row < RT; row += F.NGW) {
        const bf16* zr = Z + (size_t)row * ZP;
#pragma unroll
      for (int g = 0; g < 4; ++g) {
        if (g < 3) {
            int t, len; if (row < NLAT) { t = row & 4095; len = SEQ; } else { t = (row - NLAT) & 255; len = CTX; }
            const int c0 = g * 512 + F.lane * 8;
            float acc[8];
#pragma unroll
            for (int j = 0; j < 8; ++j) acc[j] = 0.f;
#pragma unroll
            for (int i = 0; i < 5; ++i) { const int tt = t + i - 2; const bool okt = (tt >= 0 && tt < len);
                {
                    v4u zv = *(const v4u*)(zr + (okt ? (ptrdiff_t)(i - 2) * ZP : (ptrdiff_t)0) + c0); if (!okt) zv = (v4u){0u, 0u, 0u, 0u};
                    const f32x4 w0 = cwr[g][i][0], w1 = cwr[g][i][1];
                    acc[0] += bflo(zv.x) * w0[0]; acc[1] += bfhi(zv.x) * w0[1]; acc[2] += bflo(zv.y) * w0[2]; acc[3] += bfhi(zv.y) * w0[3];
                    acc[4] += bflo(zv.z) * w1[0]; acc[5] += bfhi(zv.z) * w1[1]; acc[6] += bflo(zv.w) * w1[2]; acc[7] += bfhi(zv.w) * w1[3]; } }
            float ss = 0.f;
#pragma unroll
            for (int j = 0; j < 8; ++j) { acc[j] = siluf_(acc[j]); ss += acc[j] * acc[j]; }
            if (g < 2) {
                ss += __shfl_xor(ss, 1); ss += __shfl_xor(ss, 2); ss += __shfl_xor(ss, 4); ss += __shfl_xor(ss, 8);
                float inv = 1.f / sqrtf(ss + 1e-6f); if (g == 0) inv *= 0.08838834764831845f;
#pragma unroll
                for (int j = 0; j < 8; ++j) acc[j] *= inv;
            }
            v4u o; o.x = pk2(acc[0], acc[1]); o.y = pk2(acc[2], acc[3]); o.z = pk2(acc[4], acc[5]); o.w = pk2(acc[6], acc[7]);
            *(v4u*)(GQKV + (size_t)row * 1536 + c0) = o;
            if (g == 0 && F.lane < 16) {
                float r;
                if (F.lane < 8) { const float a = bf2f(zr[2048 + F.lane]); const float x = a + p_dtb[l * 8 + F.lane];
                    const float ee = __expf(-fabsf(x)); const float l1p = (ee < 0.03f) ? ee * (1.f - ee * (0.5f - ee * 0.33333333f)) : __logf(1.f + ee); const float sp = fmaxf(x, 0.f) + l1p;     r = -__expf(p_alog[l * 8 + F.lane]) * sp; }
                else r = sigmoidf_(bf2f(zr[2056 + F.lane - 8]));
                GB[(size_t)row * 16 + F.lane] = r;
            }
        } else {
            {
                const unsigned* p = (const unsigned*)(zr + C_MLA + F.lane * 6); const unsigned w0 = p[0], w1 = p[1], w2 = p[2];
                float x[6] = {bflo(w0), bfhi(w0), bflo(w1), bfhi(w1), bflo(w2), bfhi(w2)};
                float ss = 0.f;
#pragma unroll
                for (int j = 0; j < 6; ++j) ss += x[j] * x[j];
                const float inv = 1.f / sqrtf(wave_sum(ss) * (1.f / 384.f) + 1e-6f);
                const float* nw = p_qnw + l * 384 + F.lane * 6;
                unsigned* q = (unsigned*)(QN + (size_t)row * 384 + F.lane * 6);
                q[0] = pk2(x[0] * inv * nw[0], x[1] * inv * nw[1]); q[1] = pk2(x[2] * inv * nw[2], x[3] * inv * nw[3]); q[2] = pk2(x[4] * inv * nw[4], x[5] * inv * nw[5]);
            }
            {
                const v2u w = *(const v2u*)(zr + C_MLA + 384 + F.lane * 4);
                float x[4] = {bflo(w.x), bfhi(w.x), bflo(w.y), bfhi(w.y)};
                const float ss = x[0] * x[0] + x[1] * x[1] + x[2] * x[2] + x[3] * x[3];
                const float inv = 1.f / sqrtf(wave_sum(ss) * (1.f / 256.f) + 1e-6f);
                const float* nw = p_kvnw + l * 256 + F.lane * 4;
                v2u o; o.x = pk2(x[0] * inv * nw[0], x[1] * inv * nw[1]); o.y = pk2(x[2] * inv * nw[2], x[3] * inv * nw[3]);
                *(v2u*)(CKVN + (size_t)row * 256 + F.lane * 4) = o;
            }
            {
                const float x = bf2f(zr[C_MLA + 640 + F.lane]);
                const float pr = __shfl_xor(x, 1);
                float o = x;
                if (row < NLAT) { const int t = row & 4095, i = F.lane >> 1; const f32x2 rc = WSP(const f32x2, WS_ROPE)[t * 32 + i]; const float cs = rc[0], sn = rc[1];
                    o = (F.lane & 1) ? (pr * sn + x * cs) : (x * cs - pr * sn); }
                KROPE[(size_t)row * 64 + F.lane] = (bf16)f2bf(o);
            }
        }
      }
    }
    { bf16* NAVT = WSP(bf16, WS_NAVT);
      for (int tile = F.gw; tile < (RT / 64) * 8; tile += F.NGW) {
        const int r0 = (tile >> 3) * 64, c0 = (tile & 7) * 64;
        const bf16* zr = Z + (size_t)(r0 + F.lane) * ZP + C_NA + 1024 + c0;
        v4u v[8];
#pragma unroll
        for (int j = 0; j < 8; ++j) v[j] = *(const v4u*)(zr + 8 * j);
        bf16* dst = NAVT + (size_t)c0 * RT + r0 + F.lane;
#pragma unroll
        for (int j = 0; j < 8; ++j) {
            dst[(size_t)(8 * j + 0) * RT] = (bf16)(v[j].x & 0xffffu); dst[(size_t)(8 * j + 1) * RT] = (bf16)(v[j].x >> 16);
            dst[(size_t)(8 * j + 2) * RT] = (bf16)(v[j].y & 0xffffu); dst[(size_t)(8 * j + 3) * RT] = (bf16)(v[j].y >> 16);
            dst[(size_t)(8 * j + 4) * RT] = (bf16)(v[j].z & 0xffffu); dst[(size_t)(8 * j + 5) * RT] = (bf16)(v[j].z >> 16);
            dst[(size_t)(8 * j + 6) * RT] = (bf16)(v[j].w & 0xffffu); dst[(size_t)(8 * j + 7) * RT] = (bf16)(v[j].w >> 16); }
      } }
}

__device__ __forceinline__ void phase_post(const Fr& F, int l, int nrows) {
    const bf16* Z = WSP(bf16, WS_ZH); bf16* Y = WSP(bf16, WS_AY);
    const bf16* OG = (const bf16*)((const unsigned char*)F.out + OUT_OG); const bf16* OH = (const bf16*)((const unsigned char*)F.out + OUT_OH);
    const float* p_gnw = inp(F, 10) + l * 128; const float* p_hnw = inp(F, 18) + l * 128;
    if (F.G - 64 == 192) {
        const bf16* PO = WSP(bf16, WS_PO); const float* PML = WSP(float, WS_PML);
        for (int it = F.gw; it < 64 * 256; it += F.NGW) { const int su = it >> 8, r = it & 255, u = 192 + su, hh = (u >> 4) & 3, qb = u & 15;
            float m[3], lv[3];
#pragma unroll
            for (int p = 0; p < 3; ++p) { m[p] = PML[((size_t)(su * 3 + p) * 256 + r) * 2]; lv[p] = PML[((size_t)(su * 3 + p) * 256 + r) * 2 + 1]; }
            const float M = fmaxf(m[0], fmaxf(m[1], m[2]));
            float L = 0.f, o0 = 0.f, o1 = 0.f;
#pragma unroll
            for (int p = 0; p < 3; ++p) { const float wp = __builtin_amdgcn_exp2f(m[p] - M); L += wp * lv[p];
                const unsigned pv = *(const unsigned*)(PO + ((size_t)(su * 3 + p) * 256 + r) * 128 + F.lane * 2); o0 += wp * bflo(pv); o1 += wp * bfhi(pv); }
            const float inv = 1.f / L;
            *(unsigned*)(Y + (size_t)(3 * SEQ + qb * 256 + r) * DM + 1024 + hh * 128 + F.lane * 2) = pk2(o0 * inv, o1 * inv); }
    }
    float nwr[2][8];
#pragma unroll
    for (int j = 0; j < 8; ++j) { nwr[0][j] = p_gnw[(F.lane & 15) * 8 + j]; nwr[1][j] = p_hnw[(F.lane & 15) * 8 + j]; }
    for (int row = F.gw; row < nrows; row += F.NGW) {
#pragma unroll
      for (int which = 0; which < 2; ++which) {
        const bf16* O = which ? OH : OG;
        const v4u a = *(const v4u*)(O + (size_t)row * 512 + F.lane * 8), b = *(const v4u*)(O + (size_t)(RT + row) * 512 + F.lane * 8);
        const v4u gz = *(const v4u*)(Z + (size_t)row * ZP + (which ? (C_HG + 4 * 512) : 1536) + F.lane * 8);
        float o[8] = {bflo(a.x) + bflo(b.x), bfhi(a.x) + bfhi(b.x), bflo(a.y) + bflo(b.y), bfhi(a.y) + bfhi(b.y), bflo(a.z) + bflo(b.z), bfhi(a.z) + bfhi(b.z), bflo(a.w) + bflo(b.w), bfhi(a.w) + bfhi(b.w)};
        const float gt[8] = {bflo(gz.x), bfhi(gz.x), bflo(gz.y), bfhi(gz.y), bflo(gz.z), bfhi(gz.z), bflo(gz.w), bfhi(gz.w)};
        float ss = 0.f;
#pragma unroll
        for (int j = 0; j < 8; ++j) ss += o[j] * o[j];
        ss += __shfl_xor(ss, 1); ss += __shfl_xor(ss, 2); ss += __shfl_xor(ss, 4); ss += __shfl_xor(ss, 8);
        const float inv = 1.f / sqrtf(ss * (1.f / 128.f) + 1e-6f);
#pragma unroll
        for (int j = 0; j < 8; ++j) o[j] = o[j] * inv * nwr[which][j] * siluf_(gt[j]);
        v4u w; w.x = pk2(o[0], o[1]); w.y = pk2(o[2], o[3]); w.z = pk2(o[4], o[5]); w.w = pk2(o[6], o[7]);
        *(v4u*)(Y + (size_t)row * DM + (which ? 1536 : 0) + F.lane * 8) = w;
      }
    }
}

constexpr int SC_PR = 0, SC_VS = 64 * 288 * 4, SC_SC = SC_VS + 64 * 64 * 4, SC_OB = SC_SC + 64 * 16, SC_END = SC_OB + 64 * 64 * 4;
static_assert(SC_END <= 131072, "scan LDS");
template <int CTRL> __device__ __forceinline__ float dppf(float v) { return __builtin_bit_cast(float, __builtin_amdgcn_update_dpp(0, __builtin_bit_cast(int, v), CTRL, 0xF, 0xF, true)); }
__device__ __forceinline__ float reduce8(float v) { v += dppf<0xB1>(v); v += dppf<0x4E>(v); v += dppf<0x141>(v); return v; }

template <bool GDN>
__device__ __forceinline__ void scan_item(const Fr& F, int l, int item) {
    const int chain = item >> 1, ch = item & 1, b = chain >> 3, h = (chain >> 1) & 3, dir = chain & 1;
    const int tid = F.tid, slice = tid & 7, cl = tid >> 3;
    float* PR = (float*)(F.lds + SC_PR); float* VS = (float*)(F.lds + SC_VS); f32x4* SC = (f32x4*)(F.lds + SC_SC); float* OB = (float*)(F.lds + SC_OB);
    const bf16* Z = WSP(bf16, WS_ZH); const bf16* GQKV = WSP(bf16, WS_GQKV); const float* GB = WSP(float, WS_GB);
    bf16* O = (bf16*)((unsigned char*)F.out + (GDN ? OUT_OG : OUT_OH)) + (size_t)dir * RT * 512 + h * 128 + ch * 64;
    const bf16* srcA; const bf16* srcB; const bf16* srcV; int pitch;
    if (GDN) { pitch = 1536; srcA = GQKV + 512 + h * 128; srcB = GQKV + h * 128; srcV = GQKV + 1024 + h * 128 + ch * 64; }
    else { pitch = ZP; srcA = Z + C_HG + 512 * (1 + dir) + h * 128; srcB = Z + C_HG + h * 128; srcV = Z + C_HG + 3 * 512 + h * 128 + ch * 64; }
    float lbv[2][8];
    if (!GDN) { const float* p_lb = inp(F, 17);
#pragma unroll
        for (int i = 0; i < 2; ++i) { const int d0 = ((tid + 512 * i) & 15) * 8;
#pragma unroll
            for (int j = 0; j < 8; ++j) lbv[i][j] = (l == 0) ? 0.f : sigmoidf_(p_lb[512 + h * 128 + d0 + j] - p_lb[h * 128 + d0 + j]); }
    }
    float S[16];
#pragma unroll
    for (int j = 0; j < 16; ++j) S[j] = 0.f;
    v4u ra[2], rb[2], rv; float rg = 0.f, rbeta = 0.f;
    constexpr int NCH = (CTX + SEQ) / 64;
    int base = 0, sgn = 1;
#define SCAN_ROWS(c) do { const int gs = (c) * 64; if (gs < CTX) { base = NLAT + b * CTX + (dir ? (CTX - 1 - gs) : gs); } else { const int t = gs - CTX; base = b * SEQ + (dir ? (SEQ - 1 - t) : t); } sgn = dir ? -1 : 1; } while (0)
#define SCAN_LOAD() do { _Pragma("unroll") for (int i = 0; i < 2; ++i) { const int p = tid + 512 * i, s = p >> 4, d0 = (p & 15) * 8; const size_t ro = (size_t)(base + sgn * s) * pitch + d0; \
        ra[i] = *(const v4u*)(srcA + ro); rb[i] = *(const v4u*)(srcB + ro); } \
        { const int s = tid >> 3, c0 = (tid & 7) * 8; rv = *(const v4u*)(srcV + (size_t)(base + sgn * s) * pitch + c0); } \
        if (GDN && tid < 64) { const size_t ro = (size_t)(base + sgn * tid) * 16 + dir * 4 + h; rg = GB[ro]; rbeta = GB[ro + 8]; } } while (0)
#define SCAN_STORE() do { _Pragma("unroll") for (int i = 0; i < 2; ++i) { const int p = tid + 512 * i, s = p >> 4, d0 = (p & 15) * 8; \
        float av[8] = {bflo(ra[i].x), bfhi(ra[i].x), bflo(ra[i].y), bfhi(ra[i].y), bflo(ra[i].z), bfhi(ra[i].z), bflo(ra[i].w), bfhi(ra[i].w)}; \
        float bv[8] = {bflo(rb[i].x), bfhi(rb[i].x), bflo(rb[i].y), bfhi(rb[i].y), bflo(rb[i].z), bfhi(rb[i].z), bflo(rb[i].w), bfhi(rb[i].w)}; \
        if (!GDN) { _Pragma("unroll") for (int j = 0; j < 8; ++j) { av[j] = lbv[i][j] + (1.f - lbv[i][j]) * sigmoidf_(av[j]); bv[j] = siluf_(bv[j]) * 0.08838834764831845f; } } \
        float* dst = PR + s * 288 + (d0 >> 4) * 36 + (d0 & 15) * 2; \
        _Pragma("unroll") for (int j = 0; j < 4; ++j) *(f32x4*)(dst + 4 * j) = (f32x4){av[2 * j], bv[2 * j], av[2 * j + 1], bv[2 * j + 1]}; } \
        { const int s = tid >> 3, c0 = (tid & 7) * 8; float* dv = VS + s * 64 + c0; \
          *(f32x4*)dv = (f32x4){bflo(rv.x), bfhi(rv.x), bflo(rv.y), bfhi(rv.y)}; *(f32x4*)(dv + 4) = (f32x4){bflo(rv.z), bfhi(rv.z), bflo(rv.w), bfhi(rv.w)}; } \
        if (GDN && tid < 64) { float* sc = (float*)(SC + tid); sc[0] = __expf(rg); sc[1] = rbeta; } } while (0)
#define SCAN_QK() do { if (GDN) { _Pragma("unroll") for (int e = 0; e < 8; ++e) { const int s = F.wave * 8 + e; const f32x4 kq = *(const f32x4*)(PR + s * 288 + (F.lane >> 3) * 36 + (F.lane & 7) * 4); \
        const float d = wave_sum(kq[0] * kq[1] + kq[2] * kq[3]); if (F.lane == 0) ((float*)(SC + s))[2] = d; } } } while (0)

    SCAN_ROWS(0); SCAN_LOAD(); SCAN_STORE(); __syncthreads(); SCAN_QK(); __syncthreads();
    const float* prs = PR + slice * 36;
    for (int c = 0; c < NCH; ++c) {
        const int obase = base, osgn = sgn;
        if (c + 1 < NCH) { SCAN_ROWS(c + 1); SCAN_LOAD(); }
        f32x4 cur[8];
#pragma unroll
        for (int i = 0; i < 8; ++i) cur[i] = *(const f32x4*)(prs + i * 4);
        f32x4 scv = SC[0]; float vv = VS[cl];
#pragma unroll 2
        for (int s = 0; s < 64; ++s) {
            f32x4 nxt[8]; f32x4 nsc; float nvv;
            const int sn = (s + 1) & 63;
#pragma unroll
            for (int i = 0; i < 8; ++i) nxt[i] = *(const f32x4*)(prs + sn * 288 + i * 4);
            nsc = SC[sn]; nvv = VS[sn * 64 + cl];
            float o;
            if (GDN) {
                float pk = 0.f, pq = 0.f;
#pragma unroll
                for (int i = 0; i < 8; ++i) { pk += cur[i][0] * S[2 * i]; pq += cur[i][1] * S[2 * i]; pk += cur[i][2] * S[2 * i + 1]; pq += cur[i][3] * S[2 * i + 1]; }
                pk = reduce8(pk); pq = reduce8(pq);
                const float a = scv[0], u = scv[1] * (vv - a * pk);
                o = a * pq + scv[2] * u;
#pragma unroll
                for (int i = 0; i < 8; ++i) { S[2 * i] = a * S[2 * i] + cur[i][0] * u; S[2 * i + 1] = a * S[2 * i + 1] + cur[i][2] * u; }
            } else {
                float po = 0.f;
#pragma unroll
                for (int i = 0; i < 8; ++i) { const float f0 = cur[i][0], f1 = cur[i][2];
                    S[2 * i] = f0 * S[2 * i] + (1.f - f0) * vv; S[2 * i + 1] = f1 * S[2 * i + 1] + (1.f - f1) * vv;
                    po += cur[i][1] * S[2 * i]; po += cur[i][3] * S[2 * i + 1]; }
                o = reduce8(po);
            }
            if (slice == 0) OB[s * 64 + cl] = o;
#pragma unroll
            for (int i = 0; i < 8; ++i) cur[i] = nxt[i];
            scv = nsc; vv = nvv;
        }
        __syncthreads();
        {
            const int s = tid >> 3, c0 = (tid & 7) * 8; const float* ob = OB + s * 64 + c0;
            const f32x4 x0 = *(const f32x4*)ob, x1 = *(const f32x4*)(ob + 4);
            v4u w; w.x = pk2(x0[0], x0[1]); w.y = pk2(x0[2], x0[3]); w.z = pk2(x1[0], x1[1]); w.w = pk2(x1[2], x1[3]);
            *(v4u*)(O + (size_t)(obase + osgn * s) * 512 + c0) = w;
        }
        if (c + 1 < NCH) SCAN_STORE();
        __syncthreads();
        if (c + 1 < NCH) SCAN_QK();
        __syncthreads();
    }
#undef SCAN_ROWS
#undef SCAN_LOAD
#undef SCAN_STORE
#undef SCAN_QK
}

__device__ __forceinline__ unsigned cvtpk(float lo, float hi) { unsigned r; asm volatile("v_cvt_pk_bf16_f32 %0, %1, %2" : "=v"(r) : "v"(lo), "v"(hi)); return r; }
template <int DQK, bool NA>
__device__ __forceinline__ void attn_unit(const Fr& F, const bf16* Qh, int qpitch, int qrow0, bool qrope,
                                          const bf16* K1h, int k1pitch, const bf16* Vth,
                                          int kbase0, int n0, int kbase1, int ntiles, bf16* Yh, float sl2, int lo, int qgr, const float* rpbh, int pidx) {
    const bf16* K2 = WSP(bf16, WS_KROPE);
    constexpr int NDC = DQK / 32, KPB = (DQK + 16) * 2, KBUF = 64 * KPB, VPB = 160, VBUF = 128 * VPB,     BUF = KBUF + VBUF, PPR = DQK / 8, NKP = 64 * PPR / 512;
    static_assert(2 * BUF + 2048 <= 131072, "attn LDS");
    unsigned char* lds = F.lds;
    float* bt = (float*)(lds + 2 * BUF);
    const int tid = F.tid, lane = F.lane, w = F.wave, r16 = lane & 15, quad = lane >> 4;
    if (NA) { for (int i = tid; i < 15 * 32; i += 512) { const int dr = i >> 5, dc = i & 31; bt[i] = (rpbh != nullptr && dc < 31) ? rpbh[dr * 31 + dc] * LOG2E : 0.f; } }
    bf16x8 qf[2][NDC];
#pragma unroll
    for (int n = 0; n < 2; ++n) { const int row = qrow0 + w * 32 + n * 16 + r16;
#pragma unroll
        for (int dc = 0; dc < NDC; ++dc) qf[n][dc] = *(const bf16x8*)(Qh + (size_t)row * qpitch + dc * 32 + quad * 8);
        if (!NA && qrope) { const int t = row & 4095;
#pragma unroll
            for (int dc = 4; dc < NDC; ++dc) {
#pragma unroll
                for (int jj = 0; jj < 4; ++jj) { const f32x2 rc = WSP(const f32x2, WS_ROPE)[t * 32 + (dc - 4) * 16 + quad * 4 + jj]; const float cs = rc[0], sn = rc[1];
                    const float x1 = bf2f((unsigned short)qf[n][dc][2 * jj]), x2 = bf2f((unsigned short)qf[n][dc][2 * jj + 1]);
                    qf[n][dc][2 * jj] = (short)f2bf(x1 * cs - x2 * sn); qf[n][dc][2 * jj + 1] = (short)f2bf(x1 * sn + x2 * cs); } } }
    }
    f32x4 o[8][2];
#pragma unroll
    for (int dt = 0; dt < 8; ++dt) { o[dt][0] = (f32x4){0.f, 0.f, 0.f, 0.f}; o[dt][1] = (f32x4){0.f, 0.f, 0.f, 0.f}; }
    float mrun[2] = {-1e30f, -1e30f}, lsum[2] = {0.f, 0.f};
    v4u kreg[NKP], vreg[2];
    const int gr = qgr + (w >> 1);
    const int w0 = min(max(gr - 4, 0), 56);
#define AT_KROW(i) ((i) < n0 ? kbase0 + 64 * (i) : kbase1 + 64 * ((i) - n0))
#define AT_LOADK(i) do { const int kr0 = AT_KROW(i); _Pragma("unroll") for (int x = 0; x < NKP; ++x) { const int p = tid + 512 * x, key = p / PPR, pc = p % PPR; \
        const bf16* src = (pc < 16) ? K1h + (size_t)(kr0 + key) * k1pitch + pc * 8 : K2 + (size_t)(kr0 + key) * 64 + (pc - 16) * 8; kreg[x] = *(const v4u*)src; } } while (0)
#define AT_LOADV(i) do { const int kr0 = AT_KROW(i); _Pragma("unroll") for (int x = 0; x < 2; ++x) { const int p = tid + 512 * x, d = p >> 3, pc = p & 7; vreg[x] = *(const v4u*)(Vth + (size_t)d * RT + kr0 + pc * 8); } } while (0)
#define AT_STOREK(buf) do { _Pragma("unroll") for (int x = 0; x < NKP; ++x) { const int p = tid + 512 * x, key = p / PPR, pc = p % PPR; \
        const int slot = (key & 32) + ((key >> 2) & 1) * 16 + ((key & 31) >> 3) * 4 + (key & 3); *(v4u*)(lds + (buf) * BUF + slot * KPB + pc * 16) = kreg[x]; } } while (0)
#define AT_STOREV(buf) do { _Pragma("unroll") for (int x = 0; x < 2; ++x) { const int p = tid + 512 * x, d = p >> 3, pc = p & 7; *(v4u*)(lds + (buf) * BUF + KBUF + d * VPB + pc * 16) = vreg[x]; } } while (0)
    AT_LOADK(0); AT_LOADV(0); AT_STOREK(0); AT_STOREV(0); __syncthreads();
    for (int i = 0; i < ntiles; ++i) {
        int tid = F.tid; asm volatile("" : "+v"(tid));
        if (i + 1 < ntiles) AT_LOADK(i + 1);
        const bool win = NA && (i < n0);
        const int kr = lo + i;
        const bool active = !win || (kr >= w0 && kr < w0 + 8);
        const unsigned char* kb = lds + (i & 1) * BUF; const unsigned char* vb = kb + KBUF;
#pragma unroll
        for (int sub = 0; sub < 2; ++sub) {
            if (sub == 1 && i + 1 < ntiles) { AT_STOREK((i + 1) & 1); AT_LOADV(i + 1); }
            if (active) {
                f32x4 s[2][2];
                __builtin_amdgcn_s_setprio(1);
#pragma unroll
                for (int t = 0; t < 2; ++t) { s[t][0] = (f32x4){0.f, 0.f, 0.f, 0.f}; s[t][1] = (f32x4){0.f, 0.f, 0.f, 0.f};
                    if (!NA && t == 1) asm volatile("" ::: "memory");
#pragma unroll
                    for (int dc = 0; dc < NDC; ++dc) { const bf16x8 a = *(const bf16x8*)(kb + (sub * 32 + t * 16 + r16) * KPB + dc * 64 + quad * 16);
                        s[t][0] = __builtin_amdgcn_mfma_f32_16x16x32_bf16(a, qf[0][dc], s[t][0], 0, 0, 0);
                        s[t][1] = __builtin_amdgcn_mfma_f32_16x16x32_bf16(a, qf[1][dc], s[t][1], 0, 0, 0); } }
                __builtin_amdgcn_s_setprio(0);
                bf16x8 pb[2];
#pragma unroll
                for (int n = 0; n < 2; ++n) {
                    float mx = -1e30f;
                    const int qc = (w & 1) * 32 + n * 16 + r16; const int c0 = min(max(qc - 8, 0), 48);
#pragma unroll
                    for (int t = 0; t < 2; ++t)
#pragma unroll
                        for (int j = 0; j < 4; ++j) { float x = s[t][n][j] * sl2;
                            if (win) { const int kc = sub * 32 + quad * 8 + t * 4 + j; const bool ok = (kc >= c0) && (kc < c0 + 16);
                                const int dcc = min(max(kc - qc + 15, 0), 30); const float bb = bt[(kr - gr + 7) * 32 + dcc]; x = ok ? x + bb : -1e30f; }
                            s[t][n][j] = x; mx = fmaxf(mx, x); }
                    mx = fmaxf(mx, __shfl_xor(mx, 16)); mx = fmaxf(mx, __shfl_xor(mx, 32));
                    const float mnew = fmaxf(mrun[n], mx), alpha = __builtin_amdgcn_exp2f(mrun[n] - mnew); mrun[n] = mnew;
                    float ps = 0.f;
#pragma unroll
                    for (int t = 0; t < 2; ++t)
#pragma unroll
                        for (int j = 0; j < 4; ++j) { const float p = __builtin_amdgcn_exp2f(s[t][n][j] - mnew); s[t][n][j] = p; ps += p; }
                    lsum[n] = lsum[n] * alpha + ps;
#pragma unroll
                    for (int dt = 0; dt < 8; ++dt) o[dt][n] = o[dt][n] * alpha;
                    v4u u; u.x = cvtpk(s[0][n][0], s[0][n][1]); u.y = cvtpk(s[0][n][2], s[0][n][3]); u.z = cvtpk(s[1][n][0], s[1][n][1]); u.w = cvtpk(s[1][n][2], s[1][n][3]);
                    pb[n] = __builtin_bit_cast(bf16x8, u);
                }
                __builtin_amdgcn_s_setprio(1);
#pragma unroll
                for (int dt = 0; dt < 8; ++dt) { const bf16x8 a = *(const bf16x8*)(vb + (dt * 16 + r16) * VPB + sub * 64 + quad * 16);
                    o[dt][0] = __builtin_amdgcn_mfma_f32_16x16x32_bf16(a, pb[0], o[dt][0], 0, 0, 0);
                    o[dt][1] = __builtin_amdgcn_mfma_f32_16x16x32_bf16(a, pb[1], o[dt][1], 0, 0, 0); }
                __builtin_amdgcn_s_setprio(0);
            }
        }
        if (i + 1 < ntiles) AT_STOREV((i + 1) & 1);
        __syncthreads();
    }
#pragma unroll
    for (int n = 0; n < 2; ++n) { float lt = lsum[n]; lt += __shfl_xor(lt, 16); lt += __shfl_xor(lt, 32);
        const bool part = (pidx >= 0); const float inv = part ? 1.f : 1.f / lt;
        bf16* PO = WSP(bf16, WS_PO) + (size_t)pidx * 256 * 128; float* PML = WSP(float, WS_PML) + (size_t)pidx * 512;
        const int rl = w * 32 + n * 16 + r16, row = qrow0 + rl;
        bf16* dst = part ? PO + (size_t)rl * 128 + quad * 4 : Yh + (size_t)row * DM + quad * 4;
#pragma unroll
        for (int dt = 0; dt < 8; ++dt) { const f32x4 v = o[dt][n] * inv; v2u u; u.x = cvtpk(v[0], v[1]); u.y = cvtpk(v[2], v[3]); *(v2u*)(dst + dt * 16) = u; }
        if (part && quad == 0) { PML[rl * 2] = mrun[n]; PML[rl * 2 + 1] = lt; } }
#undef AT_KROW
#undef AT_LOADK
#undef AT_LOADV
#undef AT_STOREK
#undef AT_STOREV
}


typedef short s16x4 __attribute__((ext_vector_type(4)));
typedef short v4i16_t __attribute__((ext_vector_type(4)));
__device__ __forceinline__ s16x4 ldtr(const unsigned char* p) { return __builtin_bit_cast(s16x4, __builtin_amdgcn_ds_read_tr16_b64_v4i16((LAS v4i16_t*)p)); }
__device__ __forceinline__ bf16x8 cat8(s16x4 a, s16x4 b) { return __builtin_shufflevector(a, b, 0, 1, 2, 3, 4, 5, 6, 7); }
__device__ __forceinline__ bf16x8 pack8(f32x4 a, f32x4 b) { v4u u; u.x = cvtpk(a[0], a[1]); u.y = cvtpk(a[2], a[3]); u.z = cvtpk(b[0], b[1]); u.w = cvtpk(b[2], b[3]); return __builtin_bit_cast(bf16x8, u); }
constexpr int NCHK = (CTX + SEQ) / 64;
__device__ __forceinline__ int chunk_row_lo(int b, int dir, int c) {
    const int gs = c * 64;
    if (gs < CTX) return NLAT + b * CTX + (dir ? (CTX - 64 - gs) : gs);
    const int t = gs - CTX; return b * SEQ + (dir ? (SEQ - 64 - t) : t);
}

__device__ __forceinline__ void hg_lb(const Fr& F, int l, int h, float (&lbv)[8]) {
    const float* p_lb = inp(F, 17); const int d0 = (F.tid & 15) * 8;
#pragma unroll
    for (int j = 0; j < 8; ++j) lbv[j] = (l == 0) ? 0.f : sigmoidf_(p_lb[512 + h * 128 + d0 + j] - p_lb[h * 128 + d0 + j]);
}
__device__ __forceinline__ void hg_load_qf(const Fr& F, int cid, v4u (&ra)[2], v4u (&rb)[2]) {
    const int chain = cid / NCHK, c = cid % NCHK, b = chain >> 3, h = (chain >> 1) & 3, dir = chain & 1; const int row_lo = chunk_row_lo(b, dir, c);
    const bf16* Z = WSP(bf16, WS_ZH);
#pragma unroll
    for (int i = 0; i < 2; ++i) { const int p = F.tid + 512 * i, m = p >> 4, d0 = (p & 15) * 8;
        const bf16* zr = Z + (size_t)(row_lo + m) * ZP + C_HG + h * 128 + d0; ra[i] = *(const v4u*)(zr + 512 * (1 + dir)); rb[i] = *(const v4u*)zr; }
}
__device__ __forceinline__ void hg_compute_qf(const float (&lbv)[8], const v4u (&ra)[2], const v4u (&rb)[2], float (&qv)[2][8], float (&fv)[2][8]) {
#pragma unroll
    for (int i = 0; i < 2; ++i) { const v4u a = ra[i], b = rb[i];
        const float av[8] = {bflo(a.x), bfhi(a.x), bflo(a.y), bfhi(a.y), bflo(a.z), bfhi(a.z), bflo(a.w), bfhi(a.w)};
        const float bv[8] = {bflo(b.x), bfhi(b.x), bflo(b.y), bfhi(b.y), bflo(b.z), bfhi(b.z), bflo(b.w), bfhi(b.w)};
#pragma unroll
        for (int j = 0; j < 8; ++j) { const float lb = lbv[j]; fv[i][j] = lb + (1.f - lb) * sigmoidf_(av[j]); qv[i][j] = siluf_(bv[j]) * 0.08838834764831845f; } }
}
template <int LP> __device__ __forceinline__ void time_cumsum(const Fr& F, float* Lm, float* SEG, int dir) {
    const int d = F.tid & 127, seg = F.tid >> 7;
    float s = 0.f;
#pragma unroll
    for (int i = 0; i < 16; ++i) { const int t = seg * 16 + i, m = dir ? 63 - t : t; s += Lm[m * LP + d]; Lm[m * LP + d] = s; }
    SEG[seg * 128 + d] = s;
    LDS_BARRIER();
    float off = 0.f;
#pragma unroll
    for (int j = 0; j < 3; ++j) if (j < seg) off += SEG[j * 128 + d];
    if (seg > 0) {
#pragma unroll
        for (int i = 0; i < 16; ++i) { const int t = seg * 16 + i, m = dir ? 63 - t : t; Lm[m * LP + d] += off; } }
    LDS_BARRIER();
}
constexpr int HP = 132;
__device__ __forceinline__ void hg_scores(const Fr& F, int l, int cid, int cid_next, v4u (&ra)[2], v4u (&rb)[2]) {
    const int chain = cid / NCHK, h = (chain >> 1) & 3, dir = chain & 1;
    float* Q_ = (float*)F.lds; float* K_ = Q_ + 64 * HP; float* L_ = K_ + 64 * HP; float* SEG = L_ + 64 * HP;
    bf16* SCG = WSP(bf16, WS_HSC) + (size_t)cid * 4096;
    float qv[2][8], fv[2][8];
    {
        float lbv[8];
        hg_lb(F, l, h, lbv);
        hg_compute_qf(lbv, ra, rb, qv, fv);
        if (cid_next < 32 * NCHK) hg_load_qf(F, cid_next, ra, rb);
#pragma unroll
        for (int i = 0; i < 2; ++i) { const int p = F.tid + 512 * i, m = p >> 4, d0 = (p & 15) * 8;
#pragma unroll
            for (int j = 0; j < 8; ++j) { Q_[m * HP + d0 + j] = qv[i][j]; K_[m * HP + d0 + j] = 1.f - fv[i][j]; L_[m * HP + d0 + j] = __logf(fv[i][j]); } }
    }
    LDS_BARRIER();
    time_cumsum<HP>(F, L_, SEG, dir);
    {
        const int mlast = dir ? 0 : 63;
        bf16* QDG = WSP(bf16, WS_HQD) + (size_t)cid * 8192;
        bf16* KEG = (cid < 1664) ? (bf16*)((unsigned char*)F.out + OUT_HKE) + (size_t)cid * 8192 : WSP(bf16, WS_HKE2) + (size_t)(cid - 1664) * 8192;
#pragma unroll
        for (int i = 0; i < 2; ++i) { const int p = F.tid + 512 * i, m = p >> 4, d0 = (p & 15) * 8;
            float qd[8], ke[8];
#pragma unroll
            for (int j = 0; j < 8; ++j) { const float Lv = L_[m * HP + d0 + j], Lt = L_[mlast * HP + d0 + j]; qd[j] = qv[i][j] * __expf(Lv); ke[j] = (1.f - fv[i][j]) * __expf(Lt - Lv); }
            v4u o; o.x = cvtpk(qd[0], qd[1]); o.y = cvtpk(qd[2], qd[3]); o.z = cvtpk(qd[4], qd[5]); o.w = cvtpk(qd[6], qd[7]); *(v4u*)(QDG + m * 128 + d0) = o;
            o.x = cvtpk(ke[0], ke[1]); o.y = cvtpk(ke[2], ke[3]); o.z = cvtpk(ke[4], ke[5]); o.w = cvtpk(ke[6], ke[7]); *(v4u*)(KEG + m * 128 + d0) = o; }
        if (F.tid < 128) WSP(float, WS_HDL)[(size_t)cid * 128 + F.tid] = __expf(L_[mlast * HP + F.tid]);
    }
    const int lane = F.lane, r16 = lane & 15, quad = lane >> 4;
    for (int p = F.wave; p < 16; p += 8) {
        int ip, jp;
        if (p < 10) { ip = (p >= 6) ? 3 : (p >= 3) ? 2 : (p >= 1) ? 1 : 0; jp = p - ip * (ip + 1) / 2; }
        else { const int r = p - 10; ip = (r >= 5) ? 2 : (r >= 3) ? 1 : 0; jp = (r >= 5) ? 3 : (r >= 3) ? (r - 3 + 2) : (r + 1); }
        const int i = dir ? 3 - ip : ip, j = dir ? 3 - jp : jp;
        f32x4 acc = (f32x4){0.f, 0.f, 0.f, 0.f};
        if (p < 10) {
            const int mt = 16 * i + r16, ms = 16 * j + r16, mref = dir ? 16 * i + 15 : 16 * i;
#pragma unroll
            for (int dk = 0; dk < 4; ++dk) { const int d0 = dk * 32 + quad * 8;
                float av[8], bv[8];
#pragma unroll
                for (int hh = 0; hh < 2; ++hh) { const f32x4 q4 = *(const f32x4*)(Q_ + mt * HP + d0 + 4 * hh), lt = *(const f32x4*)(L_ + mt * HP + d0 + 4 * hh), lr = *(const f32x4*)(L_ + mref * HP + d0 + 4 * hh);
                    const f32x4 k4 = *(const f32x4*)(K_ + ms * HP + d0 + 4 * hh), ls = *(const f32x4*)(L_ + ms * HP + d0 + 4 * hh);
#pragma unroll
                    for (int e = 0; e < 4; ++e) { av[4 * hh + e] = q4[e] * __expf(lt[e] - lr[e]); bv[4 * hh + e] = k4[e] * __expf(fminf(lr[e] - ls[e], 85.f)); } }
                v4u ua, ub; ua.x = cvtpk(av[0], av[1]); ua.y = cvtpk(av[2], av[3]); ua.z = cvtpk(av[4], av[5]); ua.w = cvtpk(av[6], av[7]);
                ub.x = cvtpk(bv[0], bv[1]); ub.y = cvtpk(bv[2], bv[3]); ub.z = cvtpk(bv[4], bv[5]); ub.w = cvtpk(bv[6], bv[7]);
                acc = __builtin_amdgcn_mfma_f32_16x16x32_bf16(__builtin_bit_cast(bf16x8, ua), __builtin_bit_cast(bf16x8, ub), acc, 0, 0, 0); }
        }
        const int ms = 16 * j + r16;
#pragma unroll
        for (int e = 0; e < 4; ++e) { const int mt = 16 * i + 4 * quad + e; const bool ok = (p < 10) && (dir ? (ms >= mt) : (ms <= mt));
            SCG[mt * 64 + ms] = (bf16)f2bf(ok ? acc[e] : 0.f); }
    }
    LDS_BARRIER();
}

constexpr int HS_DL = 0, HS_QD = 512, HS_KE = HS_QD + 64 * 272, HS_V = HS_KE + 64 * 272, HS_SC = HS_V + 64 * 272, HS_END = HS_SC + 64 * 144;
static_assert(HS_END <= 131072, "hgrn seq LDS");
__device__ __forceinline__ void hg_seq(const Fr& F, int l, int chain) {
    const int b = chain >> 3, h = (chain >> 1) & 3, dir = chain & 1;
    const int tid = F.tid, lane = F.lane, w = F.wave, r16 = lane & 15, quad = lane >> 4, tq = (lane & 15) >> 2, tp = lane & 3;
    unsigned char* lds = F.lds;
    float* DL = (float*)(lds + HS_DL);
    const bf16* Z = WSP(bf16, WS_ZH);
    bf16* O = (bf16*)((unsigned char*)F.out + OUT_OH) + (size_t)dir * RT * 512 + h * 128 + 16 * w + r16;
    f32x4 S[8];
#pragma unroll
    for (int dt = 0; dt < 8; ++dt) S[dt] = (f32x4){0.f, 0.f, 0.f, 0.f};
    v4u rQ[2], rK[2], rV[2], rS; float rD = 0.f;
#define HS_LOAD(c) do { const int cid = chain * NCHK + (c); const int rl = chunk_row_lo(b, dir, (c)); \
        const bf16* QDG = WSP(bf16, WS_HQD) + (size_t)cid * 8192; \
        const bf16* KEG = (cid < 1664) ? (const bf16*)((const unsigned char*)F.out + OUT_HKE) + (size_t)cid * 8192 : WSP(bf16, WS_HKE2) + (size_t)(cid - 1664) * 8192; \
        _Pragma("unroll") for (int i = 0; i < 2; ++i) { const int p = tid + 512 * i, m = p >> 4, d0 = (p & 15) * 8; rQ[i] = *(const v4u*)(QDG + m * 128 + d0); rK[i] = *(const v4u*)(KEG + m * 128 + d0); \
            rV[i] = *(const v4u*)(Z + (size_t)(rl + m) * ZP + C_HG + 3 * 512 + h * 128 + d0); } \
        rS = *(const v4u*)(WSP(bf16, WS_HSC) + (size_t)cid * 4096 + tid * 8); \
        if (tid < 128) rD = WSP(float, WS_HDL)[(size_t)cid * 128 + tid]; } while (0)
    HS_LOAD(0);
    for (int c = 0; c < NCHK; ++c) {
        const int row_lo = chunk_row_lo(b, dir, c);
#pragma unroll
        for (int i = 0; i < 2; ++i) { const int p = tid + 512 * i, m = p >> 4, d0 = (p & 15) * 8;
            *(v4u*)(lds + HS_QD + m * 272 + d0 * 2) = rQ[i]; *(v4u*)(lds + HS_KE + m * 272 + d0 * 2) = rK[i]; *(v4u*)(lds + HS_V + m * 272 + d0 * 2) = rV[i]; }
        { const int m = tid >> 3, c0 = (tid & 7) * 8; *(v4u*)(lds + HS_SC + m * 144 + c0 * 2) = rS; }
        if (tid < 128) DL[tid] = rD;
        if (c + 1 < NCHK) HS_LOAD(c + 1);
        LDS_BARRIER();
        bf16x8 vb[2], sb[4];
#pragma unroll
        for (int ks = 0; ks < 2; ++ks) { const unsigned char* p0 = lds + HS_V + (32 * ks + 8 * quad + tq) * 272 + (16 * w + 4 * tp) * 2; vb[ks] = cat8(ldtr(p0), ldtr(p0 + 4 * 272)); }
#pragma unroll
        for (int ks = 0; ks < 4; ++ks) sb[ks] = pack8(S[2 * ks], S[2 * ks + 1]);
#pragma unroll
        for (int i = 0; i < 4; ++i) {
            f32x4 acc = (f32x4){0.f, 0.f, 0.f, 0.f};
            const unsigned char* qrow = lds + HS_QD + (16 * i + r16) * 272;
#pragma unroll
            for (int ks = 0; ks < 4; ++ks) { const bf16x8 a = cat8(*(const s16x4*)(qrow + (32 * ks + 4 * quad) * 2), *(const s16x4*)(qrow + (32 * ks + 16 + 4 * quad) * 2));
                acc = __builtin_amdgcn_mfma_f32_16x16x32_bf16(a, sb[ks], acc, 0, 0, 0); }
            const unsigned char* srow = lds + HS_SC + (16 * i + r16) * 144;
#pragma unroll
            for (int ks = 0; ks < 2; ++ks) { const bf16x8 a = *(const bf16x8*)(srow + (32 * ks + 8 * quad) * 2); acc = __builtin_amdgcn_mfma_f32_16x16x32_bf16(a, vb[ks], acc, 0, 0, 0); }
#pragma unroll
            for (int e = 0; e < 4; ++e) O[(size_t)(row_lo + 16 * i + 4 * quad + e) * 512] = (bf16)f2bf(acc[e]);
        }
#pragma unroll
        for (int dt = 0; dt < 8; ++dt) {
            const f32x4 dl = *(const f32x4*)(DL + 16 * dt + 4 * quad);
            f32x4 acc = S[dt] * dl;
#pragma unroll
            for (int ks = 0; ks < 2; ++ks) { const unsigned char* p0 = lds + HS_KE + (32 * ks + 8 * quad + tq) * 272 + (16 * dt + 4 * tp) * 2;
                acc = __builtin_amdgcn_mfma_f32_16x16x32_bf16(cat8(ldtr(p0), ldtr(p0 + 4 * 272)), vb[ks], acc, 0, 0, 0); }
            S[dt] = acc;
        }
        LDS_BARRIER();
    }
#undef HS_LOAD
}

__device__ __forceinline__ void gd_pre(const Fr& F, int cid) {
    const int chain = cid / NCHK, c = cid % NCHK, b = chain >> 3, h = (chain >> 1) & 3, dir = chain & 1;
    const int row_lo = chunk_row_lo(b, dir, c), lane = F.lane, r16 = lane & 15, quad = lane >> 4;
    float* Af = (float*)(F.lds + F.wave * 16896);
    float* cumL = Af + 4096; float* betaL = cumL + 64;
    const bf16* GQKV = WSP(bf16, WS_GQKV); const float* GB = WSP(float, WS_GB);
    bf16* T1G = (bf16*)((unsigned char*)F.out + OUT_GT) + (size_t)cid * 2 * 4096; bf16* ATG = T1G + 4096;
    float* SCL = WSP(float, WS_GSCAL) + (size_t)cid * 132;
    const float g = GB[(size_t)(row_lo + lane) * 16 + dir * 4 + h], beta = GB[(size_t)(row_lo + lane) * 16 + 8 + dir * 4 + h];
    float cum = g;
#pragma unroll
    for (int off = 1; off < 64; off <<= 1) { const float v = dir ? __shfl_down(cum, off) : __shfl_up(cum, off); const bool ok = dir ? (lane + off < 64) : (lane >= off); if (ok) cum += v; }
    cumL[lane] = cum; betaL[lane] = beta;
    const float last = __shfl(cum, dir ? 0 : 63);
    SCL[lane] = __expf(cum); SCL[64 + lane] = __expf(last - cum); if (lane == 0) SCL[128] = __expf(last);
    LDS_WAIT();
#pragma unroll 1
    for (int i = 0; i < 4; ++i) {
        bf16x8 qf[4], kfi[4];
#pragma unroll
        for (int dk = 0; dk < 4; ++dk) { const bf16* gr = GQKV + (size_t)(row_lo + 16 * i + r16) * 1536 + h * 128 + dk * 32 + quad * 8; qf[dk] = *(const bf16x8*)gr; kfi[dk] = *(const bf16x8*)(gr + 512); }
#pragma unroll 1
        for (int j2 = 0; j2 < 2; ++j2) {
            bf16x8 kfj[2][4];
#pragma unroll
            for (int jj = 0; jj < 2; ++jj)
#pragma unroll
                for (int dk = 0; dk < 4; ++dk) kfj[jj][dk] = *(const bf16x8*)(GQKV + (size_t)(row_lo + 16 * (2 * j2 + jj) + r16) * 1536 + 512 + h * 128 + dk * 32 + quad * 8);
#pragma unroll
            for (int jj = 0; jj < 2; ++jj) { const int j = 2 * j2 + jj;
                f32x4 kk = (f32x4){0.f, 0.f, 0.f, 0.f}, qk = (f32x4){0.f, 0.f, 0.f, 0.f};
#pragma unroll
                for (int dk = 0; dk < 4; ++dk) { kk = __builtin_amdgcn_mfma_f32_16x16x32_bf16(kfi[dk], kfj[jj][dk], kk, 0, 0, 0); qk = __builtin_amdgcn_mfma_f32_16x16x32_bf16(qf[dk], kfj[jj][dk], qk, 0, 0, 0); }
                const int ms = 16 * j + r16, s = dir ? 63 - ms : ms; const float cs = cumL[ms];
#pragma unroll
                for (int e = 0; e < 4; ++e) { const int mt = 16 * i + 4 * quad + e, t = dir ? 63 - mt : mt;
                    const float dec = __expf(fminf(cumL[mt] - cs, 0.f));
                    Af[t * 64 + s] = (s < t) ? betaL[mt] * kk[e] * dec : 0.f;
                    ATG[mt * 64 + ms] = (bf16)f2bf((s <= t) ? qk[e] * dec : 0.f); } }
        }
    }
    LDS_WAIT();
    for (int t = 0; t < 64; ++t) {
        float v0 = (t == lane) ? 1.f : 0.f, v1 = 0.f, v2 = 0.f, v3 = 0.f;
        for (int s0 = 0; s0 < t; s0 += 16) {
            f32x4 a[4]; float ts[16];
#pragma unroll
            for (int x = 0; x < 4; ++x) a[x] = *(const f32x4*)(Af + t * 64 + s0 + 4 * x);
#pragma unroll
            for (int x = 0; x < 16; ++x) ts[x] = Af[(s0 + x) * 64 + lane];
#pragma unroll
            for (int x = 0; x < 4; ++x) {
                v0 -= (s0 + 4 * x + 0 < t) ? a[x][0] * ts[4 * x + 0] : 0.f; v1 -= (s0 + 4 * x + 1 < t) ? a[x][1] * ts[4 * x + 1] : 0.f;
                v2 -= (s0 + 4 * x + 2 < t) ? a[x][2] * ts[4 * x + 2] : 0.f; v3 -= (s0 + 4 * x + 3 < t) ? a[x][3] * ts[4 * x + 3] : 0.f; }
        }
        const float v = (v0 + v1) + (v2 + v3);
        Af[t * 64 + lane] = v;
    }
    LDS_WAIT();
    const int msl = dir ? 63 - lane : lane; const float bs = betaL[msl];
    for (int t = 0; t < 64; ++t) { const int mt = dir ? 63 - t : t; const float tv = Af[t * 64 + lane]; T1G[mt * 64 + msl] = (bf16)f2bf(tv * bs); }
    LDS_WAIT();
}

constexpr int GS_T1 = 0, GS_T2 = 9216, GS_AT = 18432, GS_K = 27648, GS_Q = GS_K + 17408, GS_V = GS_Q + 17408, GS_W = GS_V + 17408, GS_SCL = GS_W + 17408, GS_END = GS_SCL + 1024;
static_assert(GS_END <= 131072, "gdn seq LDS");
__device__ __forceinline__ void gd_seq(const Fr& F, int chain) {
    const int b = chain >> 3, h = (chain >> 1) & 3, dir = chain & 1;
    const int tid = F.tid, lane = F.lane, w = F.wave, r16 = lane & 15, quad = lane >> 4, tq = (lane & 15) >> 2, tp = lane & 3;
    unsigned char* lds = F.lds;
    const bf16* GQKV = WSP(bf16, WS_GQKV);
    const bf16* TG = (const bf16*)((const unsigned char*)F.out + OUT_GT) + (size_t)chain * NCHK * 2 * 4096;
    const float* SCG = WSP(float, WS_GSCAL) + (size_t)chain * NCHK * 132;
    float* SCL = (float*)(lds + GS_SCL);
    bf16* O = (bf16*)((unsigned char*)F.out + OUT_OG) + (size_t)dir * RT * 512 + h * 128 + 16 * w + r16;
    f32x4 S[8];
#pragma unroll
    for (int dt = 0; dt < 8; ++dt) S[dt] = (f32x4){0.f, 0.f, 0.f, 0.f};
    v4u rT[2], rK[2], rQ[2], rV[2]; f32x4 rE[2]; float rS = 0.f;
#define GS_LOAD(c) do { const int rl = chunk_row_lo(b, dir, (c)); \
        _Pragma("unroll") for (int x = 0; x < 2; ++x) rT[x] = *(const v4u*)(TG + ((size_t)(c) * 2 + x) * 4096 + tid * 8); \
        rE[0] = *(const f32x4*)(SCG + (size_t)(c) * 132 + (tid & 7) * 8); rE[1] = *(const f32x4*)(SCG + (size_t)(c) * 132 + (tid & 7) * 8 + 4); \
        _Pragma("unroll") for (int i = 0; i < 2; ++i) { const int p = tid + 512 * i, m = p >> 4, d0 = (p & 15) * 8; const bf16* gr = GQKV + (size_t)(rl + m) * 1536 + h * 128 + d0; \
            rQ[i] = *(const v4u*)gr; rK[i] = *(const v4u*)(gr + 512); rV[i] = *(const v4u*)(gr + 1024); } \
        if (tid < 132) rS = SCG[(size_t)(c) * 132 + tid]; } while (0)
    GS_LOAD(0);
    for (int c = 0; c < NCHK; ++c) {
        const int row_lo = chunk_row_lo(b, dir, c);
        { const int m = tid >> 3, c0 = (tid & 7) * 8;
          *(v4u*)(lds + GS_T1 + m * 144 + c0 * 2) = rT[0]; *(v4u*)(lds + GS_AT + m * 144 + c0 * 2) = rT[1];
          v4u t2; t2.x = cvtpk(-bflo(rT[0].x) * rE[0][0], -bfhi(rT[0].x) * rE[0][1]); t2.y = cvtpk(-bflo(rT[0].y) * rE[0][2], -bfhi(rT[0].y) * rE[0][3]);
          t2.z = cvtpk(-bflo(rT[0].z) * rE[1][0], -bfhi(rT[0].z) * rE[1][1]); t2.w = cvtpk(-bflo(rT[0].w) * rE[1][2], -bfhi(rT[0].w) * rE[1][3]);
          *(v4u*)(lds + GS_T2 + m * 144 + c0 * 2) = t2; }
#pragma unroll
        for (int i = 0; i < 2; ++i) { const int p = tid + 512 * i, m = p >> 4, d0 = (p & 15) * 8;
            *(v4u*)(lds + GS_K + m * 272 + d0 * 2) = rK[i]; *(v4u*)(lds + GS_Q + m * 272 + d0 * 2) = rQ[i]; *(v4u*)(lds + GS_V + m * 272 + d0 * 2) = rV[i]; }
        if (tid < 132) SCL[tid] = rS;
        if (c + 1 < NCHK) GS_LOAD(c + 1);
        LDS_BARRIER();
        {
            bf16x8 kb[2];
#pragma unroll
            for (int ks = 0; ks < 2; ++ks) { const unsigned char* p0 = lds + GS_K + (32 * ks + 8 * quad + tq) * 272 + (16 * w + 4 * tp) * 2; kb[ks] = cat8(ldtr(p0), ldtr(p0 + 4 * 272)); }
#pragma unroll
            for (int i = 0; i < 4; ++i) { f32x4 acc = (f32x4){0.f, 0.f, 0.f, 0.f};
                const unsigned char* trow = lds + GS_T2 + (16 * i + r16) * 144;
#pragma unroll
                for (int ks = 0; ks < 2; ++ks) acc = __builtin_amdgcn_mfma_f32_16x16x32_bf16(*(const bf16x8*)(trow + (32 * ks + 8 * quad) * 2), kb[ks], acc, 0, 0, 0);
#pragma unroll
                for (int e = 0; e < 4; ++e) *(bf16*)(lds + GS_W + (16 * i + 4 * quad + e) * 272 + (16 * w + r16) * 2) = (bf16)f2bf(acc[e]); }
        }
        LDS_BARRIER();
        {
            bf16x8 vb[2], sb[4];
#pragma unroll
            for (int ks = 0; ks < 2; ++ks) { const unsigned char* p0 = lds + GS_V + (32 * ks + 8 * quad + tq) * 272 + (16 * w + 4 * tp) * 2; vb[ks] = cat8(ldtr(p0), ldtr(p0 + 4 * 272)); }
#pragma unroll
            for (int ks = 0; ks < 4; ++ks) sb[ks] = pack8(S[2 * ks], S[2 * ks + 1]);
            f32x4 vn[4];
#pragma unroll
            for (int i = 0; i < 4; ++i) { f32x4 acc = (f32x4){0.f, 0.f, 0.f, 0.f};
                const unsigned char* trow = lds + GS_T1 + (16 * i + r16) * 144;
#pragma unroll
                for (int ks = 0; ks < 2; ++ks) acc = __builtin_amdgcn_mfma_f32_16x16x32_bf16(*(const bf16x8*)(trow + (32 * ks + 8 * quad) * 2), vb[ks], acc, 0, 0, 0);
                const unsigned char* wrow = lds + GS_W + (16 * i + r16) * 272;
#pragma unroll
                for (int ks = 0; ks < 4; ++ks) acc = __builtin_amdgcn_mfma_f32_16x16x32_bf16(cat8(*(const s16x4*)(wrow + (32 * ks + 4 * quad) * 2), *(const s16x4*)(wrow + (32 * ks + 16 + 4 * quad) * 2)), sb[ks], acc, 0, 0, 0);
                vn[i] = acc; }
            bf16x8 vnb[2];
#pragma unroll
            for (int ks = 0; ks < 2; ++ks) vnb[ks] = pack8(vn[2 * ks], vn[2 * ks + 1]);
#pragma unroll
            for (int i = 0; i < 4; ++i) { f32x4 acc = (f32x4){0.f, 0.f, 0.f, 0.f};
                const unsigned char* qrow = lds + GS_Q + (16 * i + r16) * 272;
#pragma unroll
                for (int ks = 0; ks < 4; ++ks) acc = __builtin_amdgcn_mfma_f32_16x16x32_bf16(cat8(*(const s16x4*)(qrow + (32 * ks + 4 * quad) * 2), *(const s16x4*)(qrow + (32 * ks + 16 + 4 * quad) * 2)), sb[ks], acc, 0, 0, 0);
                acc = acc * *(const f32x4*)(SCL + 16 * i + 4 * quad);
                const unsigned char* arow = lds + GS_AT + (16 * i + r16) * 144;
#pragma unroll
                for (int ks = 0; ks < 2; ++ks) acc = __builtin_amdgcn_mfma_f32_16x16x32_bf16(cat8(*(const s16x4*)(arow + (32 * ks + 4 * quad) * 2), *(const s16x4*)(arow + (32 * ks + 16 + 4 * quad) * 2)), vnb[ks], acc, 0, 0, 0);
#pragma unroll
                for (int e = 0; e < 4; ++e) O[(size_t)(row_lo + 16 * i + 4 * quad + e) * 512] = (bf16)f2bf(acc[e]); }
#pragma unroll
            for (int i = 0; i < 4; ++i) vn[i] = vn[i] * *(const f32x4*)(SCL + 64 + 16 * i + 4 * quad);
#pragma unroll
            for (int ks = 0; ks < 2; ++ks) vnb[ks] = pack8(vn[2 * ks], vn[2 * ks + 1]);
            const float elast = SCL[128];
#pragma unroll
            for (int dt = 0; dt < 8; ++dt) { f32x4 acc = S[dt] * elast;
#pragma unroll
                for (int ks = 0; ks < 2; ++ks) { const unsigned char* p0 = lds + GS_K + (32 * ks + 4 * quad + tq) * 272 + (16 * dt + 4 * tp) * 2;
                    acc = __builtin_amdgcn_mfma_f32_16x16x32_bf16(cat8(ldtr(p0), ldtr(p0 + 16 * 272)), vnb[ks], acc, 0, 0, 0); }
                S[dt] = acc; }
        }
        LDS_BARRIER();
    }
#undef GS_LOAD
}

__device__ __forceinline__ void phase_prepass(const Fr& F, int l) {
    {
        const int N = 32 * NCHK, bx = blockIdx.x; int c0, cstep, cend;
        if (F.G == 256) { if (bx < 240) { c0 = bx; cstep = 240; cend = N - 64; } else { c0 = N - 64 + (bx - 240); cstep = 16; cend = N; } }
        else { c0 = bx; cstep = F.G; cend = N; }
        v4u ra[2], rb[2]; if (c0 < cend) hg_load_qf(F, c0, ra, rb);
        for (int cid = c0; cid < cend; cid += cstep) hg_scores(F, l, cid, (cid + cstep < cend) ? cid + cstep : N, ra, rb);
    }
    __syncthreads();
    for (int cid = (F.G - 1 - (int)blockIdx.x) * 8 + F.wave; cid < 32 * NCHK; cid += F.NGW) gd_pre(F, cid);
    __syncthreads();
}

#define XB_TMO      128
#define XB_XCNT(j)  (256  + 64 * (j))
#define XB_XSUB(j)  (1280 + 64 * (j))
#define XB_XGEN(j)  (2304 + 64 * (j))
#define XB_TOP      3328
#define XB_TOPGEN   3392
#define XCD_BAR_WORDS 3456
#define XB_SPIN_CAP (1u << 18)

__device__ __forceinline__ unsigned xb_ld(unsigned* p)              { return __hip_atomic_load(p, __ATOMIC_RELAXED, __HIP_MEMORY_SCOPE_AGENT); }
__device__ __forceinline__ unsigned xb_add(unsigned* p, unsigned v) { return __hip_atomic_fetch_add(p, v, __ATOMIC_RELAXED, __HIP_MEMORY_SCOPE_AGENT); }
__device__ __forceinline__ unsigned xb_xcc_id() { return (unsigned)__builtin_amdgcn_s_getreg((3 << 11) | 20) & 0xFu; }
#define XB_SPIN(cond, bar) do { unsigned _sp = 0; while (cond) { __builtin_amdgcn_s_sleep(1); \
    if ((++_sp & 255u) == 0u) { if (xb_ld(&(bar)[XB_TMO])) break; if (_sp > XB_SPIN_CAP) { atomicAdd(&(bar)[XB_TMO], 1u); break; } } } } while (0)

struct XcdBarrier {
    unsigned* bar; unsigned x;
    volatile LAS unsigned* st;
};

__device__ __forceinline__ XcdBarrier xcd_barrier_post(unsigned* bar, volatile LAS unsigned* st) {
    XcdBarrier b; b.bar = bar; b.x = xb_xcc_id(); b.st = st;
    if (threadIdx.x == 0) (void)xb_add(&bar[XB_XCNT(b.x)], 1u);
    return b;
}
__device__ __forceinline__ void xcd_barrier_complete(unsigned* bar, unsigned x, unsigned& nloc, unsigned& nx) {
    const unsigned G = gridDim.x * gridDim.y * gridDim.z;
    unsigned sum, cnt, mine, sp = 0u;
    for (;;) {
        sum = 0u; cnt = 0u; mine = 0u;
#pragma unroll
        for (unsigned j = 0; j < 16; ++j) { const unsigned c = xb_ld(&bar[XB_XCNT(j)]); sum += c; cnt += (c > 0u) ? 1u : 0u; mine = (j == x) ? c : mine; }
        if (sum == G) break;
        __builtin_amdgcn_s_sleep(1);
        if ((++sp & 255u) == 0u) { if (xb_ld(&bar[XB_TMO])) break; if (sp > XB_SPIN_CAP) { atomicAdd(&bar[XB_TMO], 1u); break; } }
    }
    nloc = mine > 0u ? mine : 1u; nx = cnt > 0u ? cnt : 1u;
}

__device__ __forceinline__ void xcd_barrier(const XcdBarrier& b) {
    asm volatile("s_waitcnt vmcnt(0)" ::: "memory");
    __syncthreads();
    if (threadIdx.x == 0) {
        unsigned* bar = b.bar;
        __builtin_amdgcn_s_waitcnt(0);
        unsigned nloc = b.st[0], nx = b.st[1];
        if (nloc == 0u) { xcd_barrier_complete(bar, b.x, nloc, nx); b.st[0] = nloc; b.st[1] = nx; }
        const unsigned old = xb_add(&bar[XB_XSUB(b.x)], 1u);
        const unsigned gen = old / nloc;
        if (old + 1u == (gen + 1u) * nloc) {
            __builtin_amdgcn_fence(__ATOMIC_RELEASE, "agent");
            asm volatile("s_waitcnt vmcnt(0)" ::: "memory");
            const unsigned og = xb_add(&bar[XB_TOP], 1u);
            const unsigned tg = og / nx;
            if (og + 1u == (tg + 1u) * nx) xb_add(&bar[XB_TOPGEN], 1u);
            else XB_SPIN(xb_ld(&bar[XB_TOPGEN]) == tg, bar);
            __builtin_amdgcn_fence(__ATOMIC_ACQUIRE, "agent");
            xb_add(&bar[XB_XGEN(b.x)], 1u);
            asm volatile("s_waitcnt vmcnt(0)" ::: "memory");
        } else {
            XB_SPIN(xb_ld(&bar[XB_XGEN(b.x)]) == gen, bar);
            __builtin_amdgcn_fence(__ATOMIC_ACQUIRE, "agent");
            asm volatile("s_waitcnt vmcnt(0)" ::: "memory");
        }
    }
    __syncthreads();
}

__device__ __forceinline__ void phase_mixers(const Fr& F, int l) {
    const int G = F.G, nscan = 64, bx = blockIdx.x;
    const bool split = (G == 256);
    const int natt = split ? 192 : G, ab = split ? bx - nscan : bx;
    for (int it = bx; it < 64; it += G) { if (it < 32) gd_seq(RL(F), it); else hg_seq(RL(F), l, it - 32); __syncthreads(); }
    const bf16* Z = WSP(bf16, WS_ZH); bf16* Y = WSP(bf16, WS_AY);
    const bf16* MQ = WSP(bf16, WS_MQ); const bf16* MK = WSP(bf16, WS_MK); const bf16* MVT = WSP(bf16, WS_MVT); const bf16* NAVT = WSP(bf16, WS_NAVT); const bf16* KROPE = WSP(bf16, WS_KROPE);
    const int ntot = 512 + (l == 0 ? 32 : 0);
    const float sl_mla = 0.07216878364870322f * LOG2E, sl_na = 0.08838834764831845f * LOG2E;
    for (int k = 0; ; ++k) {
        int p, t0 = 0, nl = 64, pidx = -1;
        if (split && bx < 64) {
            if (bx < 32) { if (k >= 1) break; p = 256 + 64 + bx; } else { if (k >= 2) break; p = 256 + 2 * (bx - 32) + k; }
        } else if (split) {
            if (k == 0) p = ab;
            else if (k == 1) { const int su = ab / 3, part = ab - 3 * su; p = 192 + su; t0 = part * 23; nl = part == 2 ? 18 : 23; pidx = ab; }
            else if (k == 2) { if (ab >= 160) continue; p = 256 + 96 + ab; }
            else if (k == 3) { if (l != 0 || ab < 160) break; p = 512 + (ab - 160); }
            else break;
        } else { p = ab + k * natt; if (p >= ntot) break; }
        if (p < 256 || (p >= 512 && p < 528)) {
            const bool lat = p < 256; const int b_ = lat ? (p >> 6) : ((p - 512) >> 2), h_ = lat ? ((p >> 4) & 3) : (p & 3), qb_ = p & 15;
            attn_unit<192, false>(RL(F), MQ + h_ * 192, 768, lat ? b_ * SEQ + qb_ * 256 : NLAT + b_ * CTX, lat, MK + h_ * 128, 512, MVT + (size_t)h_ * 128 * RT,
                                  lat ? b_ * SEQ + t0 * 64 : 0, lat ? nl : 0, NLAT + b_ * CTX, lat ? ((pidx >= 0 && t0 < 46) ? nl : nl + 4) : 4, Y + 1024 + h_ * 128, sl_mla, 0, 0, nullptr, pidx);
        } else {
            const bool lat = p < 512; const int v_ = lat ? p - 256 : p - 528, b_ = lat ? (v_ >> 6) : (v_ >> 2), h_ = lat ? ((v_ >> 4) & 3) : (v_ & 3), rg_ = v_ & 15;
            const int lo_ = min(max(4 * rg_ - 4, 0), 56), hi_ = min(max(4 * rg_ + 3 - 4, 0), 56) + 7, nwin_ = lat ? hi_ - lo_ + 1 : 0;
            attn_unit<128, true>(RL(F), Z + C_NA + h_ * 128, ZP, lat ? b_ * SEQ + rg_ * 256 : NLAT + b_ * CTX, false, Z + C_NA + 512 + h_ * 128, ZP, NAVT + (size_t)h_ * 128 * RT,
                                 lat ? b_ * SEQ + lo_ * 64 : 0, nwin_, NLAT + b_ * CTX, nwin_ + 4, Y + 512 + h_ * 128, sl_na, lat ? lo_ : 0, lat ? 4 * rg_ : 0,
                                 lat ? inp(F, 11) + (size_t)(l * 4 + h_) * 15 * 31 : nullptr, -1);
        }
        __syncthreads();
    }
}

template <class Epi, bool OPAQUE_K = false>
__device__ __forceinline__ void run_gemm(const Fr& F, const bf16* A, const bf16* Bt, int M, int N, int K, const Epi& E) {
    if (OPAQUE_K) asm volatile("" : "+s"(K));
    pg8::Gemm g{A, Bt, M, N, K, K, K}; pg8::StaticOrder S; S.init(M, N, F.G, (int)blockIdx.x);
    pg8::gemm_phase<Epi, pg8::StaticOrder, true, true>((LAS unsigned char*)F.lds, g, S, E);
}

__device__ __forceinline__ void run_gemm_splitk(const Fr& F, const bf16* A, int lda, const bf16* Bt, int ldb, int M, int N, int K, int KS, const pg8::EpiCtxSplit& E) {
    pg8::Gemm g{A, Bt, M, N, K, lda, ldb}; pg8::SplitKOrder S; S.init(M, N, KS, F.G, (int)blockIdx.x);
    pg8::gemm_phase<pg8::EpiCtxSplit, pg8::SplitKOrder, true, true>((LAS unsigned char*)F.lds, g, S, E);
}

__global__ void __launch_bounds__(512, 2) mk_fwd(Args args) {
    extern __shared__ __attribute__((aligned(16))) unsigned char lds[];
    cg::grid_group grid = cg::this_grid();
    Fr F; F.kp = (kargp_t)__builtin_amdgcn_kernarg_segment_ptr(); F.out = args.out; F.ws = args.ws; F.lds = lds;
    F.tid = threadIdx.x; F.lane = F.tid & 63; F.wave = __builtin_amdgcn_readfirstlane(F.tid >> 6); F.G = gridDim.x;
    F.gw = blockIdx.x * 8 + F.wave; F.NGW = F.G * 8;
#define ADA WSP(float, WS_ADA)
#define AY WSP(bf16, WS_AY)
#define X WSP(float, WS_X)
#define ZH WSP(bf16, WS_ZH)
    unsigned* barw = (unsigned*)args.ws;
    if (blockIdx.x == 0) for (int i = threadIdx.x; i < 4096; i += 512) barw[i] = 0u;
    volatile LAS unsigned* bst = (volatile LAS unsigned*)((LAS unsigned char*)lds + 144000);
    if (threadIdx.x < 4) bst[threadIdx.x] = 0u;
    __syncthreads();

    phase_ada(RL(F)); __syncthreads(); { const Fr Fw = RL(F); phase_wconv(Fw, 0, 0, Fw.gw, Fw.NGW); }
    grid.sync();
    const XcdBarrier xb = xcd_barrier_post(barw, bst);
    phase_mod0(RL(F));
    xcd_barrier(xb);
    for (int l = 0; l < 2; ++l) {
        const int MR = (l == 0) ? RT : NLAT;
        run_gemm(F, AY, WSP(bf16, WS_WIN), RT, ZP, DM, pg8::EpiStore<0>{ZH, ZP});
        {
            const int rem = ((RT / 256) * (ZP / 256)) % F.G, first = rem == 0 ? 0 : rem;
            if ((int)blockIdx.x >= first) { __syncthreads(); const Fr Fw = RL(F); phase_wconv(Fw, l, 1, ((int)blockIdx.x - first) * 8 + Fw.wave, (F.G - first) * 8); }
        }
        xcd_barrier(xb);
        phase_prep(RL(F), l);
        xcd_barrier(xb);
        run_gemm<pg8::EpiStore<0>, true>(F, WSP(bf16, WS_QN), WSP(bf16, WS_WUQ), RT, 768, 384, pg8::EpiStore<0>{WSP(bf16, WS_MQ), 768});
        run_gemm<pg8::EpiStore<0>, true>(F, WSP(bf16, WS_CKVN), WSP(bf16, WS_WUK), RT, 512, 256, pg8::EpiStore<0>{WSP(bf16, WS_MK), 512});
        run_gemm<pg8::EpiStore<0>, true>(F, WSP(bf16, WS_WUV), WSP(bf16, WS_CKVN), 512, RT, 256, pg8::EpiStore<0>{WSP(bf16, WS_MVT), RT});
        phase_prepass(RL(F), l);
        xcd_barrier(xb);
        phase_mixers(RL(F), l);
        xcd_barrier(xb);
        phase_post(RL(F), l, MR);
        xcd_barrier(xb);
        if (l == 0) run_gemm(F, AY, WSP(bf16, WS_WOUT), RT, DM, DM, pg8::EpiResid{inp(F, 0), inp(F, 2), X, ADA + 2 * 2048, ALPHA_RES});
        else run_gemm(F, AY, WSP(bf16, WS_WOUT), NLAT, DM, DM, pg8::EpiResid{X, X, X, ADA + (size_t)5 * ADAW + 2 * 2048, ALPHA_RES});
        xcd_barrier(xb);
        phase_ln(RL(F), l, 1, MR);
        xcd_barrier(xb);
        run_gemm(F, AY, WSP(bf16, WS_WM1), MR, FF, DM, pg8::EpiStore<1>{ZH, FF});
        if (l == 0) {
            const int rem = ((MR / 256) * (FF / 256)) % F.G, first = rem;
            if ((int)blockIdx.x >= first) { __syncthreads(); const Fr Fw = RL(F); phase_wconv(Fw, 1, 0, ((int)blockIdx.x - first) * 8 + Fw.wave, (F.G - first) * 8); }
        }
        xcd_barrier(xb);
        run_gemm(F, ZH, WSP(bf16, WS_WM2), NLAT, DM, FF, pg8::EpiResid{X, X, X, ADA + (size_t)l * 5 * ADAW + 5 * 2048, 1.f});
        if (l == 0) {
            run_gemm_splitk(F, ZH + (size_t)NLAT * FF, FF, WSP(bf16, WS_WM2), FF, NCTX, DM, FF / 2, 2, pg8::EpiCtxSplit{X + (size_t)NLAT * DM, WSP(float, WS_PART), ADA + 4 * ADAW + 5 * 2048});
        }
        xcd_barrier(xb);
        phase_ln(RL(F), l, 2, MR);
        if (l == 0) xcd_barrier(xb);
    }
}
#undef ADA
#undef AY
#undef X
#undef ZH

extern "C" void kernel_launch(void* const* d_in, const int* in_sizes, int n_in, void* d_out, int out_size, void* d_ws, size_t ws_size, hipStream_t stream) {
    static int grid = 0;
    if (grid == 0) {
        int dev = 0, cus = 0, per_cu = 0;
        if (n_in != 26 || ws_size < WS_END) { fprintf(stderr, "kernel_launch: unexpected n_in %d / ws %zu (need %zu)\n", n_in, ws_size, (size_t)WS_END); grid = -1; return; }
        (void)hipGetDevice(&dev); (void)hipDeviceGetAttribute(&cus, hipDeviceAttributeMultiprocessorCount, dev);
        if (hipFuncSetAttribute((const void*)mk_fwd, hipFuncAttributeMaxDynamicSharedMemorySize, LDS_BYTES) != hipSuccess) { fprintf(stderr, "kernel_launch: hipFuncSetAttribute failed\n"); grid = -1; return; }
        if (hipOccupancyMaxActiveBlocksPerMultiprocessor(&per_cu, (const void*)mk_fwd, 512, LDS_BYTES) != hipSuccess || per_cu < 1) per_cu = 1;
        (void)hipGetLastError();
        grid = cus * 1;
        fprintf(stderr, "kernel_launch: grid %d (cus %d, occupancy query %d), ws %zu\n", grid, cus, per_cu, ws_size);
    }
    if (grid < 0) return;
    Args a{};
    for (int i = 0; i < 26; ++i) a.in[i] = (const float*)d_in[i];
    a.out = (float*)d_out; a.ws = (unsigned char*)d_ws;
    void* kargs[] = {&a};
    const hipError_t e = hipLaunchCooperativeKernel((const void*)mk_fwd, dim3(grid), dim3(512), kargs, LDS_BYTES, stream);
    if (e != hipSuccess) fprintf(stderr, "kernel_launch: cooperative launch failed: %s (grid %d)\n", hipGetErrorString(e), grid);
}
```

```cpp
#include <hip/hip_runtime.h>
#include <hip/hip_cooperative_groups.h>
#include <cstdio>
#include <cstdint>
namespace cg = cooperative_groups;
#define LAS __attribute__((address_space(3)))
typedef unsigned short bf16;
typedef unsigned v4u __attribute__((ext_vector_type(4)));
typedef unsigned v2u __attribute__((ext_vector_type(2)));
typedef float f32x4 __attribute__((ext_vector_type(4)));
typedef float f32x2 __attribute__((ext_vector_type(2)));
typedef short bf16x8 __attribute__((ext_vector_type(8)));

constexpr int DM = 2048, NBATCH = 4, SEQ = 4096, CTX = 256, NLAT = NBATCH * SEQ, NCTX = NBATCH * CTX, RT = NLAT + NCTX;
constexpr int ZC = 6864, ZP = 6912;
constexpr int C_GDN = 0, C_NA = 2064, C_MLA = 3600, C_HG = 4304;
constexpr int FF = 8192, ADAW = 12288;
constexpr float LOG2E = 1.4426950408889634f;
constexpr float ALPHA_RES = 1.4142135623730951f;

constexpr size_t MiB = 1u << 20;
constexpr size_t WS_ADA = 1 * MiB;
constexpr size_t WS_WIN = 2 * MiB, WS_WOUT = 29 * MiB, WS_WM1 = 37 * MiB, WS_WM2 = 69 * MiB, WS_WUQ = 101 * MiB, WS_WUK = 102 * MiB, WS_WUV = 102 * MiB + 512 * 1024;
constexpr size_t WS_AY = 104 * MiB;
constexpr size_t WS_X = 172 * MiB;
constexpr size_t WS_ZH = 308 * MiB;
constexpr size_t WS_GQKV = 580 * MiB;
constexpr size_t WS_QN = 631 * MiB, WS_CKVN = 644 * MiB, WS_MQ = 653 * MiB, WS_MK = 679 * MiB, WS_MVT = 696 * MiB, WS_NAVT = 713 * MiB, WS_KROPE = 730 * MiB, WS_GB = 733 * MiB;
constexpr size_t WS_ROPE = 735 * MiB;
constexpr size_t WS_HSC = 736 * MiB;
constexpr size_t WS_GSCAL = 753 * MiB;
constexpr size_t WS_HDL = 755 * MiB;
constexpr size_t WS_HQD = 538 * MiB;
constexpr size_t WS_HKE2 = 572 * MiB;
constexpr size_t WS_PO = WS_QN, WS_PML = 643 * MiB;
constexpr size_t WS_PART = 757 * MiB;
constexpr size_t WS_END = 765 * MiB;
static_assert(WS_PO + (size_t)192 * 256 * 128 * 2 <= WS_PML && WS_PML + (size_t)192 * 256 * 2 * 4 <= WS_CKVN, "split-KV partials");
static_assert(WS_ZH + (size_t)RT * ZP * 2 <= WS_HQD && WS_HQD + (size_t)2176 * 16384 <= WS_HKE2 && WS_HKE2 + (size_t)512 * 16384 <= WS_GQKV, "hgrn pre-pass buffers in the z/h tail");
static_assert(WS_WIN + (size_t)ZP * DM * 2 <= WS_WOUT && WS_WM2 + (size_t)DM * FF * 2 <= WS_WUQ && WS_WUQ + 768 * 384 * 2 <= WS_WUK, "weights map");
static_assert(WS_AY + (size_t)RT * DM * 2 <= WS_X && WS_X + (size_t)RT * DM * 4 <= WS_ZH && WS_ZH + (size_t)RT * FF * 2 <= WS_GQKV, "act map");
static_assert(WS_GQKV + (size_t)RT * 1536 * 2 <= WS_QN && WS_QN + (size_t)RT * 384 * 2 <= WS_CKVN && WS_CKVN + (size_t)RT * 256 * 2 <= WS_MQ && WS_MQ + (size_t)RT * 768 * 2 <= WS_MK, "mixer map");
static_assert(WS_MK + (size_t)RT * 512 * 2 <= WS_MVT && WS_MVT + (size_t)RT * 512 * 2 <= WS_NAVT && WS_NAVT + (size_t)RT * 512 * 2 <= WS_KROPE && WS_KROPE + (size_t)RT * 64 * 2 <= WS_GB && WS_GB + (size_t)RT * 16 * 4 <= WS_END, "mixer map 2");
constexpr size_t OUT_OG = 0, OUT_OH = 34 * MiB, OUT_GT = 68 * MiB, OUT_HKE = 102 * MiB;
static_assert(OUT_OH + (size_t)2 * RT * 512 * 2 <= OUT_GT && OUT_GT + (size_t)2176 * 2 * 8192 <= OUT_HKE && OUT_HKE + (size_t)1664 * 16384 <= (size_t)NLAT * DM * 4, "d_out scratch");

constexpr int LDS_BYTES = 147456;

__device__ __forceinline__ float bf2f(unsigned short u) { return __builtin_bit_cast(float, (unsigned)u << 16); }
__device__ __forceinline__ float bflo(unsigned w) { return __builtin_bit_cast(float, w << 16); }
__device__ __forceinline__ float bfhi(unsigned w) { return __builtin_bit_cast(float, w & 0xffff0000u); }
__device__ __forceinline__ unsigned f2bf(float f) { unsigned u = __builtin_bit_cast(unsigned, f); return (u + 0x7fffu + ((u >> 16) & 1u)) >> 16; }
__device__ __forceinline__ unsigned pk2(float lo, float hi) { return f2bf(lo) | (f2bf(hi) << 16); }
__device__ __forceinline__ float wave_sum(float v) {
#pragma unroll
    for (int o = 1; o < 64; o <<= 1) v += __shfl_xor(v, o);
    return v;
}
__device__ __forceinline__ float sigmoidf_(float x) { return __builtin_amdgcn_rcpf(1.f + __expf(-x)); }
__device__ __forceinline__ float siluf_(float x) { return x * __builtin_amdgcn_rcpf(1.f + __expf(-x)); }
#define LDS_WAIT() asm volatile("s_waitcnt vmcnt(0) lgkmcnt(0)" ::: "memory")
#define LDS_BARRIER() do { asm volatile("s_waitcnt lgkmcnt(0)" ::: "memory"); __builtin_amdgcn_s_barrier(); asm volatile("" ::: "memory"); } while (0)

namespace pg8 {
#define PG8_LAS __attribute__((address_space(3)))
typedef unsigned short bf16_t;
typedef short bf16x8 __attribute__((ext_vector_type(8)));
typedef float f32x4 __attribute__((ext_vector_type(4)));
typedef unsigned u32x4 __attribute__((ext_vector_type(4)));
constexpr int BM = 256, BK = 64, HALF = 128, HTB = HALF * BK * 2  , STAGE_BYTES = 8 * HTB, NXCD = 8, WGM = 8;

__host__ __device__ __forceinline__ int lds_byte(int r, int c) { const int st = (r >> 4) * 2 + (c >> 5), rr = r & 15, cc = c & 31, ob = rr * 64 + cc * 2; return st * 1024 + (ob ^ (((ob >> 9) & 1) << 5)); }
__host__ __device__ __forceinline__ void stage_rc(int b, int& R, int& C) { const int st = b / 1024, sb = b % 1024, swz = sb ^ (((sb >> 9) & 1) << 5); R = (st >> 1) * 16 + swz / 64; C = (st & 1) * 32 + (swz % 64) / 2; }
__host__ __device__ __forceinline__ int perm32(int rho) { const int n = rho >> 4, i = rho & 15; return 8 * (i >> 2) + 4 * n + (i & 3); }

struct Unit { int pm, pn, ks; };
struct Gemm { const bf16_t* A; const bf16_t* Bt; int M, N, K, lda, ldb; };

struct StaticOrder {
    int nM, nN, nwg, G, c;
    __host__ __device__ void init(int M, int N, int G_, int c_) { nM = M / BM; nN = N / BM; nwg = nM * nN; G = G_; c = c_; }
    __host__ __device__ bool next(int i, Unit& u) const {
        const long L = (long)i * G + c; if (L >= nwg) return false;
        int wgid = (int)L; { const int q = nwg / NXCD, r = nwg % NXCD, xcd = wgid % NXCD, off = wgid / NXCD; wgid = (xcd < r ? xcd * (q + 1) : r * (q + 1) + (xcd - r) * q) + off; }
        const int nig = WGM * nN, gid = wgid / nig, fm = gid * WGM, gsz = (nM - fm) < WGM ? (nM - fm) : WGM;
        u.pm = fm + ((wgid % nig) % gsz); u.pn = (wgid % nig) / gsz; u.ks = 0; return true;
    }
    __device__ __forceinline__ void a_ready(const Unit&) const {}
    __device__ __forceinline__ void done(const Unit&) const {}
};

struct SplitKOrder {
    int nM, nN, KS, nwg, G, c;
    __host__ __device__ void init(int M, int N, int KS_, int G_, int c_) { nM = M / BM; nN = N / BM; KS = KS_; nwg = nM * nN * KS; G = G_; c = c_; }
    __host__ __device__ bool next(int i, Unit& u) const {
        const long L = (long)i * G + c; if (L >= nwg) return false;
        const int t = (int)L; u.ks = t % KS; const int r = t / KS; u.pm = r % nM; u.pn = r / nM; return true;
    }
    __device__ __forceinline__ void a_ready(const Unit&) const {}
    __device__ __forceinline__ void done(const Unit&) const {}
};

template <class Epi, class Sched, bool ALIGN_EPI = false, bool SP2 = false>
__device__ __forceinline__ void gemm_phase(PG8_LAS unsigned char* lds, const Gemm g, const Sched& S, const Epi& E) {
    int tid_ = threadIdx.x; asm volatile("" : "+v"(tid_));
    const int tid = tid_, wid = __builtin_amdgcn_readfirstlane(tid >> 6), lane = tid & 63, wr = wid >> 2, wc = wid & 3, fr = lane & 15, fq = lane >> 4;
    const int K = g.K, nt = K / BK;
    unsigned voffA[2], voffB[2];
#pragma unroll
    for (int i = 0; i < 2; ++i) { int R, C; stage_rc(tid * 16 + i * 8192, R, C); const int Rb = Epi::PERM ? ((R & ~31) + perm32(R & 31)) : R;
        voffA[i] = (unsigned)(R * g.lda + C) * 2u; voffB[i] = (unsigned)(Rb * g.ldb + C) * 2u; }
    const size_t kstep = (size_t)(BK * 2);
    const size_t hstepA = (size_t)HALF * g.lda * 2, hstepB = (size_t)HALF * g.ldb * 2;
    const size_t tstepA = 2 * hstepA, tstepB = 2 * hstepB, sstep = (size_t)K * 2;
    const unsigned ldsw = (unsigned)wid * 1024u;
    const int aoff = lds_byte(wr * 64 + fr, fq * 8), boff = lds_byte(wc * 32 + fr, fq * 8);
#define PG8_SA(b, h) (((b) * 2 + (h)) * HTB)
#define PG8_SB(b, h) ((4 + (b) * 2 + (h)) * HTB)
#define PG8_STAGE(bufoff, gbase, voff) do { _Pragma("unroll") for (int _i = 0; _i < 2; ++_i) \
        __builtin_amdgcn_global_load_lds((const unsigned*)((const char*)(gbase) + (voff)[_i]), (PG8_LAS unsigned*)(lds + (bufoff) + ldsw + _i * 8192), 16, 0, 0); } while (0)
#define PG8_LDA(dst, b, h) do { _Pragma("unroll") for (int m = 0; m < 4; ++m) _Pragma("unroll") for (int k = 0; k < 2; ++k) dst[m][k] = *(const PG8_LAS bf16x8*)(lds + PG8_SA(b, h) + aoff + m * 2048 + k * 1024); } while (0)
#define PG8_LDB(dst, b, h) do { _Pragma("unroll") for (int n = 0; n < 2; ++n) _Pragma("unroll") for (int k = 0; k < 2; ++k) dst[n][k] = *(const PG8_LAS bf16x8*)(lds + PG8_SB(b, h) + boff + n * 2048 + k * 1024); } while (0)
#define PG8_MMA(ai, bj, At, Bt) do { __builtin_amdgcn_s_setprio(1); _Pragma("unroll") for (int m = 0; m < 4; ++m) _Pragma("unroll") for (int n = 0; n < 2; ++n) _Pragma("unroll") for (int k = 0; k < 2; ++k) \
        acc[ai][bj][m][n] = __builtin_amdgcn_mfma_f32_16x16x32_bf16(Bt[n][k], At[m][k], acc[ai][bj][m][n], 0, 0, 0); __builtin_amdgcn_s_setprio(0); } while (0)
#define PG8_WAIT_V(n) asm volatile("s_waitcnt vmcnt(" #n ")" ::: "memory")
#define PG8_WAIT_L(n) asm volatile("s_waitcnt lgkmcnt(" #n ")" ::: "memory")
#define PG8_BAR __builtin_amdgcn_s_barrier()
#define PG8_SCHED __builtin_amdgcn_sched_barrier(0)
    Unit cur, nxt; int ui = 0;
    if (!S.next(0, cur)) return;
    f32x4 acc[2][2][4][2];
#pragma unroll
    for (int a = 0; a < 2; ++a)
#pragma unroll
        for (int b = 0; b < 2; ++b)
#pragma unroll
            for (int m = 0; m < 4; ++m)
#pragma unroll
                for (int n = 0; n < 2; ++n) acc[a][b][m][n] = (f32x4){0.f, 0.f, 0.f, 0.f};
    bf16x8 At[4][2], B0[2][2], B1[2][2];
    const char* cA = (const char*)g.A + (size_t)cur.pm * tstepA + (size_t)cur.ks * sstep; const char* cB = (const char*)g.Bt + (size_t)cur.pn * tstepB + (size_t)cur.ks * sstep;
    S.a_ready(cur);
    if constexpr (SP2) {
        PG8_STAGE(PG8_SB(0, 0), cB, voffB); PG8_STAGE(PG8_SB(0, 1), cB + hstepB, voffB); PG8_STAGE(PG8_SA(0, 0), cA, voffA); PG8_STAGE(PG8_SA(0, 1), cA + hstepA, voffA);
        if (wr == 1) PG8_BAR;
        PG8_WAIT_V(2); PG8_BAR;
        PG8_STAGE(PG8_SB(1, 0), cB + kstep, voffB); PG8_STAGE(PG8_SA(1, 0), cA + kstep, voffA); PG8_STAGE(PG8_SB(1, 1), cB + hstepB + kstep, voffB);
        PG8_WAIT_V(6); PG8_BAR;
    } else {
        PG8_STAGE(PG8_SB(0, 0), cB, voffB); PG8_STAGE(PG8_SA(0, 0), cA, voffA); PG8_STAGE(PG8_SB(0, 1), cB + hstepB, voffB); PG8_STAGE(PG8_SA(0, 1), cA + hstepA, voffA);
        if (wr == 1) PG8_BAR;
        PG8_WAIT_V(4); PG8_BAR;
        PG8_STAGE(PG8_SB(1, 0), cB + kstep, voffB); PG8_STAGE(PG8_SA(1, 0), cA + kstep, voffA); PG8_STAGE(PG8_SB(1, 1), cB + hstepB + kstep, voffB);
        PG8_WAIT_V(6); PG8_BAR;
    }
    for (;;) {
        const bool has_next = S.next(ui + 1, nxt);
        const char* nA = has_next ? (const char*)g.A + (size_t)nxt.pm * tstepA + (size_t)nxt.ks * sstep : cA; const char* nB = has_next ? (const char*)g.Bt + (size_t)nxt.pn * tstepB + (size_t)nxt.ks * sstep : cB;
        for (int t = 0; t < nt; t += 2) {
            const bool last = (t == nt - 2);
            const char* a1 = cA + (size_t)(t + 1) * kstep;
            const char* a2 = last ? nA : cA + (size_t)(t + 2) * kstep; const char* b2 = last ? nB : cB + (size_t)(t + 2) * kstep;
            const char* a3 = a2 + kstep; const char* b3 = b2 + kstep;
            if (last && has_next) S.a_ready(nxt);
            if constexpr (SP2) {
            PG8_LDB(B0, 0, 0); PG8_LDB(B1, 0, 1); PG8_SCHED; PG8_LDA(At, 0, 0); PG8_STAGE(PG8_SA(1, 1), a1 + hstepA, voffA);
            PG8_WAIT_V(8); PG8_WAIT_L(0); PG8_BAR; PG8_MMA(0, 0, At, B0); PG8_MMA(0, 1, At, B1); PG8_BAR; PG8_SCHED;
            PG8_LDA(At, 0, 1); PG8_STAGE(PG8_SB(0, 0), b2, voffB); PG8_STAGE(PG8_SB(0, 1), b2 + hstepB, voffB); PG8_STAGE(PG8_SA(0, 0), a2, voffA);
            PG8_WAIT_V(8); PG8_WAIT_L(0); PG8_BAR; PG8_MMA(1, 0, At, B0); PG8_MMA(1, 1, At, B1); PG8_BAR; PG8_SCHED;
            PG8_LDB(B0, 1, 0); PG8_LDB(B1, 1, 1); PG8_SCHED; PG8_LDA(At, 1, 0); PG8_STAGE(PG8_SA(0, 1), a2 + hstepA, voffA);
            PG8_WAIT_V(8); PG8_WAIT_L(0); PG8_BAR; PG8_MMA(0, 0, At, B0); PG8_MMA(0, 1, At, B1); PG8_BAR; PG8_SCHED;
            PG8_LDA(At, 1, 1); PG8_STAGE(PG8_SB(1, 0), b3, voffB); PG8_STAGE(PG8_SB(1, 1), b3 + hstepB, voffB); PG8_STAGE(PG8_SA(1, 0), a3, voffA);
            PG8_WAIT_V(8); PG8_WAIT_L(0); PG8_BAR; PG8_MMA(1, 0, At, B0); PG8_MMA(1, 1, At, B1); PG8_BAR; PG8_SCHED;
            } else {
            PG8_LDB(B0, 0, 0); PG8_SCHED; PG8_LDA(At, 0, 0); PG8_STAGE(PG8_SA(1, 1), a1 + hstepA, voffA);
            PG8_WAIT_L(8); PG8_BAR; PG8_WAIT_L(0); PG8_MMA(0, 0, At, B0); PG8_BAR; PG8_SCHED;
            PG8_LDB(B1, 0, 1); PG8_STAGE(PG8_SB(0, 0), b2, voffB);
            PG8_BAR; PG8_WAIT_L(0); PG8_MMA(0, 1, At, B1); PG8_BAR;
            PG8_LDA(At, 0, 1); PG8_STAGE(PG8_SA(0, 0), a2, voffA);
            PG8_BAR; PG8_WAIT_L(0); PG8_MMA(1, 0, At, B0); PG8_BAR; PG8_SCHED;
            PG8_STAGE(PG8_SB(0, 1), b2 + hstepB, voffB);
            PG8_WAIT_V(6); PG8_BAR; PG8_MMA(1, 1, At, B1); PG8_BAR;
            PG8_LDB(B0, 1, 0); PG8_SCHED; PG8_LDA(At, 1, 0); PG8_STAGE(PG8_SA(0, 1), a2 + hstepA, voffA);
            PG8_WAIT_L(8); PG8_BAR; PG8_WAIT_L(0); PG8_MMA(0, 0, At, B0); PG8_BAR; PG8_SCHED;
            PG8_LDB(B1, 1, 1); PG8_STAGE(PG8_SB(1, 0), b3, voffB);
            PG8_BAR; PG8_WAIT_L(0); PG8_MMA(0, 1, At, B1); PG8_BAR;
            PG8_LDA(At, 1, 1); PG8_STAGE(PG8_SA(1, 0), a3, voffA);
            PG8_BAR; PG8_WAIT_L(0); PG8_MMA(1, 0, At, B0); PG8_BAR; PG8_SCHED;
            PG8_STAGE(PG8_SB(1, 1), b3 + hstepB, voffB);
            PG8_WAIT_V(6); PG8_BAR; PG8_MMA(1, 1, At, B1); PG8_BAR;
            }
        }
        if constexpr (ALIGN_EPI) { if (wr == 0) PG8_BAR; }
        if constexpr (!Epi::AFTER_DRAIN) { E(acc, cur, wr, wc, fr, fq); S.done(cur); }
        if (!has_next) break;
#pragma unroll
        for (int a = 0; a < 2; ++a)
#pragma unroll
            for (int b = 0; b < 2; ++b)
#pragma unroll
                for (int m = 0; m < 4; ++m)
#pragma unroll
                    for (int n = 0; n < 2; ++n) acc[a][b][m][n] = (f32x4){0.f, 0.f, 0.f, 0.f};
        cur = nxt; cA = nA; cB = nB; ++ui;
        if constexpr (ALIGN_EPI) { if (wr == 1) PG8_BAR; }
    }
    PG8_WAIT_V(0);
    if constexpr (!ALIGN_EPI) { if (wr == 0) PG8_BAR; }
    PG8_BAR;
    if constexpr (Epi::AFTER_DRAIN) { E.fused(acc, cur, wr, wc, fr, fq, lds, wid, lane); S.done(cur); }
#undef PG8_SA
#undef PG8_SB
#undef PG8_STAGE
#undef PG8_LDA
#undef PG8_LDB
#undef PG8_MMA
#undef PG8_WAIT_V
#undef PG8_WAIT_L
#undef PG8_BAR
#undef PG8_SCHED
}
}

namespace pg8 {
__device__ __forceinline__ unsigned cvt_pk_bf16(float lo, float hi) { unsigned r; asm volatile("v_cvt_pk_bf16_f32 %0, %1, %2" : "=v"(r) : "v"(lo), "v"(hi)); return r; }
template <int ACT> struct EpiStore {
    static constexpr bool PERM = true, AFTER_DRAIN = false;
    bf16_t* O; int ldc;
    __device__ __forceinline__ void operator()(const f32x4 (&acc)[2][2][4][2], const Unit& u, int wr, int wc, int fr, int fq) const {
        const int row0 = u.pm * BM + wr * 64 + fr, col0 = u.pn * BM + wc * 32 + 8 * fq;
#pragma unroll
        for (int ai = 0; ai < 2; ++ai)
#pragma unroll
            for (int m = 0; m < 4; ++m) { bf16_t* rowp = O + (size_t)(row0 + ai * HALF + m * 16) * ldc + col0;
#pragma unroll
                for (int bj = 0; bj < 2; ++bj) { f32x4 v0 = acc[ai][bj][m][0], v1 = acc[ai][bj][m][1];
                    if (ACT == 1) {
#pragma unroll
                        for (int j = 0; j < 4; ++j) { float a = fmaxf(v0[j], 0.f), b = fmaxf(v1[j], 0.f); v0[j] = a * a; v1[j] = b * b; } }
                    u32x4 w; w.x = cvt_pk_bf16(v0[0], v0[1]); w.y = cvt_pk_bf16(v0[2], v0[3]); w.z = cvt_pk_bf16(v1[0], v1[1]); w.w = cvt_pk_bf16(v1[2], v1[3]);
                    *(u32x4*)(rowp + bj * HALF) = w; } }
    }
};
struct EpiResid {
    static constexpr bool PERM = false, AFTER_DRAIN = false;
    const float* xlat; const float* xctx; float* out; const float* gbase; float alpha;
    __device__ __forceinline__ void operator()(const f32x4 (&acc)[2][2][4][2], const Unit& u, int wr, int wc, int fr, int fq) const {
#pragma unroll
        for (int ai = 0; ai < 2; ++ai)
#pragma unroll
            for (int m = 0; m < 4; ++m) {
                const int row = u.pm * BM + ai * HALF + wr * 64 + m * 16 + fr;
                const int v = row < NLAT ? (row >> 12) : 4;
                const float* xin = row < NLAT ? xlat + (size_t)row * DM : xctx + (size_t)(row - NLAT) * DM;
                const float* g = gbase + (size_t)v * ADAW;
                float* op = out + (size_t)row * DM;
#pragma unroll
                for (int bj = 0; bj < 2; ++bj)
#pragma unroll
                    for (int n = 0; n < 2; ++n) { const int col = u.pn * BM + bj * HALF + wc * 32 + n * 16 + fq * 4;
                        const f32x4 x4 = *(const f32x4*)(xin + col), g4 = *(const f32x4*)(g + col);
                        *(f32x4*)(op + col) = x4 * alpha + g4 * acc[ai][bj][m][n]; }
            }
    }
};
struct EpiCtxSplit {
    static constexpr bool PERM = false, AFTER_DRAIN = false;
    float* out; float* part; const float* g;
    __device__ __forceinline__ void operator()(const f32x4 (&acc)[2][2][4][2], const Unit& u, int wr, int wc, int fr, int fq) const {
#pragma unroll
        for (int ai = 0; ai < 2; ++ai)
#pragma unroll
            for (int m = 0; m < 4; ++m) {
                const size_t ro = (size_t)(u.pm * BM + ai * HALF + wr * 64 + m * 16 + fr) * DM;
#pragma unroll
                for (int bj = 0; bj < 2; ++bj)
#pragma unroll
                    for (int n = 0; n < 2; ++n) { const int col = u.pn * BM + bj * HALF + wc * 32 + n * 16 + fq * 4; const f32x4 v = *(const f32x4*)(g + col) * acc[ai][bj][m][n];
                        if (u.ks == 0) *(f32x4*)(out + ro + col) = *(const f32x4*)(out + ro + col) + v; else *(f32x4*)(part + ro + col) = v; }
            }
    }
};
}

struct Args { const float* in[26]; float* out; unsigned char* ws; };
typedef const float* cfp_t;
typedef const __attribute__((address_space(4))) cfp_t* kargp_t;
struct Fr {
    kargp_t kp; float* out; unsigned char* ws; unsigned char* lds;
    int tid, lane, wave, G, gw, NGW;
};
__device__ __forceinline__ const float* inp(const Fr& F, int k) { kargp_t p = F.kp; asm volatile("" : "+s"(p)); return p[k]; }
#define WSP(T, off) ((T*)(F.ws + (off)))
__device__ __forceinline__ Fr RL(const Fr& F0) { Fr F = F0; int t = threadIdx.x; asm volatile("" : "+v"(t)); F.tid = t; F.lane = t & 63; F.wave = __builtin_amdgcn_readfirstlane(t >> 6); F.gw = blockIdx.x * 8 + F.wave; return F; }

__device__ __forceinline__ void phase_ada(const Fr& F) {
    float* sl = (float*)F.lds;
    float* red = sl + 5 * 2048;
    float* ADA = WSP(float, WS_ADA);
    const float* p_c = inp(F, 1); const float* p_cc = inp(F, 3); const float* p_wada = inp(F, 4); const float* p_bada = inp(F, 5);
    for (int i = F.tid; i < 5 * 2048; i += 512) { const float c = (i < 4 * 2048) ? p_c[i] : p_cc[i - 4 * 2048]; sl[i] = siluf_(c); }
    __syncthreads();
    for (int it = blockIdx.x; it < 2 * 384; it += F.G) {
        const int l = it / 384, n0 = (it % 384) * 32, c4 = (F.tid & 7) * 4, ks = F.tid >> 3;
        const float* W = p_wada + (size_t)l * DM * ADAW + n0 + c4;
        f32x4 a0 = (f32x4){0.f, 0.f, 0.f, 0.f}, a1 = a0, a2 = a0, a3 = a0, a4 = a0;
        const int k0 = ks * 32;
#pragma unroll 16
        for (int k = 0; k < 32; ++k) { const f32x4 wv = *(const f32x4*)(W + (size_t)(k0 + k) * ADAW);
            a0 += wv * sl[k0 + k]; a1 += wv * sl[2048 + k0 + k]; a2 += wv * sl[4096 + k0 + k]; a3 += wv * sl[6144 + k0 + k]; a4 += wv * sl[8192 + k0 + k]; }
        *(f32x4*)(red + (ks * 5 + 0) * 32 + c4) = a0; *(f32x4*)(red + (ks * 5 + 1) * 32 + c4) = a1; *(f32x4*)(red + (ks * 5 + 2) * 32 + c4) = a2;
        *(f32x4*)(red + (ks * 5 + 3) * 32 + c4) = a3; *(f32x4*)(red + (ks * 5 + 4) * 32 + c4) = a4;
        __syncthreads();
        if (F.tid < 160) { const int v = F.tid >> 5, ln = F.tid & 31; float s = 0.f;
#pragma unroll 16
            for (int ww = 0; ww < 64; ++ww) s += red[(ww * 5 + v) * 32 + ln];
            ADA[((size_t)l * 5 + v) * ADAW + n0 + ln] = s + p_bada[(size_t)l * ADAW + n0 + ln]; }
        __syncthreads();
    }
    {
        f32x2* RP = WSP(f32x2, WS_ROPE);
        for (int e = blockIdx.x * 512 + F.tid; e < SEQ * 32; e += F.G * 512) { const int t = e >> 5, i = e & 31; const int pos = i < 16 ? (t >> 6) : (t & 63);
            const float freq = exp2f(-(float)(i & 15) * 0.8304820237218406f)  ; float sn, cs; sincosf((float)pos * freq, &sn, &cs); RP[e] = (f32x2){cs, sn}; }
    }
}

__device__ __forceinline__ void transpose_item(const float* W, int K, int N, int NP, bf16* WT, float* scr, int item, int lane) {
    const int nblk = NP / 32, kb = item / nblk, nb = item % nblk, k0 = 64 * kb, n0 = 32 * nb;
    const int l8 = lane & 7, kr = lane >> 3, nn = n0 + 4 * l8; const bool ok = nn < N;
    f32x4 wv[8];
#pragma unroll
    for (int i = 0; i < 8; ++i) { const int kk = 8 * i + kr; wv[i] = ok ? *(const f32x4*)(W + (size_t)(k0 + kk) * N + nn) : (f32x4){0.f, 0.f, 0.f, 0.f}; }
#pragma unroll
    for (int i = 0; i < 8; ++i) { const int kk = 8 * i + kr; float* d = scr + kk * 33 + 4 * l8; d[0] = wv[i][0]; d[1] = wv[i][1]; d[2] = wv[i][2]; d[3] = wv[i][3]; }
    LDS_WAIT();
    const int c = lane & 7;
#pragma unroll
    for (int j = 0; j < 4; ++j) { const int n = (lane >> 3) + 8 * j; const float* s = scr + (8 * c) * 33 + n;
        v4u o; o.x = pk2(s[0 * 33], s[1 * 33]); o.y = pk2(s[2 * 33], s[3 * 33]); o.z = pk2(s[4 * 33], s[5 * 33]); o.w = pk2(s[6 * 33], s[7 * 33]);
        *(v4u*)(WT + (size_t)(n0 + n) * K + k0 + 8 * c) = o; }
    LDS_WAIT();
}
__device__ __forceinline__ void phase_wconv(const Fr& F, int l, int mode, int w0, int nw) {
    float* scr = (float*)F.lds + F.wave * (64 * 33);
    constexpr int I_IN = 32 * 216, I_OUT = 32 * 64, I_M1 = 32 * 256, I_M2 = 128 * 64, I_UQ = 6 * 24, I_UK = 4 * 16, I_UV = 4 * 16;
    constexpr int NIT = I_IN + I_OUT + I_M1 + I_M2 + I_UQ + I_UK + I_UV;
    for (int q = w0; ; q += nw) {
        int it;
        if (mode == 0) { if (q >= I_IN + I_UQ + I_UK + I_UV) break; it = q < I_IN ? q : q + I_OUT + I_M1 + I_M2; }
        else { if (q >= I_OUT + I_M1 + I_M2) break; it = I_IN + q; }
        int r = it;
        if (r < I_IN) { transpose_item(inp(F, 6) + (size_t)l * DM * ZC, DM, ZC, ZP, WSP(bf16, WS_WIN), scr, r, F.lane); continue; } r -= I_IN;
        if (r < I_OUT) { transpose_item(inp(F, 19) + (size_t)l * DM * DM, DM, DM, DM, WSP(bf16, WS_WOUT), scr, r, F.lane); continue; } r -= I_OUT;
        if (r < I_M1) { transpose_item(inp(F, 22) + (size_t)l * DM * FF, DM, FF, FF, WSP(bf16, WS_WM1), scr, r, F.lane); continue; } r -= I_M1;
        if (r < I_M2) { transpose_item(inp(F, 23) + (size_t)l * FF * DM, FF, DM, DM, WSP(bf16, WS_WM2), scr, r, F.lane); continue; } r -= I_M2;
        if (r < I_UQ) { transpose_item(inp(F, 14) + (size_t)l * 384 * 768, 384, 768, 768, WSP(bf16, WS_WUQ), scr, r, F.lane); continue; } r -= I_UQ;
        if (r < I_UK) { transpose_item(inp(F, 15) + (size_t)l * 256 * 512, 256, 512, 512, WSP(bf16, WS_WUK), scr, r, F.lane); continue; } r -= I_UK;
        transpose_item(inp(F, 16) + (size_t)l * 256 * 512, 256, 512, 512, WSP(bf16, WS_WUV), scr, r, F.lane);
    }
}

__device__ __forceinline__ void phase_mod0(const Fr& F) {
    const float* ADA = WSP(float, WS_ADA); bf16* AY = WSP(bf16, WS_AY);
    const float* p_x = inp(F, 0); const float* p_ctx = inp(F, 2);
    f32x4 xv[8], xn[8];
    if (F.gw < RT) { const float* xr = F.gw < NLAT ? p_x + (size_t)F.gw * DM : p_ctx + (size_t)(F.gw - NLAT) * DM;
#pragma unroll
        for (int j = 0; j < 8; ++j) xv[j] = *(const f32x4*)(xr + j * 256 + F.lane * 4); }
    for (int row = F.gw; row < RT; row += F.NGW) {
        { const int rn = row + F.NGW; if (rn < RT) { const float* xr = rn < NLAT ? p_x + (size_t)rn * DM : p_ctx + (size_t)(rn - NLAT) * DM;
#pragma unroll
            for (int j = 0; j < 8; ++j) xn[j] = *(const f32x4*)(xr + j * 256 + F.lane * 4); } }
        const int v = row < NLAT ? (row >> 12) : 4;
        const float* sh = ADA + (size_t)v * ADAW; const float* sc = sh + 2048;
#pragma unroll
        for (int j = 0; j < 8; ++j) { const int col = j * 256 + F.lane * 4;
            const f32x4 x = xv[j], s1 = *(const f32x4*)(sc + col), s0 = *(const f32x4*)(sh + col);
            const f32x4 y = x * (s1 + 1.f) + s0;
            v2u o; o.x = pk2(y[0], y[1]); o.y = pk2(y[2], y[3]);
            *(v2u*)(AY + (size_t)row * DM + col) = o;
            if (row >= NLAT) *(f32x4*)(WSP(float, WS_X) + (size_t)row * DM + col) = x * ALPHA_RES; }
#pragma unroll
        for (int j = 0; j < 8; ++j) xv[j] = xn[j];
    }
}

__device__ __forceinline__ void phase_ln(const Fr& F, int l, int which, int nrows) {
    const float* ADA = WSP(float, WS_ADA); bf16* AY = WSP(bf16, WS_AY); float* X = WSP(float, WS_X);
    const float* lw = (which == 1 ? inp(F, 20) : inp(F, 24)) + (size_t)l * DM; const float* lb = (which == 1 ? inp(F, 21) : inp(F, 25)) + (size_t)l * DM;
    const bool last = (which == 2 && l == 1);
    const size_t aoff = which == 1 ? ((size_t)l * 5 * ADAW + 3 * 2048) : ((size_t)(l + 1) * 5 * ADAW);
    f32x4 scr[8], shr[8]; int cur_vi = -1;
    f32x4 v[8], vn[8], lwr[8], lbr[8];
#pragma unroll
    for (int j = 0; j < 8; ++j) { lwr[j] = *(const f32x4*)(lw + j * 256 + F.lane * 4); lbr[j] = *(const f32x4*)(lb + j * 256 + F.lane * 4); }
    if (F.gw < nrows) {
#pragma unroll
        for (int j = 0; j < 8; ++j) v[j] = *(const f32x4*)(X + (size_t)F.gw * DM + j * 256 + F.lane * 4); }
    for (int row = F.gw; row < nrows; row += F.NGW) {
        float* xr = X + (size_t)row * DM;
        if (row + F.NGW < nrows) {
#pragma unroll
            for (int j = 0; j < 8; ++j) vn[j] = *(const f32x4*)(xr + (size_t)F.NGW * DM + j * 256 + F.lane * 4); }
        float s = 0.f;
#pragma unroll
        for (int j = 0; j < 8; ++j) {
            if (which == 2 && l == 0 && row >= NLAT) v[j] = v[j] + *(const f32x4*)(WSP(float, WS_PART) + (size_t)(row - NLAT) * DM + j * 256 + F.lane * 4);
            s += (v[j][0] + v[j][1]) + (v[j][2] + v[j][3]); }
        const float mean = wave_sum(s) * (1.f / DM); float s2 = 0.f;
#pragma unroll
        for (int j = 0; j < 8; ++j) { v[j] = v[j] - mean; s2 += (v[j][0] * v[j][0] + v[j][1] * v[j][1]) + (v[j][2] * v[j][2] + v[j][3] * v[j][3]); }
        const float rstd = 1.f / sqrtf(wave_sum(s2) * (1.f / DM) + 1e-5f);
        const int vi = row < NLAT ? (row >> 12) : 4;
        if (!last && vi != cur_vi) {
            cur_vi = vi; const float* sh = ADA + aoff + (size_t)vi * ADAW; const float* sc = sh + 2048;
#pragma unroll
            for (int j = 0; j < 8; ++j) { scr[j] = *(const f32x4*)(sc + j * 256 + F.lane * 4) + 1.f; shr[j] = *(const f32x4*)(sh + j * 256 + F.lane * 4); } }
#pragma unroll
        for (int j = 0; j < 8; ++j) { const int col = j * 256 + F.lane * 4;
            const f32x4 y = v[j] * rstd * lwr[j] + lbr[j];
            if (last) { *(f32x4*)(F.out + (size_t)row * DM + col) = y; }
            else { *(f32x4*)(xr + col) = (which == 1) ? y * ALPHA_RES : y;
                const f32x4 a = y * scr[j] + shr[j];
                v2u o; o.x = pk2(a[0], a[1]); o.y = pk2(a[2], a[3]);
                *(v2u*)(AY + (size_t)row * DM + col) = o; }
        }
#pragma unroll
        for (int j = 0; j < 8; ++j) v[j] = vn[j];
    }
}

__device__ __forceinline__ void phase_prep(const Fr& F, int l) {
    const bf16* Z = WSP(bf16, WS_ZH); bf16* GQKV = WSP(bf16, WS_GQKV); float* GB = WSP(float, WS_GB);
    bf16* QN = WSP(bf16, WS_QN); bf16* CKVN = WSP(bf16, WS_CKVN); bf16* KROPE = WSP(bf16, WS_KROPE);
    const float* cw = inp(F, 7) + (size_t)l * 5 * 1536;
    const float* p_alog = inp(F, 8); const float* p_dtb = inp(F, 9); const float* p_qnw = inp(F, 12); const float* p_kvnw = inp(F, 13);
    f32x4 cwr[3][5][2];
#pragma unroll
    for (int g = 0; g < 3; ++g)
#pragma unroll
        for (int i = 0; i < 5; ++i) { cwr[g][i][0] = *(const f32x4*)(cw + i * 1536 + g * 512 + F.lane * 8); cwr[g][i][1] = *(const f32x4*)(cw + i * 1536 + g * 512 + F.lane * 8 + 4); }
    for (int row = F.gw; row < RT; row += F.NGW) {
        const bf16* zr = Z + (size_t)row * ZP;
#pragma unroll
      for (int g = 0; g < 4; ++g) {
        if (g < 3) {
            int t, len; if (row < NLAT) { t = row & 4095; len = SEQ; } else { t = (row - NLAT) & 255; len = CTX; }
            const int c0 = g * 512 + F.lane * 8;
            float acc[8];
#pragma unroll
            for (int j = 0; j < 8; ++j) acc[j] = 0.f;
#pragma unroll
            for (int i = 0; i < 5; ++i) { const int tt = t + i - 2; const bool okt = (tt >= 0 && tt < len);
                {
                    v4u zv = *(const v4u*)(zr + (okt ? (ptrdiff_t)(i - 2) * ZP : (ptrdiff_t)0) + c0); if (!okt) zv = (v4u){0u, 0u, 0u, 0u};
                    const f32x4 w0 = cwr[g][i][0], w1 = cwr[g][i][1];
                    acc[0] += bflo(zv.x) * w0[0]; acc[1] += bfhi(zv.x) * w0[1]; acc[2] += bflo(zv.y) * w0[2]; acc[3] += bfhi(zv.y) * w0[3];
                    acc[4] += bflo(zv.z) * w1[0]; acc[5] += bfhi(zv.z) * w1[1]; acc[6] += bflo(zv.w) * w1[2]; acc[7] += bfhi(zv.w) * w1[3]; } }
            float ss = 0.f;
#pragma unroll
            for (int j = 0; j < 8; ++j) { acc[j] = siluf_(acc[j]); ss += acc[j] * acc[j]; }
            if (g < 2) {
                ss += __shfl_xor(ss, 1); ss += __shfl_xor(ss, 2); ss += __shfl_xor(ss, 4); ss += __shfl_xor(ss, 8);
                float inv = 1.f / sqrtf(ss + 1e-6f); if (g == 0) inv *= 0.08838834764831845f;
#pragma unroll
                for (int j = 0; j < 8; ++j) acc[j] *= inv;
            }
            v4u o; o.x = pk2(acc[0], acc[1]); o.y = pk2(acc[2], acc[3]); o.z = pk2(acc[4], acc[5]); o.w = pk2(acc[6], acc[7]);
            *(v4u*)(GQKV + (size_t)row * 1536 + c0) = o;
            if (g == 0 && F.lane < 16) {
                float r;
                if (F.lane < 8) { const float a = bf2f(zr[2048 + F.lane]); const float x = a + p_dtb[l * 8 + F.lane];
                    const float ee = __expf(-fabsf(x)); const float l1p = (ee < 0.03f) ? ee * (1.f - ee * (0.5f - ee * 0.33333333f)) : __logf(1.f + ee); const float sp = fmaxf(x, 0.f) + l1p;     r = -__expf(p_alog[l * 8 + F.lane]) * sp; }
                else r = sigmoidf_(bf2f(zr[2056 + F.lane - 8]));
                GB[(size_t)row * 16 + F.lane] = r;
            }
        } else {
            {
                const unsigned* p = (const unsigned*)(zr + C_MLA + F.lane * 6); const unsigned w0 = p[0], w1 = p[1], w2 = p[2];
                float x[6] = {bflo(w0), bfhi(w0), bflo(w1), bfhi(w1), bflo(w2), bfhi(w2)};
                float ss = 0.f;
#pragma unroll
                for (int j = 0; j < 6; ++j) ss += x[j] * x[j];
                const float inv = 1.f / sqrtf(wave_sum(ss) * (1.f / 384.f) + 1e-6f);
                const float* nw = p_qnw + l * 384 + F.lane * 6;
                unsigned* q = (unsigned*)(QN + (size_t)row * 384 + F.lane * 6);
                q[0] = pk2(x[0] * inv * nw[0], x[1] * inv * nw[1]); q[1] = pk2(x[2] * inv * nw[2], x[3] * inv * nw[3]); q[2] = pk2(x[4] * inv * nw[4], x[5] * inv * nw[5]);
            }
            {
                const v2u w = *(const v2u*)(zr + C_MLA + 384 + F.lane * 4);
                float x[4] = {bflo(w.x), bfhi(w.x), bflo(w.y), bfhi(w.y)};
                const float ss = x[0] * x[0] + x[1] * x[1] + x[2] * x[2] + x[3] * x[3];
                const float inv = 1.f / sqrtf(wave_sum(ss) * (1.f / 256.f) + 1e-6f);
                const float* nw = p_kvnw + l * 256 + F.lane * 4;
                v2u o; o.x = pk2(x[0] * inv * nw[0], x[1] * inv * nw[1]); o.y = pk2(x[2] * inv * nw[2], x[3] * inv * nw[3]);
                *(v2u*)(CKVN + (size_t)row * 256 + F.lane * 4) = o;
            }
            {
                const float x = bf2f(zr[C_MLA + 640 + F.lane]);
                const float pr = __shfl_xor(x, 1);
                float o = x;
                if (row < NLAT) { const int t = row & 4095, i = F.lane >> 1; const f32x2 rc = WSP(const f32x2, WS_ROPE)[t * 32 + i]; const float cs = rc[0], sn = rc[1];
                    o = (F.lane & 1) ? (pr * sn + x * cs) : (x * cs - pr * sn); }
                KROPE[(size_t)row * 64 + F.lane] = (bf16)f2bf(o);
            }
        }
      }
    }
    { bf16* NAVT = WSP(bf16, WS_NAVT);
      for (int tile = F.gw; tile < (RT / 64) * 8; tile += F.NGW) {
        const int r0 = (tile >> 3) * 64, c0 = (tile & 7) * 64;
        const bf16* zr = Z + (size_t)(r0 + F.lane) * ZP + C_NA + 1024 + c0;
        v4u v[8];
#pragma unroll
        for (int j = 0; j < 8; ++j) v[j] = *(const v4u*)(zr + 8 * j);
        bf16* dst = NAVT + (size_t)c0 * RT + r0 + F.lane;
#pragma unroll
        for (int j = 0; j < 8; ++j) {
            dst[(size_t)(8 * j + 0) * RT] = (bf16)(v[j].x & 0xffffu); dst[(size_t)(8 * j + 1) * RT] = (bf16)(v[j].x >> 16);
            dst[(size_t)(8 * j + 2) * RT] = (bf16)(v[j].y & 0xffffu); dst[(size_t)(8 * j + 3) * RT] = (bf16)(v[j].y >> 16);
            dst[(size_t)(8 * j + 4) * RT] = (bf16)(v[j].z & 0xffffu); dst[(size_t)(8 * j + 5) * RT] = (bf16)(v[j].z >> 16);
            dst[(size_t)(8 * j + 6) * RT] = (bf16)(v[j].w & 0xffffu); dst[(size_t)(8 * j + 7) * RT] = (bf16)(v[j].w >> 16); }
      } }
}

__device__ __forceinline__ void phase_post(const Fr& F, int l, int nrows) {
    const bf16* Z = WSP(bf16, WS_ZH); bf16* Y = WSP(bf16, WS_AY);
    const bf16* OG = (const bf16*)((const unsigned char*)F.out + OUT_OG); const bf16* OH = (const bf16*)((const unsigned char*)F.out + OUT_OH);
    const float* p_gnw = inp(F, 10) + l * 128; const float* p_hnw = inp(F, 18) + l * 128;
    if (F.G - 64 == 192) {
        const bf16* PO = WSP(bf16, WS_PO); const float* PML = WSP(float, WS_PML);
        for (int it = F.gw; it < 64 * 256; it += F.NGW) { const int su = it >> 8, r = it & 255, u = 192 + su, hh = (u >> 4) & 3, qb = u & 15;
            float m[3], lv[3];
#pragma unroll
            for (int p = 0; p < 3; ++p) { m[p] = PML[((size_t)(su * 3 + p) * 256 + r) * 2]; lv[p] = PML[((size_t)(su * 3 + p) * 256 + r) * 2 + 1]; }
            const float M = fmaxf(m[0], fmaxf(m[1], m[2]));
            float L = 0.f, o0 = 0.f, o1 = 0.f;
#pragma unroll
            for (int p = 0; p < 3; ++p) { const float wp = __builtin_amdgcn_exp2f(m[p] - M); L += wp * lv[p];
                const unsigned pv = *(const unsigned*)(PO + ((size_t)(su * 3 + p) * 256 + r) * 128 + F.lane * 2); o0 += wp * bflo(pv); o1 += wp * bfhi(pv); }
            const float inv = 1.f / L;
            *(unsigned*)(Y + (size_t)(3 * SEQ + qb * 256 + r) * DM + 1024 + hh * 128 + F.lane * 2) = pk2(o0 * inv, o1 * inv); }
    }
    float nwr[2][8];
#pragma unroll
    for (int j = 0; j < 8; ++j) { nwr[0][j] = p_gnw[(F.lane & 15) * 8 + j]; nwr[1][j] = p_hnw[(F.lane & 15) * 8 + j]; }
    for (int row = F.gw; row < nrows; row += F.NGW) {
#pragma unroll
      for (int which = 0; which < 2; ++which) {
        const bf16* O = which ? OH : OG;
        const v4u a = *(const v4u*)(O + (size_t)row * 512 + F.lane * 8), b = *(const v4u*)(O + (size_t)(RT + row) * 512 + F.lane * 8);
        const v4u gz = *(const v4u*)(Z + (size_t)row * ZP + (which ? (C_HG + 4 * 512) : 1536) + F.lane * 8);
        float o[8] = {bflo(a.x) + bflo(b.x), bfhi(a.x) + bfhi(b.x), bflo(a.y) + bflo(b.y), bfhi(a.y) + bfhi(b.y), bflo(a.z) + bflo(b.z), bfhi(a.z) + bfhi(b.z), bflo(a.w) + bflo(b.w), bfhi(a.w) + bfhi(b.w)};
        const float gt[8] = {bflo(gz.x), bfhi(gz.x), bflo(gz.y), bfhi(gz.y), bflo(gz.z), bfhi(gz.z), bflo(gz.w), bfhi(gz.w)};
        float ss = 0.f;
#pragma unroll
        for (int j = 0; j < 8; ++j) ss += o[j] * o[j];
        ss += __shfl_xor(ss, 1); ss += __shfl_xor(ss, 2); ss += __shfl_xor(ss, 4); ss += __shfl_xor(ss, 8);
        const float inv = 1.f / sqrtf(ss * (1.f / 128.f) + 1e-6f);
#pragma unroll
        for (int j = 0; j < 8; ++j) o[j] = o[j] * inv * nwr[which][j] * siluf_(gt[j]);
        v4u w; w.x = pk2(o[0], o[1]); w.y = pk2(o[2], o[3]); w.z = pk2(o[4], o[5]); w.w = pk2(o[6], o[7]);
        *(v4u*)(Y + (size_t)row * DM + (which ? 1536 : 0) + F.lane * 8) = w;
      }
    }
}

constexpr int SC_PR = 0, SC_VS = 64 * 288 * 4, SC_SC = SC_VS + 64 * 64 * 4, SC_OB = SC_SC + 64 * 16, SC_END = SC_OB + 64 * 64 * 4;
static_assert(SC_END <= 131072, "scan LDS");
template <int CTRL> __device__ __forceinline__ float dppf(float v) { return __builtin_bit_cast(float, __builtin_amdgcn_update_dpp(0, __builtin_bit_cast(int, v), CTRL, 0xF, 0xF, true)); }
__device__ __forceinline__ float reduce8(float v) { v += dppf<0xB1>(v); v += dppf<0x4E>(v); v += dppf<0x141>(v); return v; }

template <bool GDN>
__device__ __forceinline__ void scan_item(const Fr& F, int l, int item) {
    const int chain = item >> 1, ch = item & 1, b = chain >> 3, h = (chain >> 1) & 3, dir = chain & 1;
    const int tid = F.tid, slice = tid & 7, cl = tid >> 3;
    float* PR = (float*)(F.lds + SC_PR); float* VS = (float*)(F.lds + SC_VS); f32x4* SC = (f32x4*)(F.lds + SC_SC); float* OB = (float*)(F.lds + SC_OB);
    const bf16* Z = WSP(bf16, WS_ZH); const bf16* GQKV = WSP(bf16, WS_GQKV); const float* GB = WSP(float, WS_GB);
    bf16* O = (bf16*)((unsigned char*)F.out + (GDN ? OUT_OG : OUT_OH)) + (size_t)dir * RT * 512 + h * 128 + ch * 64;
    const bf16* srcA; const bf16* srcB; const bf16* srcV; int pitch;
    if (GDN) { pitch = 1536; srcA = GQKV + 512 + h * 128; srcB = GQKV + h * 128; srcV = GQKV + 1024 + h * 128 + ch * 64; }
    else { pitch = ZP; srcA = Z + C_HG + 512 * (1 + dir) + h * 128; srcB = Z + C_HG + h * 128; srcV = Z + C_HG + 3 * 512 + h * 128 + ch * 64; }
    float lbv[2][8];
    if (!GDN) { const float* p_lb = inp(F, 17);
#pragma unroll
        for (int i = 0; i < 2; ++i) { const int d0 = ((tid + 512 * i) & 15) * 8;
#pragma unroll
            for (int j = 0; j < 8; ++j) lbv[i][j] = (l == 0) ? 0.f : sigmoidf_(p_lb[512 + h * 128 + d0 + j] - p_lb[h * 128 + d0 + j]); }
    }
    float S[16];
#pragma unroll
    for (int j = 0; j < 16; ++j) S[j] = 0.f;
    v4u ra[2], rb[2], rv; float rg = 0.f, rbeta = 0.f;
    constexpr int NCH = (CTX + SEQ) / 64;
    int base = 0, sgn = 1;
#define SCAN_ROWS(c) do { const int gs = (c) * 64; if (gs < CTX) { base = NLAT + b * CTX + (dir ? (CTX - 1 - gs) : gs); } else { const int t = gs - CTX; base = b * SEQ + (dir ? (SEQ - 1 - t) : t); } sgn = dir ? -1 : 1; } while (0)
#define SCAN_LOAD() do { _Pragma("unroll") for (int i = 0; i < 2; ++i) { const int p = tid + 512 * i, s = p >> 4, d0 = (p & 15) * 8; const size_t ro = (size_t)(base + sgn * s) * pitch + d0; \
        ra[i] = *(const v4u*)(srcA + ro); rb[i] = *(const v4u*)(srcB + ro); } \
        { const int s = tid >> 3, c0 = (tid & 7) * 8; rv = *(const v4u*)(srcV + (size_t)(base + sgn * s) * pitch + c0); } \
        if (GDN && tid < 64) { const size_t ro = (size_t)(base + sgn * tid) * 16 + dir * 4 + h; rg = GB[ro]; rbeta = GB[ro + 8]; } } while (0)
#define SCAN_STORE() do { _Pragma("unroll") for (int i = 0; i < 2; ++i) { const int p = tid + 512 * i, s = p >> 4, d0 = (p & 15) * 8; \
        float av[8] = {bflo(ra[i].x), bfhi(ra[i].x), bflo(ra[i].y), bfhi(ra[i].y), bflo(ra[i].z), bfhi(ra[i].z), bflo(ra[i].w), bfhi(ra[i].w)}; \
        float bv[8] = {bflo(rb[i].x), bfhi(rb[i].x), bflo(rb[i].y), bfhi(rb[i].y), bflo(rb[i].z), bfhi(rb[i].z), bflo(rb[i].w), bfhi(rb[i].w)}; \
        if (!GDN) { _Pragma("unroll") for (int j = 0; j < 8; ++j) { av[j] = lbv[i][j] + (1.f - lbv[i][j]) * sigmoidf_(av[j]); bv[j] = siluf_(bv[j]) * 0.08838834764831845f; } } \
        float* dst = PR + s * 288 + (d0 >> 4) * 36 + (d0 & 15) * 2; \
        _Pragma("unroll") for (int j = 0; j < 4; ++j) *(f32x4*)(dst + 4 * j) = (f32x4){av[2 * j], bv[2 * j], av[2 * j + 1], bv[2 * j + 1]}; } \
        { const int s = tid >> 3, c0 = (tid & 7) * 8; float* dv = VS + s * 64 + c0; \
          *(f32x4*)dv = (f32x4){bflo(rv.x), bfhi(rv.x), bflo(rv.y), bfhi(rv.y)}; *(f32x4*)(dv + 4) = (f32x4){bflo(rv.z), bfhi(rv.z), bflo(rv.w), bfhi(rv.w)}; } \
        if (GDN && tid < 64) { float* sc = (float*)(SC + tid); sc[0] = __expf(rg); sc[1] = rbeta; } } while (0)
#define SCAN_QK() do { if (GDN) { _Pragma("unroll") for (int e = 0; e < 8; ++e) { const int s = F.wave * 8 + e; const f32x4 kq = *(const f32x4*)(PR + s * 288 + (F.lane >> 3) * 36 + (F.lane & 7) * 4); \
        const float d = wave_sum(kq[0] * kq[1] + kq[2] * kq[3]); if (F.lane == 0) ((float*)(SC + s))[2] = d; } } } while (0)

    SCAN_ROWS(0); SCAN_LOAD(); SCAN_STORE(); __syncthreads(); SCAN_QK(); __syncthreads();
    const float* prs = PR + slice * 36;
    for (int c = 0; c < NCH; ++c) {
        const int obase = base, osgn = sgn;
        if (c + 1 < NCH) { SCAN_ROWS(c + 1); SCAN_LOAD(); }
        f32x4 cur[8];
#pragma unroll
        for (int i = 0; i < 8; ++i) cur[i] = *(const f32x4*)(prs + i * 4);
        f32x4 scv = SC[0]; float vv = VS[cl];
#pragma unroll 2
        for (int s = 0; s < 64; ++s) {
            f32x4 nxt[8]; f32x4 nsc; float nvv;
            const int sn = (s + 1) & 63;
#pragma unroll
            for (int i = 0; i < 8; ++i) nxt[i] = *(const f32x4*)(prs + sn * 288 + i * 4);
            nsc = SC[sn]; nvv = VS[sn * 64 + cl];
            float o;
            if (GDN) {
                float pk = 0.f, pq = 0.f;
#pragma unroll
                for (int i = 0; i < 8; ++i) { pk += cur[i][0] * S[2 * i]; pq += cur[i][1] * S[2 * i]; pk += cur[i][2] * S[2 * i + 1]; pq += cur[i][3] * S[2 * i + 1]; }
                pk = reduce8(pk); pq = reduce8(pq);
                const float a = scv[0], u = scv[1] * (vv - a * pk);
                o = a * pq + scv[2] * u;
#pragma unroll
                for (int i = 0; i < 8; ++i) { S[2 * i] = a * S[2 * i] + cur[i][0] * u; S[2 * i + 1] = a * S[2 * i + 1] + cur[i][2] * u; }
            } else {
                float po = 0.f;
#pragma unroll
                for (int i = 0; i < 8; ++i) { const float f0 = cur[i][0], f1 = cur[i][2];
                    S[2 * i] = f0 * S[2 * i] + (1.f - f0) * vv; S[2 * i + 1] = f1 * S[2 * i + 1] + (1.f - f1) * vv;
                    po += cur[i][1] * S[2 * i]; po += cur[i][3] * S[2 * i + 1]; }
                o = reduce8(po);
            }
            if (slice == 0) OB[s * 64 + cl] = o;
#pragma unroll
            for (int i = 0; i < 8; ++i) cur[i] = nxt[i];
            scv = nsc; vv = nvv;
        }
        __syncthreads();
        {
            const int s = tid >> 3, c0 = (tid & 7) * 8; const float* ob = OB + s * 64 + c0;
            const f32x4 x0 = *(const f32x4*)ob, x1 = *(const f32x4*)(ob + 4);
            v4u w; w.x = pk2(x0[0], x0[1]); w.y = pk2(x0[2], x0[3]); w.z = pk2(x1[0], x1[1]); w.w = pk2(x1[2], x1[3]);
            *(v4u*)(O + (size_t)(obase + osgn * s) * 512 + c0) = w;
        }
        if (c + 1 < NCH) SCAN_STORE();
        __syncthreads();
        if (c + 1 < NCH) SCAN_QK();
        __syncthreads();
    }
#undef SCAN_ROWS
#undef SCAN_LOAD
#undef SCAN_STORE
#undef SCAN_QK
}

__device__ __forceinline__ unsigned cvtpk(float lo, float hi) { unsigned r; asm volatile("v_cvt_pk_bf16_f32 %0, %1, %2" : "=v"(r) : "v"(lo), "v"(hi)); return r; }
template <int DQK, bool NA>
__device__ __forceinline__ void attn_unit(const Fr& F, const bf16* Qh, int qpitch, int qrow0, bool qrope,
                                          const bf16* K1h, int k1pitch, const bf16* Vth,
                                          int kbase0, int n0, int kbase1, int ntiles, bf16* Yh, float sl2, int lo, int qgr, const float* rpbh, int pidx) {
    const bf16* K2 = WSP(bf16, WS_KROPE);
    constexpr int NDC = DQK / 32, KPB = (DQK + 16) * 2, KBUF = 64 * KPB, VPB = 160, VBUF = 128 * VPB,     BUF = KBUF + VBUF, PPR = DQK / 8, NKP = 64 * PPR / 512;
    static_assert(2 * BUF + 2048 <= 131072, "attn LDS");
    unsigned char* lds = F.lds;
    float* bt = (float*)(lds + 2 * BUF);
    const int tid = F.tid, lane = F.lane, w = F.wave, r16 = lane & 15, quad = lane >> 4;
    if (NA) { for (int i = tid; i < 15 * 32; i += 512) { const int dr = i >> 5, dc = i & 31; bt[i] = (rpbh != nullptr && dc < 31) ? rpbh[dr * 31 + dc] * LOG2E : 0.f; } }
    bf16x8 qf[2][NDC];
#pragma unroll
    for (int n = 0; n < 2; ++n) { const int row = qrow0 + w * 32 + n * 16 + r16;
#pragma unroll
        for (int dc = 0; dc < NDC; ++dc) qf[n][dc] = *(const bf16x8*)(Qh + (size_t)row * qpitch + dc * 32 + quad * 8);
        if (!NA && qrope) { const int t = row & 4095;
#pragma unroll
            for (int dc = 4; dc < NDC; ++dc) {
#pragma unroll
                for (int jj = 0; jj < 4; ++jj) { const f32x2 rc = WSP(const f32x2, WS_ROPE)[t * 32 + (dc - 4) * 16 + quad * 4 + jj]; const float cs = rc[0], sn = rc[1];
                    const float x1 = bf2f((unsigned short)qf[n][dc][2 * jj]), x2 = bf2f((unsigned short)qf[n][dc][2 * jj + 1]);
                    qf[n][dc][2 * jj] = (short)f2bf(x1 * cs - x2 * sn); qf[n][dc][2 * jj + 1] = (short)f2bf(x1 * sn + x2 * cs); } } }
    }
    f32x4 o[8][2];
#pragma unroll
    for (int dt = 0; dt < 8; ++dt) { o[dt][0] = (f32x4){0.f, 0.f, 0.f, 0.f}; o[dt][1] = (f32x4){0.f, 0.f, 0.f, 0.f}; }
    float mrun[2] = {-1e30f, -1e30f}, lsum[2] = {0.f, 0.f};
    v4u kreg[NKP], vreg[2];
    const int gr = qgr + (w >> 1);
    const int w0 = min(max(gr - 4, 0), 56);
#define AT_KROW(i) ((i) < n0 ? kbase0 + 64 * (i) : kbase1 + 64 * ((i) - n0))
#define AT_LOADK(i) do { const int kr0 = AT_KROW(i); _Pragma("unroll") for (int x = 0; x < NKP; ++x) { const int p = tid + 512 * x, key = p / PPR, pc = p % PPR; \
        const bf16* src = (pc < 16) ? K1h + (size_t)(kr0 + key) * k1pitch + pc * 8 : K2 + (size_t)(kr0 + key) * 64 + (pc - 16) * 8; kreg[x] = *(const v4u*)src; } } while (0)
#define AT_LOADV(i) do { const int kr0 = AT_KROW(i); _Pragma("unroll") for (int x = 0; x < 2; ++x) { const int p = tid + 512 * x, d = p >> 3, pc = p & 7; vreg[x] = *(const v4u*)(Vth + (size_t)d * RT + kr0 + pc * 8); } } while (0)
#define AT_STOREK(buf) do { _Pragma("unroll") for (int x = 0; x < NKP; ++x) { const int p = tid + 512 * x, key = p / PPR, pc = p % PPR; \
        const int slot = (key & 32) + ((key >> 2) & 1) * 16 + ((key & 31) >> 3) * 4 + (key & 3); *(v4u*)(lds + (buf) * BUF + slot * KPB + pc * 16) = kreg[x]; } } while (0)
#define AT_STOREV(buf) do { _Pragma("unroll") for (int x = 0; x < 2; ++x) { const int p = tid + 512 * x, d = p >> 3, pc = p & 7; *(v4u*)(lds + (buf) * BUF + KBUF + d * VPB + pc * 16) = vreg[x]; } } while (0)
    AT_LOADK(0); AT_LOADV(0); AT_STOREK(0); AT_STOREV(0); __syncthreads();
    for (int i = 0; i < ntiles; ++i) {
        int tid = F.tid; asm volatile("" : "+v"(tid));
        if (i + 1 < ntiles) AT_LOADK(i + 1);
        const bool win = NA && (i < n0);
        const int kr = lo + i;
        const bool active = !win || (kr >= w0 && kr < w0 + 8);
        const unsigned char* kb = lds + (i & 1) * BUF; const unsigned char* vb = kb + KBUF;
#pragma unroll
        for (int sub = 0; sub < 2; ++sub) {
            if (sub == 1 && i + 1 < ntiles) { AT_STOREK((i + 1) & 1); AT_LOADV(i + 1); }
            if (active) {
                f32x4 s[2][2];
                __builtin_amdgcn_s_setprio(1);
#pragma unroll
                for (int t = 0; t < 2; ++t) { s[t][0] = (f32x4){0.f, 0.f, 0.f, 0.f}; s[t][1] = (f32x4){0.f, 0.f, 0.f, 0.f};
                    if (!NA && t == 1) asm volatile("" ::: "memory");
#pragma unroll
                    for (int dc = 0; dc < NDC; ++dc) { const bf16x8 a = *(const bf16x8*)(kb + (sub * 32 + t * 16 + r16) * KPB + dc * 64 + quad * 16);
                        s[t][0] = __builtin_amdgcn_mfma_f32_16x16x32_bf16(a, qf[0][dc], s[t][0], 0, 0, 0);
                        s[t][1] = __builtin_amdgcn_mfma_f32_16x16x32_bf16(a, qf[1][dc], s[t][1], 0, 0, 0); } }
                __builtin_amdgcn_s_setprio(0);
                bf16x8 pb[2];
#pragma unroll
                for (int n = 0; n < 2; ++n) {
                    float mx = -1e30f;
                    const int qc = (w & 1) * 32 + n * 16 + r16; const int c0 = min(max(qc - 8, 0), 48);
#pragma unroll
                    for (int t = 0; t < 2; ++t)
#pragma unroll
                        for (int j = 0; j < 4; ++j) { float x = s[t][n][j] * sl2;
                            if (win) { const int kc = sub * 32 + quad * 8 + t * 4 + j; const bool ok = (kc >= c0) && (kc < c0 + 16);
                                const int dcc = min(max(kc - qc + 15, 0), 30); const float bb = bt[(kr - gr + 7) * 32 + dcc]; x = ok ? x + bb : -1e30f; }
                            s[t][n][j] = x; mx = fmaxf(mx, x); }
                    mx = fmaxf(mx, __shfl_xor(mx, 16)); mx = fmaxf(mx, __shfl_xor(mx, 32));
                    const float mnew = fmaxf(mrun[n], mx), alpha = __builtin_amdgcn_exp2f(mrun[n] - mnew); mrun[n] = mnew;
                    float ps = 0.f;
#pragma unroll
                    for (int t = 0; t < 2; ++t)
#pragma unroll
                        for (int j = 0; j < 4; ++j) { const float p = __builtin_amdgcn_exp2f(s[t][n][j] - mnew); s[t][n][j] = p; ps += p; }
                    lsum[n] = lsum[n] * alpha + ps;
#pragma unroll
                    for (int dt = 0; dt < 8; ++dt) o[dt][n] = o[dt][n] * alpha;
                    v4u u; u.x = cvtpk(s[0][n][0], s[0][n][1]); u.y = cvtpk(s[0][n][2], s[0][n][3]); u.z = cvtpk(s[1][n][0], s[1][n][1]); u.w = cvtpk(s[1][n][2], s[1][n][3]);
                    pb[n] = __builtin_bit_cast(bf16x8, u);
                }
                __builtin_amdgcn_s_setprio(1);
#pragma unroll
                for (int dt = 0; dt < 8; ++dt) { const bf16x8 a = *(const bf16x8*)(vb + (dt * 16 + r16) * VPB + sub * 64 + quad * 16);
                    o[dt][0] = __builtin_amdgcn_mfma_f32_16x16x32_bf16(a, pb[0], o[dt][0], 0, 0, 0);
                    o[dt][1] = __builtin_amdgcn_mfma_f32_16x16x32_bf16(a, pb[1], o[dt][1], 0, 0, 0); }
                __builtin_amdgcn_s_setprio(0);
            }
        }
        if (i + 1 < ntiles) AT_STOREV((i + 1) & 1);
        __syncthreads();
    }
#pragma unroll
    for (int n = 0; n < 2; ++n) { float lt = lsum[n]; lt += __shfl_xor(lt, 16); lt += __shfl_xor(lt, 32);
        const bool part = (pidx >= 0); const float inv = part ? 1.f : 1.f / lt;
        bf16* PO = WSP(bf16, WS_PO) + (size_t)pidx * 256 * 128; float* PML = WSP(float, WS_PML) + (size_t)pidx * 512;
        const int rl = w * 32 + n * 16 + r16, row = qrow0 + rl;
        bf16* dst = part ? PO + (size_t)rl * 128 + quad * 4 : Yh + (size_t)row * DM + quad * 4;
#pragma unroll
        for (int dt = 0; dt < 8; ++dt) { const f32x4 v = o[dt][n] * inv; v2u u; u.x = cvtpk(v[0], v[1]); u.y = cvtpk(v[2], v[3]); *(v2u*)(dst + dt * 16) = u; }
        if (part && quad == 0) { PML[rl * 2] = mrun[n]; PML[rl * 2 + 1] = lt; } }
#undef AT_KROW
#undef AT_LOADK
#undef AT_LOADV
#undef AT_STOREK
#undef AT_STOREV
}


typedef short s16x4 __attribute__((ext_vector_type(4)));
typedef short v4i16_t __attribute__((ext_vector_type(4)));
__device__ __forceinline__ s16x4 ldtr(const unsigned char* p) { return __builtin_bit_cast(s16x4, __builtin_amdgcn_ds_read_tr16_b64_v4i16((LAS v4i16_t*)p)); }
__device__ __forceinline__ bf16x8 cat8(s16x4 a, s16x4 b) { return __builtin_shufflevector(a, b, 0, 1, 2, 3, 4, 5, 6, 7); }
__device__ __forceinline__ bf16x8 pack8(f32x4 a, f32x4 b) { v4u u; u.x = cvtpk(a[0], a[1]); u.y = cvtpk(a[2], a[3]); u.z = cvtpk(b[0], b[1]); u.w = cvtpk(b[2], b[3]); return __builtin_bit_cast(bf16x8, u); }
constexpr int NCHK = (CTX + SEQ) / 64;
__device__ __forceinline__ int chunk_row_lo(int b, int dir, int c) {
    const int gs = c * 64;
    if (gs < CTX) return NLAT + b * CTX + (dir ? (CTX - 64 - gs) : gs);
    const int t = gs - CTX; return b * SEQ + (dir ? (SEQ - 64 - t) : t);
}

__device__ __forceinline__ void hg_lb(const Fr& F, int l, int h, float (&lbv)[8]) {
    const float* p_lb = inp(F, 17); const int d0 = (F.tid & 15) * 8;
#pragma unroll
    for (int j = 0; j < 8; ++j) lbv[j] = (l == 0) ? 0.f : sigmoidf_(p_lb[512 + h * 128 + d0 + j] - p_lb[h * 128 + d0 + j]);
}
__device__ __forceinline__ void hg_load_qf(const Fr& F, int cid, v4u (&ra)[2], v4u (&rb)[2]) {
    const int chain = cid / NCHK, c = cid % NCHK, b = chain >> 3, h = (chain >> 1) & 3, dir = chain & 1; const int row_lo = chunk_row_lo(b, dir, c);
    const bf16* Z = WSP(bf16, WS_ZH);
#pragma unroll
    for (int i = 0; i < 2; ++i) { const int p = F.tid + 512 * i, m = p >> 4, d0 = (p & 15) * 8;
        const bf16* zr = Z + (size_t)(row_lo + m) * ZP + C_HG + h * 128 + d0; ra[i] = *(const v4u*)(zr + 512 * (1 + dir)); rb[i] = *(const v4u*)zr; }
}
__device__ __forceinline__ void hg_compute_qf(const float (&lbv)[8], const v4u (&ra)[2], const v4u (&rb)[2], float (&qv)[2][8], float (&fv)[2][8]) {
#pragma unroll
    for (int i = 0; i < 2; ++i) { const v4u a = ra[i], b = rb[i];
        const float av[8] = {bflo(a.x), bfhi(a.x), bflo(a.y), bfhi(a.y), bflo(a.z), bfhi(a.z), bflo(a.w), bfhi(a.w)};
        const float bv[8] = {bflo(b.x), bfhi(b.x), bflo(b.y), bfhi(b.y), bflo(b.z), bfhi(b.z), bflo(b.w), bfhi(b.w)};
#pragma unroll
        for (int j = 0; j < 8; ++j) { const float lb = lbv[j]; fv[i][j] = lb + (1.f - lb) * sigmoidf_(av[j]); qv[i][j] = siluf_(bv[j]) * 0.08838834764831845f; } }
}
template <int LP> __device__ __forceinline__ void time_cumsum(const Fr& F, float* Lm, float* SEG, int dir) {
    const int d = F.tid & 127, seg = F.tid >> 7;
    float s = 0.f;
#pragma unroll
    for (int i = 0; i < 16; ++i) { const int t = seg * 16 + i, m = dir ? 63 - t : t; s += Lm[m * LP + d]; Lm[m * LP + d] = s; }
    SEG[seg * 128 + d] = s;
    LDS_BARRIER();
    float off = 0.f;
#pragma unroll
    for (int j = 0; j < 3; ++j) if (j < seg) off += SEG[j * 128 + d];
    if (seg > 0) {
#pragma unroll
        for (int i = 0; i < 16; ++i) { const int t = seg * 16 + i, m = dir ? 63 - t : t; Lm[m * LP + d] += off; } }
    LDS_BARRIER();
}
constexpr int HP = 132;
__device__ __forceinline__ void hg_scores(const Fr& F, int l, int cid, int cid_next, v4u (&ra)[2], v4u (&rb)[2]) {
    const int chain = cid / NCHK, h = (chain >> 1) & 3, dir = chain & 1;
    float* Q_ = (float*)F.lds; float* K_ = Q_ + 64 * HP; float* L_ = K_ + 64 * HP; float* SEG = L_ + 64 * HP;
    bf16* SCG = WSP(bf16, WS_HSC) + (size_t)cid * 4096;
    float qv[2][8], fv[2][8];
    {
        float lbv[8];
        hg_lb(F, l, h, lbv);
        hg_compute_qf(lbv, ra, rb, qv, fv);
        if (cid_next < 32 * NCHK) hg_load_qf(F, cid_next, ra, rb);
#pragma unroll
        for (int i = 0; i < 2; ++i) { const int p = F.tid + 512 * i, m = p >> 4, d0 = (p & 15) * 8;
#pragma unroll
            for (int j = 0; j < 8; ++j) { Q_[m * HP + d0 + j] = qv[i][j]; K_[m * HP + d0 + j] = 1.f - fv[i][j]; L_[m * HP + d0 + j] = __logf(fv[i][j]); } }
    }
    LDS_BARRIER();
    time_cumsum<HP>(F, L_, SEG, dir);
    {
        const int mlast = dir ? 0 : 63;
        bf16* QDG = WSP(bf16, WS_HQD) + (size_t)cid * 8192;
        bf16* KEG = (cid < 1664) ? (bf16*)((unsigned char*)F.out + OUT_HKE) + (size_t)cid * 8192 : WSP(bf16, WS_HKE2) + (size_t)(cid - 1664) * 8192;
#pragma unroll
        for (int i = 0; i < 2; ++i) { const int p = F.tid + 512 * i, m = p >> 4, d0 = (p & 15) * 8;
            float qd[8], ke[8];
#pragma unroll
            for (int j = 0; j < 8; ++j) { const float Lv = L_[m * HP + d0 + j], Lt = L_[mlast * HP + d0 + j]; qd[j] = qv[i][j] * __expf(Lv); ke[j] = (1.f - fv[i][j]) * __expf(Lt - Lv); }
            v4u o; o.x = cvtpk(qd[0], qd[1]); o.y = cvtpk(qd[2], qd[3]); o.z = cvtpk(qd[4], qd[5]); o.w = cvtpk(qd[6], qd[7]); *(v4u*)(QDG + m * 128 + d0) = o;
            o.x = cvtpk(ke[0], ke[1]); o.y = cvtpk(ke[2], ke[3]); o.z = cvtpk(ke[4], ke[5]); o.w = cvtpk(ke[6], ke[7]); *(v4u*)(KEG + m * 128 + d0) = o; }
        if (F.tid < 128) WSP(float, WS_HDL)[(size_t)cid * 128 + F.tid] = __expf(L_[mlast * HP + F.tid]);
    }
    const int lane = F.lane, r16 = lane & 15, quad = lane >> 4;
    for (int p = F.wave; p < 16; p += 8) {
        int ip, jp;
        if (p < 10) { ip = (p >= 6) ? 3 : (p >= 3) ? 2 : (p >= 1) ? 1 : 0; jp = p - ip * (ip + 1) / 2; }
        else { const int r = p - 10; ip = (r >= 5) ? 2 : (r >= 3) ? 1 : 0; jp = (r >= 5) ? 3 : (r >= 3) ? (r - 3 + 2) : (r + 1); }
        const int i = dir ? 3 - ip : ip, j = dir ? 3 - jp : jp;
        f32x4 acc = (f32x4){0.f, 0.f, 0.f, 0.f};
        if (p < 10) {
            const int mt = 16 * i + r16, ms = 16 * j + r16, mref = dir ? 16 * i + 15 : 16 * i;
#pragma unroll
            for (int dk = 0; dk < 4; ++dk) { const int d0 = dk * 32 + quad * 8;
                float av[8], bv[8];
#pragma unroll
                for (int hh = 0; hh < 2; ++hh) { const f32x4 q4 = *(const f32x4*)(Q_ + mt * HP + d0 + 4 * hh), lt = *(const f32x4*)(L_ + mt * HP + d0 + 4 * hh), lr = *(const f32x4*)(L_ + mref * HP + d0 + 4 * hh);
                    const f32x4 k4 = *(const f32x4*)(K_ + ms * HP + d0 + 4 * hh), ls = *(const f32x4*)(L_ + ms * HP + d0 + 4 * hh);
#pragma unroll
                    for (int e = 0; e < 4; ++e) { av[4 * hh + e] = q4[e] * __expf(lt[e] - lr[e]); bv[4 * hh + e] = k4[e] * __expf(fminf(lr[e] - ls[e], 85.f)); } }
                v4u ua, ub; ua.x = cvtpk(av[0], av[1]); ua.y = cvtpk(av[2], av[3]); ua.z = cvtpk(av[4], av[5]); ua.w = cvtpk(av[6], av[7]);
                ub.x = cvtpk(bv[0], bv[1]); ub.y = cvtpk(bv[2], bv[3]); ub.z = cvtpk(bv[4], bv[5]); ub.w = cvtpk(bv[6], bv[7]);
                acc = __builtin_amdgcn_mfma_f32_16x16x32_bf16(__builtin_bit_cast(bf16x8, ua), __builtin_bit_cast(bf16x8, ub), acc, 0, 0, 0); }
        }
        const int ms = 16 * j + r16;
#pragma unroll
        for (int e = 0; e < 4; ++e) { const int mt = 16 * i + 4 * quad + e; const bool ok = (p < 10) && (dir ? (ms >= mt) : (ms <= mt));
            SCG[mt * 64 + ms] = (bf16)f2bf(ok ? acc[e] : 0.f); }
    }
    LDS_BARRIER();
}

constexpr int HS_DL = 0, HS_QD = 512, HS_KE = HS_QD + 64 * 272, HS_V = HS_KE + 64 * 272, HS_SC = HS_V + 64 * 272, HS_END = HS_SC + 64 * 144;
static_assert(HS_END <= 131072, "hgrn seq LDS");
__device__ __forceinline__ void hg_seq(const Fr& F, int l, int chain) {
    const int b = chain >> 3, h = (chain >> 1) & 3, dir = chain & 1;
    const int tid = F.tid, lane = F.lane, w = F.wave, r16 = lane & 15, quad = lane >> 4, tq = (lane & 15) >> 2, tp = lane & 3;
    unsigned char* lds = F.lds;
    float* DL = (float*)(lds + HS_DL);
    const bf16* Z = WSP(bf16, WS_ZH);
    bf16* O = (bf16*)((unsigned char*)F.out + OUT_OH) + (size_t)dir * RT * 512 + h * 128 + 16 * w + r16;
    f32x4 S[8];
#pragma unroll
    for (int dt = 0; dt < 8; ++dt) S[dt] = (f32x4){0.f, 0.f, 0.f, 0.f};
    v4u rQ[2], rK[2], rV[2], rS; float rD = 0.f;
#define HS_LOAD(c) do { const int cid = chain * NCHK + (c); const int rl = chunk_row_lo(b, dir, (c)); \
        const bf16* QDG = WSP(bf16, WS_HQD) + (size_t)cid * 8192; \
        const bf16* KEG = (cid < 1664) ? (const bf16*)((const unsigned char*)F.out + OUT_HKE) + (size_t)cid * 8192 : WSP(bf16, WS_HKE2) + (size_t)(cid - 1664) * 8192; \
        _Pragma("unroll") for (int i = 0; i < 2; ++i) { const int p = tid + 512 * i, m = p >> 4, d0 = (p & 15) * 8; rQ[i] = *(const v4u*)(QDG + m * 128 + d0); rK[i] = *(const v4u*)(KEG + m * 128 + d0); \
            rV[i] = *(const v4u*)(Z + (size_t)(rl + m) * ZP + C_HG + 3 * 512 + h * 128 + d0); } \
        rS = *(const v4u*)(WSP(bf16, WS_HSC) + (size_t)cid * 4096 + tid * 8); \
        if (tid < 128) rD = WSP(float, WS_HDL)[(size_t)cid * 128 + tid]; } while (0)
    HS_LOAD(0);
    for (int c = 0; c < NCHK; ++c) {
        const int row_lo = chunk_row_lo(b, dir, c);
#pragma unroll
        for (int i = 0; i < 2; ++i) { const int p = tid + 512 * i, m = p >> 4, d0 = (p & 15) * 8;
            *(v4u*)(lds + HS_QD + m * 272 + d0 * 2) = rQ[i]; *(v4u*)(lds + HS_KE + m * 272 + d0 * 2) = rK[i]; *(v4u*)(lds + HS_V + m * 272 + d0 * 2) = rV[i]; }
        { const int m = tid >> 3, c0 = (tid & 7) * 8; *(v4u*)(lds + HS_SC + m * 144 + c0 * 2) = rS; }
        if (tid < 128) DL[tid] = rD;
        if (c + 1 < NCHK) HS_LOAD(c + 1);
        LDS_BARRIER();
        bf16x8 vb[2], sb[4];
#pragma unroll
        for (int ks = 0; ks < 2; ++ks) { const unsigned char* p0 = lds + HS_V + (32 * ks + 8 * quad + tq) * 272 + (16 * w + 4 * tp) * 2; vb[ks] = cat8(ldtr(p0), ldtr(p0 + 4 * 272)); }
#pragma unroll
        for (int ks = 0; ks < 4; ++ks) sb[ks] = pack8(S[2 * ks], S[2 * ks + 1]);
#pragma unroll
        for (int i = 0; i < 4; ++i) {
            f32x4 acc = (f32x4){0.f, 0.f, 0.f, 0.f};
            const unsigned char* qrow = lds + HS_QD + (16 * i + r16) * 272;
#pragma unroll
            for (int ks = 0; ks < 4; ++ks) { const bf16x8 a = cat8(*(const s16x4*)(qrow + (32 * ks + 4 * quad) * 2), *(const s16x4*)(qrow + (32 * ks + 16 + 4 * quad) * 2));
                acc = __builtin_amdgcn_mfma_f32_16x16x32_bf16(a, sb[ks], acc, 0, 0, 0); }
            const unsigned char* srow = lds + HS_SC + (16 * i + r16) * 144;
#pragma unroll
            for (int ks = 0; ks < 2; ++ks) { const bf16x8 a = *(const bf16x8*)(srow + (32 * ks + 8 * quad) * 2); acc = __builtin_amdgcn_mfma_f32_16x16x32_bf16(a, vb[ks], acc, 0, 0, 0); }
#pragma unroll
            for (int e = 0; e < 4; ++e) O[(size_t)(row_lo + 16 * i + 4 * quad + e) * 512] = (bf16)f2bf(acc[e]);
        }
#pragma unroll
        for (int dt = 0; dt < 8; ++dt) {
            const f32x4 dl = *(const f32x4*)(DL + 16 * dt + 4 * quad);
            f32x4 acc = S[dt] * dl;
#pragma unroll
            for (int ks = 0; ks < 2; ++ks) { const unsigned char* p0 = lds + HS_KE + (32 * ks + 8 * quad + tq) * 272 + (16 * dt + 4 * tp) * 2;
                acc = __builtin_amdgcn_mfma_f32_16x16x32_bf16(cat8(ldtr(p0), ldtr(p0 + 4 * 272)), vb[ks], acc, 0, 0, 0); }
            S[dt] = acc;
        }
        LDS_BARRIER();
    }
#undef HS_LOAD
}

__device__ __forceinline__ void gd_pre(const Fr& F, int cid) {
    const int chain = cid / NCHK, c = cid % NCHK, b = chain >> 3, h = (chain >> 1) & 3, dir = chain & 1;
    const int row_lo = chunk_row_lo(b, dir, c), lane = F.lane, r16 = lane & 15, quad = lane >> 4;
    float* Af = (float*)(F.lds + F.wave * 16896);
    float* cumL = Af + 4096; float* betaL = cumL + 64;
    const bf16* GQKV = WSP(bf16, WS_GQKV); const float* GB = WSP(float, WS_GB);
    bf16* T1G = (bf16*)((unsigned char*)F.out + OUT_GT) + (size_t)cid * 2 * 4096; bf16* ATG = T1G + 4096;
    float* SCL = WSP(float, WS_GSCAL) + (size_t)cid * 132;
    const float g = GB[(size_t)(row_lo + lane) * 16 + dir * 4 + h], beta = GB[(size_t)(row_lo + lane) * 16 + 8 + dir * 4 + h];
    float cum = g;
#pragma unroll
    for (int off = 1; off < 64; off <<= 1) { const float v = dir ? __shfl_down(cum, off) : __shfl_up(cum, off); const bool ok = dir ? (lane + off < 64) : (lane >= off); if (ok) cum += v; }
    cumL[lane] = cum; betaL[lane] = beta;
    const float last = __shfl(cum, dir ? 0 : 63);
    SCL[lane] = __expf(cum); SCL[64 + lane] = __expf(last - cum); if (lane == 0) SCL[128] = __expf(last);
    LDS_WAIT();
#pragma unroll 1
    for (int i = 0; i < 4; ++i) {
        bf16x8 qf[4], kfi[4];
#pragma unroll
        for (int dk = 0; dk < 4; ++dk) { const bf16* gr = GQKV + (size_t)(row_lo + 16 * i + r16) * 1536 + h * 128 + dk * 32 + quad * 8; qf[dk] = *(const bf16x8*)gr; kfi[dk] = *(const bf16x8*)(gr + 512); }
#pragma unroll 1
        for (int j2 = 0; j2 < 2; ++j2) {
            bf16x8 kfj[2][4];
#pragma unroll
            for (int jj = 0; jj < 2; ++jj)
#pragma unroll
                for (int dk = 0; dk < 4; ++dk) kfj[jj][dk] = *(const bf16x8*)(GQKV + (size_t)(row_lo + 16 * (2 * j2 + jj) + r16) * 1536 + 512 + h * 128 + dk * 32 + quad * 8);
#pragma unroll
            for (int jj = 0; jj < 2; ++jj) { const int j = 2 * j2 + jj;
                f32x4 kk = (f32x4){0.f, 0.f, 0.f, 0.f}, qk = (f32x4){0.f, 0.f, 0.f, 0.f};
#pragma unroll
                for (int dk = 0; dk < 4; ++dk) { kk = __builtin_amdgcn_mfma_f32_16x16x32_bf16(kfi[dk], kfj[jj][dk], kk, 0, 0, 0); qk = __builtin_amdgcn_mfma_f32_16x16x32_bf16(qf[dk], kfj[jj][dk], qk, 0, 0, 0); }
                const int ms = 16 * j + r16, s = dir ? 63 - ms : ms; const float cs = cumL[ms];
#pragma unroll
                for (int e = 0; e < 4; ++e) { const int mt = 16 * i + 4 * quad + e, t = dir ? 63 - mt : mt;
                    const float dec = __expf(fminf(cumL[mt] - cs, 0.f));
                    Af[t * 64 + s] = (s < t) ? betaL[mt] * kk[e] * dec : 0.f;
                    ATG[mt * 64 + ms] = (bf16)f2bf((s <= t) ? qk[e] * dec : 0.f); } }
        }
    }
    LDS_WAIT();
    for (int t = 0; t < 64; ++t) {
        float v0 = (t == lane) ? 1.f : 0.f, v1 = 0.f, v2 = 0.f, v3 = 0.f;
        for (int s0 = 0; s0 < t; s0 += 16) {
            f32x4 a[4]; float ts[16];
#pragma unroll
            for (int x = 0; x < 4; ++x) a[x] = *(const f32x4*)(Af + t * 64 + s0 + 4 * x);
#pragma unroll
            for (int x = 0; x < 16; ++x) ts[x] = Af[(s0 + x) * 64 + lane];
#pragma unroll
            for (int x = 0; x < 4; ++x) {
                v0 -= (s0 + 4 * x + 0 < t) ? a[x][0] * ts[4 * x + 0] : 0.f; v1 -= (s0 + 4 * x + 1 < t) ? a[x][1] * ts[4 * x + 1] : 0.f;
                v2 -= (s0 + 4 * x + 2 < t) ? a[x][2] * ts[4 * x + 2] : 0.f; v3 -= (s0 + 4 * x + 3 < t) ? a[x][3] * ts[4 * x + 3] : 0.f; }
        }
        const float v = (v0 + v1) + (v2 + v3);
        Af[t * 64 + lane] = v;
    }
    LDS_WAIT();
    const int msl = dir ? 63 - lane : lane; const float bs = betaL[msl];
    for (int t = 0; t < 64; ++t) { const int mt = dir ? 63 - t : t; const float tv = Af[t * 64 + lane]; T1G[mt * 64 + msl] = (bf16)f2bf(tv * bs); }
    LDS_WAIT();
}

constexpr int GS_T1 = 0, GS_T2 = 9216, GS_AT = 18432, GS_K = 27648, GS_Q = GS_K + 17408, GS_V = GS_Q + 17408, GS_W = GS_V + 17408, GS_SCL = GS_W + 17408, GS_END = GS_SCL + 1024;
static_assert(GS_END <= 131072, "gdn seq LDS");
__device__ __forceinline__ void gd_seq(const Fr& F, int chain) {
    const int b = chain >> 3, h = (chain >> 1) & 3, dir = chain & 1;
    const int tid = F.tid, lane = F.lane, w = F.wave, r16 = lane & 15, quad = lane >> 4, tq = (lane & 15) >> 2, tp = lane & 3;
    unsigned char* lds = F.lds;
    const bf16* GQKV = WSP(bf16, WS_GQKV);
    const bf16* TG = (const bf16*)((const unsigned char*)F.out + OUT_GT) + (size_t)chain * NCHK * 2 * 4096;
    const float* SCG = WSP(float, WS_GSCAL) + (size_t)chain * NCHK * 132;
    float* SCL = (float*)(lds + GS_SCL);
    bf16* O = (bf16*)((unsigned char*)F.out + OUT_OG) + (size_t)dir * RT * 512 + h * 128 + 16 * w + r16;
    f32x4 S[8];
#pragma unroll
    for (int dt = 0; dt < 8; ++dt) S[dt] = (f32x4){0.f, 0.f, 0.f, 0.f};
    v4u rT[2], rK[2], rQ[2], rV[2]; f32x4 rE[2]; float rS = 0.f;
#define GS_LOAD(c) do { const int rl = chunk_row_lo(b, dir, (c)); \
        _Pragma("unroll") for (int x = 0; x < 2; ++x) rT[x] = *(const v4u*)(TG + ((size_t)(c) * 2 + x) * 4096 + tid * 8); \
        rE[0] = *(const f32x4*)(SCG + (size_t)(c) * 132 + (tid & 7) * 8); rE[1] = *(const f32x4*)(SCG + (size_t)(c) * 132 + (tid & 7) * 8 + 4); \
        _Pragma("unroll") for (int i = 0; i < 2; ++i) { const int p = tid + 512 * i, m = p >> 4, d0 = (p & 15) * 8; const bf16* gr = GQKV + (size_t)(rl + m) * 1536 + h * 128 + d0; \
            rQ[i] = *(const v4u*)gr; rK[i] = *(const v4u*)(gr + 512); rV[i] = *(const v4u*)(gr + 1024); } \
        if (tid < 132) rS = SCG[(size_t)(c) * 132 + tid]; } while (0)
    GS_LOAD(0);
    for (int c = 0; c < NCHK; ++c) {
        const int row_lo = chunk_row_lo(b, dir, c);
        { const int m = tid >> 3, c0 = (tid & 7) * 8;
          *(v4u*)(lds + GS_T1 + m * 144 + c0 * 2) = rT[0]; *(v4u*)(lds + GS_AT + m * 144 + c0 * 2) = rT[1];
          v4u t2; t2.x = cvtpk(-bflo(rT[0].x) * rE[0][0], -bfhi(rT[0].x) * rE[0][1]); t2.y = cvtpk(-bflo(rT[0].y) * rE[0][2], -bfhi(rT[0].y) * rE[0][3]);
          t2.z = cvtpk(-bflo(rT[0].z) * rE[1][0], -bfhi(rT[0].z) * rE[1][1]); t2.w = cvtpk(-bflo(rT[0].w) * rE[1][2], -bfhi(rT[0].w) * rE[1][3]);
          *(v4u*)(lds + GS_T2 + m * 144 + c0 * 2) = t2; }
#pragma unroll
        for (int i = 0; i < 2; ++i) { const int p = tid + 512 * i, m = p >> 4, d0 = (p & 15) * 8;
            *(v4u*)(lds + GS_K + m * 272 + d0 * 2) = rK[i]; *(v4u*)(lds + GS_Q + m * 272 + d0 * 2) = rQ[i]; *(v4u*)(lds + GS_V + m * 272 + d0 * 2) = rV[i]; }
        if (tid < 132) SCL[tid] = rS;
        if (c + 1 < NCHK) GS_LOAD(c + 1);
        LDS_BARRIER();
        {
            bf16x8 kb[2];
#pragma unroll
            for (int ks = 0; ks < 2; ++ks) { const unsigned char* p0 = lds + GS_K + (32 * ks + 8 * quad + tq) * 272 + (16 * w + 4 * tp) * 2; kb[ks] = cat8(ldtr(p0), ldtr(p0 + 4 * 272)); }
#pragma unroll
            for (int i = 0; i < 4; ++i) { f32x4 acc = (f32x4){0.f, 0.f, 0.f, 0.f};
                const unsigned char* trow = lds + GS_T2 + (16 * i + r16) * 144;
#pragma unroll
                for (int ks = 0; ks < 2; ++ks) acc = __builtin_amdgcn_mfma_f32_16x16x32_bf16(*(const bf16x8*)(trow + (32 * ks + 8 * quad) * 2), kb[ks], acc, 0, 0, 0);
#pragma unroll
                for (int e = 0; e < 4; ++e) *(bf16*)(lds + GS_W + (16 * i + 4 * quad + e) * 272 + (16 * w + r16) * 2) = (bf16)f2bf(acc[e]); }
        }
        LDS_BARRIER();
        {
            bf16x8 vb[2], sb[4];
#pragma unroll
            for (int ks = 0; ks < 2; ++ks) { const unsigned char* p0 = lds + GS_V + (32 * ks + 8 * quad + tq) * 272 + (16 * w + 4 * tp) * 2; vb[ks] = cat8(ldtr(p0), ldtr(p0 + 4 * 272)); }
#pragma unroll
            for (int ks = 0; ks < 4; ++ks) sb[ks] = pack8(S[2 * ks], S[2 * ks + 1]);
            f32x4 vn[4];
#pragma unroll
            for (int i = 0; i < 4; ++i) { f32x4 acc = (f32x4){0.f, 0.f, 0.f, 0.f};
                const unsigned char* trow = lds + GS_T1 + (16 * i + r16) * 144;
#pragma unroll
                for (int ks = 0; ks < 2; ++ks) acc = __builtin_amdgcn_mfma_f32_16x16x32_bf16(*(const bf16x8*)(trow + (32 * ks + 8 * quad) * 2), vb[ks], acc, 0, 0, 0);
                const unsigned char* wrow = lds + GS_W + (16 * i + r16) * 272;
#pragma unroll
                for (int ks = 0; ks < 4; ++ks) acc = __builtin_amdgcn_mfma_f32_16x16x32_bf16(cat8(*(const s16x4*)(wrow + (32 * ks + 4 * quad) * 2), *(const s16x4*)(wrow + (32 * ks + 16 + 4 * quad) * 2)), sb[ks], acc, 0, 0, 0);
                vn[i] = acc; }
            bf16x8 vnb[2];
#pragma unroll
            for (int ks = 0; ks < 2; ++ks) vnb[ks] = pack8(vn[2 * ks], vn[2 * ks + 1]);
#pragma unroll
            for (int i = 0; i < 4; ++i) { f32x4 acc = (f32x4){0.f, 0.f, 0.f, 0.f};
                const unsigned char* qrow = lds + GS_Q + (16 * i + r16) * 272;
#pragma unroll
                for (int ks = 0; ks < 4; ++ks) acc = __builtin_amdgcn_mfma_f32_16x16x32_bf16(cat8(*(const s16x4*)(qrow + (32 * ks + 4 * quad) * 2), *(const s16x4*)(qrow + (32 * ks + 16 + 4 * quad) * 2)), sb[ks], acc, 0, 0, 0);
                acc = acc * *(const f32x4*)(SCL + 16 * i + 4 * quad);
                const unsigned char* arow = lds + GS_AT + (16 * i + r16) * 144;
#pragma unroll
                for (int ks = 0; ks < 2; ++ks) acc = __builtin_amdgcn_mfma_f32_16x16x32_bf16(cat8(*(const s16x4*)(arow + (32 * ks + 4 * quad) * 2), *(const s16x4*)(arow + (32 * ks + 16 + 4 * quad) * 2)), vnb[ks], acc, 0, 0, 0);
#pragma unroll
                for (int e = 0; e < 4; ++e) O[(size_t)(row_lo + 16 * i + 4 * quad + e) * 512] = (bf16)f2bf(acc[e]); }
#pragma unroll
            for (int i = 0; i < 4; ++i) vn[i] = vn[i] * *(const f32x4*)(SCL + 64 + 16 * i + 4 * quad);
#pragma unroll
            for (int ks = 0; ks < 2; ++ks) vnb[ks] = pack8(vn[2 * ks], vn[2 * ks + 1]);
            const float elast = SCL[128];
#pragma unroll
            for (int dt = 0; dt < 8; ++dt) { f32x4 acc = S[dt] * elast;
#pragma unroll
                for (int ks = 0; ks < 2; ++ks) { const unsigned char* p0 = lds + GS_K + (32 * ks + 4 * quad + tq) * 272 + (16 * dt + 4 * tp) * 2;
                    acc = __builtin_amdgcn_mfma_f32_16x16x32_bf16(cat8(ldtr(p0), ldtr(p0 + 16 * 272)), vnb[ks], acc, 0, 0, 0); }
                S[dt] = acc; }
        }
        LDS_BARRIER();
    }
#undef GS_LOAD
}

__device__ __forceinline__ void phase_prepass(const Fr& F, int l) {
    {
        const int N = 32 * NCHK, bx = blockIdx.x; int c0, cstep, cend;
        if (F.G == 256) { if (bx < 240) { c0 = bx; cstep = 240; cend = N - 64; } else { c0 = N - 64 + (bx - 240); cstep = 16; cend = N; } }
        else { c0 = bx; cstep = F.G; cend = N; }
        v4u ra[2], rb[2]; if (c0 < cend) hg_load_qf(F, c0, ra, rb);
        for (int cid = c0; cid < cend; cid += cstep) hg_scores(F, l, cid, (cid + cstep < cend) ? cid + cstep : N, ra, rb);
    }
    __syncthreads();
    for (int cid = (F.G - 1 - (int)blockIdx.x) * 8 + F.wave; cid < 32 * NCHK; cid += F.NGW) gd_pre(F, cid);
    __syncthreads();
}

#define XB_TMO      128
#define XB_XCNT(j)  (256  + 64 * (j))
#define XB_XSUB(j)  (1280 + 64 * (j))
#define XB_XGEN(j)  (2304 + 64 * (j))
#define XB_TOP      3328
#define XB_TOPGEN   3392
#define XCD_BAR_WORDS 3456
#define XB_SPIN_CAP (1u << 18)

__device__ __forceinline__ unsigned xb_ld(unsigned* p)              { return __hip_atomic_load(p, __ATOMIC_RELAXED, __HIP_MEMORY_SCOPE_AGENT); }
__device__ __forceinline__ unsigned xb_add(unsigned* p, unsigned v) { return __hip_atomic_fetch_add(p, v, __ATOMIC_RELAXED, __HIP_MEMORY_SCOPE_AGENT); }
__device__ __forceinline__ unsigned xb_xcc_id() { return (unsigned)__builtin_amdgcn_s_getreg((3 << 11) | 20) & 0xFu; }
#define XB_SPIN(cond, bar) do { unsigned _sp = 0; while (cond) { __builtin_amdgcn_s_sleep(1); \
    if ((++_sp & 255u) == 0u) { if (xb_ld(&(bar)[XB_TMO])) break; if (_sp > XB_SPIN_CAP) { atomicAdd(&(bar)[XB_TMO], 1u); break; } } } } while (0)

struct XcdBarrier {
    unsigned* bar; unsigned x;
    volatile LAS unsigned* st;
};

__device__ __forceinline__ XcdBarrier xcd_barrier_post(unsigned* bar, volatile LAS unsigned* st) {
    XcdBarrier b; b.bar = bar; b.x = xb_xcc_id(); b.st = st;
    if (threadIdx.x == 0) (void)xb_add(&bar[XB_XCNT(b.x)], 1u);
    return b;
}
__device__ __forceinline__ void xcd_barrier_complete(unsigned* bar, unsigned x, unsigned& nloc, unsigned& nx) {
    const unsigned G = gridDim.x * gridDim.y * gridDim.z;
    unsigned sum, cnt, mine, sp = 0u;
    for (;;) {
        sum = 0u; cnt = 0u; mine = 0u;
#pragma unroll
        for (unsigned j = 0; j < 16; ++j) { const unsigned c = xb_ld(&bar[XB_XCNT(j)]); sum += c; cnt += (c > 0u) ? 1u : 0u; mine = (j == x) ? c : mine; }
        if (sum == G) break;
        __builtin_amdgcn_s_sleep(1);
        if ((++sp & 255u) == 0u) { if (xb_ld(&bar[XB_TMO])) break; if (sp > XB_SPIN_CAP) { atomicAdd(&bar[XB_TMO], 1u); break; } }
    }
    nloc = mine > 0u ? mine : 1u; nx = cnt > 0u ? cnt : 1u;
}

__device__ __forceinline__ void xcd_barrier(const XcdBarrier& b) {
    asm volatile("s_waitcnt vmcnt(0)" ::: "memory");
    __syncthreads();
    if (threadIdx.x == 0) {
        unsigned* bar = b.bar;
        __builtin_amdgcn_s_waitcnt(0);
        unsigned nloc = b.st[0], nx = b.st[1];
        if (nloc == 0u) { xcd_barrier_complete(bar, b.x, nloc, nx); b.st[0] = nloc; b.st[1] = nx; }
        const unsigned old = xb_add(&bar[XB_XSUB(b.x)], 1u);
        const unsigned gen = old / nloc;
        if (old + 1u == (gen + 1u) * nloc) {
            __builtin_amdgcn_fence(__ATOMIC_RELEASE, "agent");
            asm volatile("s_waitcnt vmcnt(0)" ::: "memory");
            const unsigned og = xb_add(&bar[XB_TOP], 1u);
            const unsigned tg = og / nx;
            if (og + 1u == (tg + 1u) * nx) xb_add(&bar[XB_TOPGEN], 1u);
            else XB_SPIN(xb_ld(&bar[XB_TOPGEN]) == tg, bar);
            __builtin_amdgcn_fence(__ATOMIC_ACQUIRE, "agent");
            xb_add(&bar[XB_XGEN(b.x)], 1u);
            asm volatile("s_waitcnt vmcnt(0)" ::: "memory");
        } else {
            XB_SPIN(xb_ld(&bar[XB_XGEN(b.x)]) == gen, bar);
            __builtin_amdgcn_fence(__ATOMIC_ACQUIRE, "agent");
            asm volatile("s_waitcnt vmcnt(0)" ::: "memory");
        }
    }
    __syncthreads();
}

__device__ __forceinline__ void phase_mixers(const Fr& F, int l) {
    const int G = F.G, nscan = 64, bx = blockIdx.x;
    const bool split = (G == 256);
    const int natt = split ? 192 : G, ab = split ? bx - nscan : bx;
    for (int it = bx; it < 64; it += G) { if (it < 32) gd_seq(RL(F), it); else hg_seq(RL(F), l, it - 32); __syncthreads(); }
    const bf16* Z = WSP(bf16, WS_ZH); bf16* Y = WSP(bf16, WS_AY);
    const bf16* MQ = WSP(bf16, WS_MQ); const bf16* MK = WSP(bf16, WS_MK); const bf16* MVT = WSP(bf16, WS_MVT); const bf16* NAVT = WSP(bf16, WS_NAVT); const bf16* KROPE = WSP(bf16, WS_KROPE);
    const int ntot = 512 + (l == 0 ? 32 : 0);
    const float sl_mla = 0.07216878364870322f * LOG2E, sl_na = 0.08838834764831845f * LOG2E;
    for (int k = 0; ; ++k) {
        int p, t0 = 0, nl = 64, pidx = -1;
        if (split && bx < 64) {
            if (bx < 32) { if (k >= 1) break; p = 256 + 64 + bx; } else { if (k >= 2) break; p = 256 + 2 * (bx - 32) + k; }
        } else if (split) {
            if (k == 0) p = ab;
            else if (k == 1) { const int su = ab / 3, part = ab - 3 * su; p = 192 + su; t0 = part * 23; nl = part == 2 ? 18 : 23; pidx = ab; }
            else if (k == 2) { if (ab >= 160) continue; p = 256 + 96 + ab; }
            else if (k == 3) { if (l != 0 || ab < 160) break; p = 512 + (ab - 160); }
            else break;
        } else { p = ab + k * natt; if (p >= ntot) break; }
        if (p < 256 || (p >= 512 && p < 528)) {
            const bool lat = p < 256; const int b_ = lat ? (p >> 6) : ((p - 512) >> 2), h_ = lat ? ((p >> 4) & 3) : (p & 3), qb_ = p & 15;
            attn_unit<192, false>(RL(F), MQ + h_ * 192, 768, lat ? b_ * SEQ + qb_ * 256 : NLAT + b_ * CTX, lat, MK + h_ * 128, 512, MVT + (size_t)h_ * 128 * RT,
                                  lat ? b_ * SEQ + t0 * 64 : 0, lat ? nl : 0, NLAT + b_ * CTX, lat ? ((pidx >= 0 && t0 < 46) ? nl : nl + 4) : 4, Y + 1024 + h_ * 128, sl_mla, 0, 0, nullptr, pidx);
        } else {
            const bool lat = p < 512; const int v_ = lat ? p - 256 : p - 528, b_ = lat ? (v_ >> 6) : (v_ >> 2), h_ = lat ? ((v_ >> 4) & 3) : (v_ & 3), rg_ = v_ & 15;
            const int lo_ = min(max(4 * rg_ - 4, 0), 56), hi_ = min(max(4 * rg_ + 3 - 4, 0), 56) + 7, nwin_ = lat ? hi_ - lo_ + 1 : 0;
            attn_unit<128, true>(RL(F), Z + C_NA + h_ * 128, ZP, lat ? b_ * SEQ + rg_ * 256 : NLAT + b_ * CTX, false, Z + C_NA + 512 + h_ * 128, ZP, NAVT + (size_t)h_ * 128 * RT,
                                 lat ? b_ * SEQ + lo_ * 64 : 0, nwin_, NLAT + b_ * CTX, nwin_ + 4, Y + 512 + h_ * 128, sl_na, lat ? lo_ : 0, lat ? 4 * rg_ : 0,
                                 lat ? inp(F, 11) + (size_t)(l * 4 + h_) * 15 * 31 : nullptr, -1);
        }
        __syncthreads();
    }
}

template <class Epi, bool OPAQUE_K = false>
__device__ __forceinline__ void run_gemm(const Fr& F, const bf16* A, const bf16* Bt, int M, int N, int K, const Epi& E) {
    if (OPAQUE_K) asm volatile("" : "+s"(K));
    pg8::Gemm g{A, Bt, M, N, K, K, K}; pg8::StaticOrder S; S.init(M, N, F.G, (int)blockIdx.x);
    pg8::gemm_phase<Epi, pg8::StaticOrder, true, true>((LAS unsigned char*)F.lds, g, S, E);
}

__device__ __forceinline__ void run_gemm_splitk(const Fr& F, const bf16* A, int lda, const bf16* Bt, int ldb, int M, int N, int K, int KS, const pg8::EpiCtxSplit& E) {
    pg8::Gemm g{A, Bt, M, N, K, lda, ldb}; pg8::SplitKOrder S; S.init(M, N, KS, F.G, (int)blockIdx.x);
    pg8::gemm_phase<pg8::EpiCtxSplit, pg8::SplitKOrder, true, true>((LAS unsigned char*)F.lds, g, S, E);
}

__global__ void __launch_bounds__(512, 2) mk_fwd(Args args) {
    extern __shared__ __attribute__((aligned(16))) unsigned char lds[];
    cg::grid_group grid = cg::this_grid();
    Fr F; F.kp = (kargp_t)__builtin_amdgcn_kernarg_segment_ptr(); F.out = args.out; F.ws = args.ws; F.lds = lds;
    F.tid = threadIdx.x; F.lane = F.tid & 63; F.wave = __builtin_amdgcn_readfirstlane(F.tid >> 6); F.G = gridDim.x;
    F.gw = blockIdx.x * 8 + F.wave; F.NGW = F.G * 8;
#define ADA WSP(float, WS_ADA)
#define AY WSP(bf16, WS_AY)
#define X WSP(float, WS_X)
#define ZH WSP(bf16, WS_ZH)
    unsigned* barw = (unsigned*)args.ws;
    if (blockIdx.x == 0) for (int i = threadIdx.x; i < 4096; i += 512) barw[i] = 0u;
    volatile LAS unsigned* bst = (volatile LAS unsigned*)((LAS unsigned char*)lds + 144000);
    if (threadIdx.x < 4) bst[threadIdx.x] = 0u;
    __syncthreads();

    phase_ada(RL(F)); __syncthreads(); { const Fr Fw = RL(F); phase_wconv(Fw, 0, 0, Fw.gw, Fw.NGW); }
    grid.sync();
    const XcdBarrier xb = xcd_barrier_post(barw, bst);
    phase_mod0(RL(F));
    xcd_barrier(xb);
    for (int l = 0; l < 2; ++l) {
        const int MR = (l == 0) ? RT : NLAT;
        run_gemm(F, AY, WSP(bf16, WS_WIN), RT, ZP, DM, pg8::EpiStore<0>{ZH, ZP});
        {
            const int rem = ((RT / 256) * (ZP / 256)) % F.G, first = rem == 0 ? 0 : rem;
            if ((int)blockIdx.x >= first) { __syncthreads(); const Fr Fw = RL(F); phase_wconv(Fw, l, 1, ((int)blockIdx.x - first) * 8 + Fw.wave, (F.G - first) * 8); }
        }
        xcd_barrier(xb);
        phase_prep(RL(F), l);
        xcd_barrier(xb);
        run_gemm<pg8::EpiStore<0>, true>(F, WSP(bf16, WS_QN), WSP(bf16, WS_WUQ), RT, 768, 384, pg8::EpiStore<0>{WSP(bf16, WS_MQ), 768});
        run_gemm<pg8::EpiStore<0>, true>(F, WSP(bf16, WS_CKVN), WSP(bf16, WS_WUK), RT, 512, 256, pg8::EpiStore<0>{WSP(bf16, WS_MK), 512});
        run_gemm<pg8::EpiStore<0>, true>(F, WSP(bf16, WS_WUV), WSP(bf16, WS_CKVN), 512, RT, 256, pg8::EpiStore<0>{WSP(bf16, WS_MVT), RT});
        phase_prepass(RL(F), l);
        xcd_barrier(xb);
        phase_mixers(RL(F), l);
        xcd_barrier(xb);
        phase_post(RL(F), l, MR);
        xcd_barrier(xb);
        if (l == 0) run_gemm(F, AY, WSP(bf16, WS_WOUT), RT, DM, DM, pg8::EpiResid{inp(F, 0), inp(F, 2), X, ADA + 2 * 2048, ALPHA_RES});
        else run_gemm(F, AY, WSP(bf16, WS_WOUT), NLAT, DM, DM, pg8::EpiResid{X, X, X, ADA + (size_t)5 * ADAW + 2 * 2048, ALPHA_RES});
        xcd_barrier(xb);
        phase_ln(RL(F), l, 1, MR);
        xcd_barrier(xb);
        run_gemm(F, AY, WSP(bf16, WS_WM1), MR, FF, DM, pg8::EpiStore<1>{ZH, FF});
        if (l == 0) {
            const int rem = ((MR / 256) * (FF / 256)) % F.G, first = rem;
            if ((int)blockIdx.x >= first) { __syncthreads(); const Fr Fw = RL(F); phase_wconv(Fw, 1, 0, ((int)blockIdx.x - first) * 8 + Fw.wave, (F.G - first) * 8); }
        }
        xcd_barrier(xb);
        run_gemm(F, ZH, WSP(bf16, WS_WM2), NLAT, DM, FF, pg8::EpiResid{X, X, X, ADA + (size_t)l * 5 * ADAW + 5 * 2048, 1.f});
        if (l == 0) {
            run_gemm_splitk(F, ZH + (size_t)NLAT * FF, FF, WSP(bf16, WS_WM2), FF, NCTX, DM, FF / 2, 2, pg8::EpiCtxSplit{X + (size_t)NLAT * DM, WSP(float, WS_PART), ADA + 4 * ADAW + 5 * 2048});
        }
        xcd_barrier(xb);
        phase_ln(RL(F), l, 2, MR);
        if (l == 0) xcd_barrier(xb);
    }
}
#undef ADA
#undef AY
#undef X
#undef ZH

extern "C" void kernel_launch(void* const* d_in, const int* in_sizes, int n_in, void* d_out, int out_size, void* d_ws, size_t ws_size, hipStream_t stream) {
    static int grid = 0;
    if (grid == 0) {
        int dev = 0, cus = 0, per_cu = 0;
        if (n_in != 26 || ws_size < WS_END) { fprintf(stderr, "kernel_launch: unexpected n_in %d / ws %zu (need %zu)\n", n_in, ws_size, (size_t)WS_END); grid = -1; return; }
        (void)hipGetDevice(&dev); (void)hipDeviceGetAttribute(&cus, hipDeviceAttributeMultiprocessorCount, dev);
        if (hipFuncSetAttribute((const void*)mk_fwd, hipFuncAttributeMaxDynamicSharedMemorySize, LDS_BYTES) != hipSuccess) { fprintf(stderr, "kernel_launch: hipFuncSetAttribute failed\n"); grid = -1; return; }
        if (hipOccupancyMaxActiveBlocksPerMultiprocessor(&per_cu, (const void*)mk_fwd, 512, LDS_BYTES) != hipSuccess || per_cu < 1) per_cu = 1;
        (void)hipGetLastError();
        grid = cus * 1;
        fprintf(stderr, "kernel_launch: grid %d (cus %d, occupancy query %d), ws %zu\n", grid, cus, per_cu, ws_size);
    }
    if (grid < 0) return;
    Args a{};
    for (int i = 0; i < 26; ++i) a.in[i] = (const float*)d_in[i];
    a.out = (float*)d_out; a.ws = (unsigned char*)d_ws;
    void* kargs[] = {&a};
    const hipError_t e = hipLaunchCooperativeKernel((const void*)mk_fwd, dim3(grid), dim3(512), kargs, LDS_BYTES, stream);
    if (e != hipSuccess) fprintf(stderr, "kernel_launch: cooperative launch failed: %s (grid %d)\n", hipGetErrorString(e), grid);
}
```

```cpp
#include <hip/hip_runtime.h>
#include <hip/hip_cooperative_groups.h>
#include <cstdio>
#include <cstdint>
namespace cg = cooperative_groups;
#define LAS __attribute__((address_space(3)))
typedef unsigned short bf16;
typedef unsigned v4u __attribute__((ext_vector_type(4)));
typedef unsigned v2u __attribute__((ext_vector_type(2)));
typedef float f32x4 __attribute__((ext_vector_type(4)));
typedef float f32x2 __attribute__((ext_vector_type(2)));
typedef short bf16x8 __attribute__((ext_vector_type(8)));

constexpr int DM = 2048, NBATCH = 4, SEQ = 4096, CTX = 256, NLAT = NBATCH * SEQ, NCTX = NBATCH * CTX, RT = NLAT + NCTX;
constexpr int ZC = 6864, ZP = 6912;
constexpr int C_GDN = 0, C_NA = 2064, C_MLA = 3600, C_HG = 4304;
constexpr int FF = 8192, ADAW = 12288;
constexpr float LOG2E = 1.4426950408889634f;
constexpr float ALPHA_RES = 1.4142135623730951f;

constexpr size_t MiB = 1u << 20;
constexpr size_t WS_ADA = 1 * MiB;
constexpr size_t WS_WIN = 2 * MiB, WS_WOUT = 29 * MiB, WS_WM1 = 37 * MiB, WS_WM2 = 69 * MiB, WS_WUQ = 101 * MiB, WS_WUK = 102 * MiB, WS_WUV = 102 * MiB + 512 * 1024;
constexpr size_t WS_AY = 104 * MiB;
constexpr size_t WS_X = 172 * MiB;
constexpr size_t WS_ZH = 308 * MiB;
constexpr size_t WS_GQKV = 580 * MiB;
constexpr size_t WS_QN = 631 * MiB, WS_CKVN = 644 * MiB, WS_MQ = 653 * MiB, WS_MK = 679 * MiB, WS_MVT = 696 * MiB, WS_NAVT = 713 * MiB, WS_KROPE = 730 * MiB, WS_GB = 733 * MiB;
constexpr size_t WS_ROPE = 735 * MiB;
constexpr size_t WS_HSC = 736 * MiB;
constexpr size_t WS_GSCAL = 753 * MiB;
constexpr size_t WS_HDL = 755 * MiB;
constexpr size_t WS_HQD = 538 * MiB;
constexpr size_t WS_HKE2 = 572 * MiB;
constexpr size_t WS_PO = WS_QN, WS_PML = 643 * MiB;
constexpr size_t WS_PART = 757 * MiB;
constexpr size_t WS_END = 765 * MiB;
static_assert(WS_PO + (size_t)192 * 256 * 128 * 2 <= WS_PML && WS_PML + (size_t)192 * 256 * 2 * 4 <= WS_CKVN, "split-KV partials");
static_assert(WS_ZH + (size_t)RT * ZP * 2 <= WS_HQD && WS_HQD + (size_t)2176 * 16384 <= WS_HKE2 && WS_HKE2 + (size_t)512 * 16384 <= WS_GQKV, "hgrn pre-pass buffers in the z/h tail");
static_assert(WS_WIN + (size_t)ZP * DM * 2 <= WS_WOUT && WS_WM2 + (size_t)DM * FF * 2 <= WS_WUQ && WS_WUQ + 768 * 384 * 2 <= WS_WUK, "weights map");
static_assert(WS_AY + (size_t)RT * DM * 2 <= WS_X && WS_X + (size_t)RT * DM * 4 <= WS_ZH && WS_ZH + (size_t)RT * FF * 2 <= WS_GQKV, "act map");
static_assert(WS_GQKV + (size_t)RT * 1536 * 2 <= WS_QN && WS_QN + (size_t)RT * 384 * 2 <= WS_CKVN && WS_CKVN + (size_t)RT * 256 * 2 <= WS_MQ && WS_MQ + (size_t)RT * 768 * 2 <= WS_MK, "mixer map");
static_assert(WS_MK + (size_t)RT * 512 * 2 <= WS_MVT && WS_MVT + (size_t)RT * 512 * 2 <= WS_NAVT && WS_NAVT + (size_t)RT * 512 * 2 <= WS_KROPE && WS_KROPE + (size_t)RT * 64 * 2 <= WS_GB && WS_GB + (size_t)RT * 16 * 4 <= WS_END, "mixer map 2");
constexpr size_t OUT_OG = 0, OUT_OH = 34 * MiB, OUT_GT = 68 * MiB, OUT_HKE = 102 * MiB;
static_assert(OUT_OH + (size_t)2 * RT * 512 * 2 <= OUT_GT && OUT_GT + (size_t)2176 * 2 * 8192 <= OUT_HKE && OUT_HKE + (size_t)1664 * 16384 <= (size_t)NLAT * DM * 4, "d_out scratch");

constexpr int LDS_BYTES = 147456;

__device__ __forceinline__ float bf2f(unsigned short u) { return __builtin_bit_cast(float, (unsigned)u << 16); }
__device__ __forceinline__ float bflo(unsigned w) { return __builtin_bit_cast(float, w << 16); }
__device__ __forceinline__ float bfhi(unsigned w) { return __builtin_bit_cast(float, w & 0xffff0000u); }
__device__ __forceinline__ unsigned f2bf(float f) { unsigned u = __builtin_bit_cast(unsigned, f); return (u + 0x7fffu + ((u >> 16) & 1u)) >> 16; }
__device__ __forceinline__ unsigned pk2(float lo, float hi) { return f2bf(lo) | (f2bf(hi) << 16); }
__device__ __forceinline__ float wave_sum(float v) {
#pragma unroll
    for (int o = 1; o < 64; o <<= 1) v += __shfl_xor(v, o);
    return v;
}
__device__ __forceinline__ float sigmoidf_(float x) { return __builtin_amdgcn_rcpf(1.f + __expf(-x)); }
__device__ __forceinline__ float siluf_(float x) { return x * __builtin_amdgcn_rcpf(1.f + __expf(-x)); }
#define LDS_WAIT() asm volatile("s_waitcnt vmcnt(0) lgkmcnt(0)" ::: "memory")
#define LDS_BARRIER() do { asm volatile("s_waitcnt lgkmcnt(0)" ::: "memory"); __builtin_amdgcn_s_barrier(); asm volatile("" ::: "memory"); } while (0)

namespace pg8 {
#define PG8_LAS __attribute__((address_space(3)))
typedef unsigned short bf16_t;
typedef short bf16x8 __attribute__((ext_vector_type(8)));
typedef float f32x4 __attribute__((ext_vector_type(4)));
typedef unsigned u32x4 __attribute__((ext_vector_type(4)));
constexpr int BM = 256, BK = 64, HALF = 128, HTB = HALF * BK * 2  , STAGE_BYTES = 8 * HTB, NXCD = 8, WGM = 8;

__host__ __device__ __forceinline__ int lds_byte(int r, int c) { const int st = (r >> 4) * 2 + (c >> 5), rr = r & 15, cc = c & 31, ob = rr * 64 + cc * 2; return st * 1024 + (ob ^ (((ob >> 9) & 1) << 5)); }
__host__ __device__ __forceinline__ void stage_rc(int b, int& R, int& C) { const int st = b / 1024, sb = b % 1024, swz = sb ^ (((sb >> 9) & 1) << 5); R = (st >> 1) * 16 + swz / 64; C = (st & 1) * 32 + (swz % 64) / 2; }
__host__ __device__ __forceinline__ int perm32(int rho) { const int n = rho >> 4, i = rho & 15; return 8 * (i >> 2) + 4 * n + (i & 3); }

struct Unit { int pm, pn, ks; };
struct Gemm { const bf16_t* A; const bf16_t* Bt; int M, N, K, lda, ldb; };

struct StaticOrder {
    int nM, nN, nwg, G, c;
    __host__ __device__ void init(int M, int N, int G_, int c_) { nM = M / BM; nN = N / BM; nwg = nM * nN; G = G_; c = c_; }
    __host__ __device__ bool next(int i, Unit& u) const {
        const long L = (long)i * G + c; if (L >= nwg) return false;
        int wgid = (int)L; { const int q = nwg / NXCD, r = nwg % NXCD, xcd = wgid % NXCD, off = wgid / NXCD; wgid = (xcd < r ? xcd * (q + 1) : r * (q + 1) + (xcd - r) * q) + off; }
        const int nig = WGM * nN, gid = wgid / nig, fm = gid * WGM, gsz = (nM - fm) < WGM ? (nM - fm) : WGM;
        u.pm = fm + ((wgid % nig) % gsz); u.pn = (wgid % nig) / gsz; u.ks = 0; return true;
    }
    __device__ __forceinline__ void a_ready(const Unit&) const {}
    __device__ __forceinline__ void done(const Unit&) const {}
};

struct SplitKOrder {
    int nM, nN, KS, nwg, G, c;
    __host__ __device__ void init(int M, int N, int KS_, int G_, int c_) { nM = M / BM; nN = N / BM; KS = KS_; nwg = nM * nN * KS; G = G_; c = c_; }
    __host__ __device__ bool next(int i, Unit& u) const {
        const long L = (long)i * G + c; if (L >= nwg) return false;
        const int t = (int)L; u.ks = t % KS; const int r = t / KS; u.pm = r % nM; u.pn = r / nM; return true;
    }
    __device__ __forceinline__ void a_ready(const Unit&) const {}
    __device__ __forceinline__ void done(const Unit&) const {}
};

template <class Epi, class Sched, bool ALIGN_EPI = false, bool SP2 = false>
__device__ __forceinline__ void gemm_phase(PG8_LAS unsigned char* lds, const Gemm g, const Sched& S, const Epi& E) {
    int tid_ = threadIdx.x; asm volatile("" : "+v"(tid_));
    const int tid = tid_, wid = __builtin_amdgcn_readfirstlane(tid >> 6), lane = tid & 63, wr = wid >> 2, wc = wid & 3, fr = lane & 15, fq = lane >> 4;
    const int K = g.K, nt = K / BK;
    unsigned voffA[2], voffB[2];
#pragma unroll
    for (int i = 0; i < 2; ++i) { int R, C; stage_rc(tid * 16 + i * 8192, R, C); const int Rb = Epi::PERM ? ((R & ~31) + perm32(R & 31)) : R;
        voffA[i] = (unsigned)(R * g.lda + C) * 2u; voffB[i] = (unsigned)(Rb * g.ldb + C) * 2u; }
    const size_t kstep = (size_t)(BK * 2);
    const size_t hstepA = (size_t)HALF * g.lda * 2, hstepB = (size_t)HALF * g.ldb * 2;
    const size_t tstepA = 2 * hstepA, tstepB = 2 * hstepB, sstep = (size_t)K * 2;
    const unsigned ldsw = (unsigned)wid * 1024u;
    const int aoff = lds_byte(wr * 64 + fr, fq * 8), boff = lds_byte(wc * 32 + fr, fq * 8);
#define PG8_SA(b, h) (((b) * 2 + (h)) * HTB)
#define PG8_SB(b, h) ((4 + (b) * 2 + (h)) * HTB)
#define PG8_STAGE(bufoff, gbase, voff) do { _Pragma("unroll") for (int _i = 0; _i < 2; ++_i) \
        __builtin_amdgcn_global_load_lds((const unsigned*)((const char*)(gbase) + (voff)[_i]), (PG8_LAS unsigned*)(lds + (bufoff) + ldsw + _i * 8192), 16, 0, 0); } while (0)
#define PG8_LDA(dst, b, h) do { _Pragma("unroll") for (int m = 0; m < 4; ++m) _Pragma("unroll") for (int k = 0; k < 2; ++k) dst[m][k] = *(const PG8_LAS bf16x8*)(lds + PG8_SA(b, h) + aoff + m * 2048 + k * 1024); } while (0)
#define PG8_LDB(dst, b, h) do { _Pragma("unroll") for (int n = 0; n < 2; ++n) _Pragma("unroll") for (int k = 0; k < 2; ++k) dst[n][k] = *(const PG8_LAS bf16x8*)(lds + PG8_SB(b, h) + boff + n * 2048 + k * 1024); } while (0)
#define PG8_MMA(ai, bj, At, Bt) do { __builtin_amdgcn_s_setprio(1); _Pragma("unroll") for (int m = 0; m < 4; ++m) _Pragma("unroll") for (int n = 0; n < 2; ++n) _Pragma("unroll") for (int k = 0; k < 2; ++k) \
        acc[ai][bj][m][n] = __builtin_amdgcn_mfma_f32_16x16x32_bf16(Bt[n][k], At[m][k], acc[ai][bj][m][n], 0, 0, 0); __builtin_amdgcn_s_setprio(0); } while (0)
#define PG8_WAIT_V(n) asm volatile("s_waitcnt vmcnt(" #n ")" ::: "memory")
#define PG8_WAIT_L(n) asm volatile("s_waitcnt lgkmcnt(" #n ")" ::: "memory")
#define PG8_BAR __builtin_amdgcn_s_barrier()
#define PG8_SCHED __builtin_amdgcn_sched_barrier(0)
    Unit cur, nxt; int ui = 0;
    if (!S.next(0, cur)) return;
    f32x4 acc[2][2][4][2];
#pragma unroll
    for (int a = 0; a < 2; ++a)
#pragma unroll
        for (int b = 0; b < 2; ++b)
#pragma unroll
            for (int m = 0; m < 4; ++m)
#pragma unroll
                for (int n = 0; n < 2; ++n) acc[a][b][m][n] = (f32x4){0.f, 0.f, 0.f, 0.f};
    bf16x8 At[4][2], B0[2][2], B1[2][2];
    const char* cA = (const char*)g.A + (size_t)cur.pm * tstepA + (size_t)cur.ks * sstep; const char* cB = (const char*)g.Bt + (size_t)cur.pn * tstepB + (size_t)cur.ks * sstep;
    S.a_ready(cur);
    if constexpr (SP2) {
        PG8_STAGE(PG8_SB(0, 0), cB, voffB); PG8_STAGE(PG8_SB(0, 1), cB + hstepB, voffB); PG8_STAGE(PG8_SA(0, 0), cA, voffA); PG8_STAGE(PG8_SA(0, 1), cA + hstepA, voffA);
        if (wr == 1) PG8_BAR;
        PG8_WAIT_V(2); PG8_BAR;
        PG8_STAGE(PG8_SB(1, 0), cB + kstep, voffB); PG8_STAGE(PG8_SA(1, 0), cA + kstep, voffA); PG8_STAGE(PG8_SB(1, 1), cB + hstepB + kstep, voffB);
        PG8_WAIT_V(6); PG8_BAR;
    } else {
        PG8_STAGE(PG8_SB(0, 0), cB, voffB); PG8_STAGE(PG8_SA(0, 0), cA, voffA); PG8_STAGE(PG8_SB(0, 1), cB + hstepB, voffB); PG8_STAGE(PG8_SA(0, 1), cA + hstepA, voffA);
        if (wr == 1) PG8_BAR;
        PG8_WAIT_V(4); PG8_BAR;
        PG8_STAGE(PG8_SB(1, 0), cB + kstep, voffB); PG8_STAGE(PG8_SA(1, 0), cA + kstep, voffA); PG8_STAGE(PG8_SB(1, 1), cB + hstepB + kstep, voffB);
        PG8_WAIT_V(6); PG8_BAR;
    }
    for (;;) {
        const bool has_next = S.next(ui + 1, nxt);
        const char* nA = has_next ? (const char*)g.A + (size_t)nxt.pm * tstepA + (size_t)nxt.ks * sstep : cA; const char* nB = has_next ? (const char*)g.Bt + (size_t)nxt.pn * tstepB + (size_t)nxt.ks * sstep : cB;
        for (int t = 0; t < nt; t += 2) {
            const bool last = (t == nt - 2);
            const char* a1 = cA + (size_t)(t + 1) * kstep;
            const char* a2 = last ? nA : cA + (size_t)(t + 2) * kstep; const char* b2 = last ? nB : cB + (size_t)(t + 2) * kstep;
            const char* a3 = a2 + kstep; const char* b3 = b2 + kstep;
            if (last && has_next) S.a_ready(nxt);
            if constexpr (SP2) {
            PG8_LDB(B0, 0, 0); PG8_LDB(B1, 0, 1); PG8_SCHED; PG8_LDA(At, 0, 0); PG8_STAGE(PG8_SA(1, 1), a1 + hstepA, voffA);
            PG8_WAIT_V(8); PG8_WAIT_L(0); PG8_BAR; PG8_MMA(0, 0, At, B0); PG8_MMA(0, 1, At, B1); PG8_BAR; PG8_SCHED;
            PG8_LDA(At, 0, 1); PG8_STAGE(PG8_SB(0, 0), b2, voffB); PG8_STAGE(PG8_SB(0, 1), b2 + hstepB, voffB); PG8_STAGE(PG8_SA(0, 0), a2, voffA);
            PG8_WAIT_V(8); PG8_WAIT_L(0); PG8_BAR; PG8_MMA(1, 0, At, B0); PG8_MMA(1, 1, At, B1); PG8_BAR; PG8_SCHED;
            PG8_LDB(B0, 1, 0); PG8_LDB(B1, 1, 1); PG8_SCHED; PG8_LDA(At, 1, 0); PG8_STAGE(PG8_SA(0, 1), a2 + hstepA, voffA);
            PG8_WAIT_V(8); PG8_WAIT_L(0); PG8_BAR; PG8_MMA(0, 0, At, B0); PG8_MMA(0, 1, At, B1); PG8_BAR; PG8_SCHED;
            PG8_LDA(At, 1, 1); PG8_STAGE(PG8_SB(1, 0), b3, voffB); PG8_STAGE(PG8_SB(1, 1), b3 + hstepB, voffB); PG8_STAGE(PG8_SA(1, 0), a3, voffA);
            PG8_WAIT_V(8); PG8_WAIT_L(0); PG8_BAR; PG8_MMA(1, 0, At, B0); PG8_MMA(1, 1, At, B1); PG8_BAR; PG8_SCHED;
            } else {
            PG8_LDB(B0, 0, 0); PG8_SCHED; PG8_LDA(At, 0, 0); PG8_STAGE(PG8_SA(1, 1), a1 + hstepA, voffA);
            PG8_WAIT_L(8); PG8_BAR; PG8_WAIT_L(0); PG8_MMA(0, 0, At, B0); PG8_BAR; PG8_SCHED;
            PG8_LDB(B1, 0, 1); PG8_STAGE(PG8_SB(0, 0), b2, voffB);
            PG8_BAR; PG8_WAIT_L(0); PG8_MMA(0, 1, At, B1); PG8_BAR;
            PG8_LDA(At, 0, 1); PG8_STAGE(PG8_SA(0, 0), a2, voffA);
            PG8_BAR; PG8_WAIT_L(0); PG8_MMA(1, 0, At, B0); PG8_BAR; PG8_SCHED;
            PG8_STAGE(PG8_SB(0, 1), b2 + hstepB, voffB);
            PG8_WAIT_V(6); PG8_BAR; PG8_MMA(1, 1, At, B1); PG8_BAR;
            PG8_LDB(B0, 1, 0); PG8_SCHED; PG8_LDA(At, 1, 0); PG8_STAGE(PG8_SA(0, 1), a2 + hstepA, voffA);
            PG8_WAIT_L(8); PG8_BAR; PG8_WAIT_L(0); PG8_MMA(0, 0, At, B0); PG8_BAR; PG8_SCHED;
            PG8_LDB(B1, 1, 1); PG8_STAGE(PG8_SB(1, 0), b3, voffB);
            PG8_BAR; PG8_WAIT_L(0); PG8_MMA(0, 1, At, B1); PG8_BAR;
            PG8_LDA(At, 1, 1); PG8_STAGE(PG8_SA(1, 0), a3, voffA);
            PG8_BAR; PG8_WAIT_L(0); PG8_MMA(1, 0, At, B0); PG8_BAR; PG8_SCHED;
            PG8_STAGE(PG8_SB(1, 1), b3 + hstepB, voffB);
            PG8_WAIT_V(6); PG8_BAR; PG8_MMA(1, 1, At, B1); PG8_BAR;
            }
        }
        if constexpr (ALIGN_EPI) { if (wr == 0) PG8_BAR; }
        if constexpr (!Epi::AFTER_DRAIN) { E(acc, cur, wr, wc, fr, fq); S.done(cur); }
        if (!has_next) break;
#pragma unroll
        for (int a = 0; a < 2; ++a)
#pragma unroll
            for (int b = 0; b < 2; ++b)
#pragma unroll
                for (int m = 0; m < 4; ++m)
#pragma unroll
                    for (int n = 0; n < 2; ++n) acc[a][b][m][n] = (f32x4){0.f, 0.f, 0.f, 0.f};
        cur = nxt; cA = nA; cB = nB; ++ui;
        if constexpr (ALIGN_EPI) { if (wr == 1) PG8_BAR; }
    }
    PG8_WAIT_V(0);
    if constexpr (!ALIGN_EPI) { if (wr == 0) PG8_BAR; }
    PG8_BAR;
    if constexpr (Epi::AFTER_DRAIN) { E.fused(acc, cur, wr, wc, fr, fq, lds, wid, lane); S.done(cur); }
#undef PG8_SA
#undef PG8_SB
#undef PG8_STAGE
#undef PG8_LDA
#undef PG8_LDB
#undef PG8_MMA
#undef PG8_WAIT_V
#undef PG8_WAIT_L
#undef PG8_BAR
#undef PG8_SCHED
}
}

namespace pg8 {
__device__ __forceinline__ unsigned cvt_pk_bf16(float lo, float hi) { unsigned r; asm volatile("v_cvt_pk_bf16_f32 %0, %1, %2" : "=v"(r) : "v"(lo), "v"(hi)); return r; }
template <int ACT> struct EpiStore {
    static constexpr bool PERM = true, AFTER_DRAIN = false;
    bf16_t* O; int ldc;
    __device__ __forceinline__ void operator()(const f32x4 (&acc)[2][2][4][2], const Unit& u, int wr, int wc, int fr, int fq) const {
        const int row0 = u.pm * BM + wr * 64 + fr, col0 = u.pn * BM + wc * 32 + 8 * fq;
#pragma unroll
        for (int ai = 0; ai < 2; ++ai)
#pragma unroll
            for (int m = 0; m < 4; ++m) { bf16_t* rowp = O + (size_t)(row0 + ai * HALF + m * 16) * ldc + col0;
#pragma unroll
                for (int bj = 0; bj < 2; ++bj) { f32x4 v0 = acc[ai][bj][m][0], v1 = acc[ai][bj][m][1];
                    if (ACT == 1) {
#pragma unroll
                        for (int j = 0; j < 4; ++j) { float a = fmaxf(v0[j], 0.f), b = fmaxf(v1[j], 0.f); v0[j] = a * a; v1[j] = b * b; } }
                    u32x4 w; w.x = cvt_pk_bf16(v0[0], v0[1]); w.y = cvt_pk_bf16(v0[2], v0[3]); w.z = cvt_pk_bf16(v1[0], v1[1]); w.w = cvt_pk_bf16(v1[2], v1[3]);
                    *(u32x4*)(rowp + bj * HALF) = w; } }
    }
};
struct EpiResid {
    static constexpr bool PERM = false, AFTER_DRAIN = false;
    const float* xlat; const float* xctx; float* out; const float* gbase; float alpha;
    __device__ __forceinline__ void operator()(const f32x4 (&acc)[2][2][4][2], const Unit& u, int wr, int wc, int fr, int fq) const {
#pragma unroll
        for (int ai = 0; ai < 2; ++ai)
#pragma unroll
            for (int m = 0; m < 4; ++m) {
                const int row = u.pm * BM + ai * HALF + wr * 64 + m * 16 + fr;
                const int v = row < NLAT ? (row >> 12) : 4;
                const float* xin = row < NLAT ? xlat + (size_t)row * DM : xctx + (size_t)(row - NLAT) * DM;
                const float* g = gbase + (size_t)v * ADAW;
                float* op = out + (size_t)row * DM;
#pragma unroll
                for (int bj = 0; bj < 2; ++bj)
#pragma unroll
                    for (int n = 0; n < 2; ++n) { const int col = u.pn * BM + bj * HALF + wc * 32 + n * 16 + fq * 4;
                        const f32x4 x4 = *(const f32x4*)(xin + col), g4 = *(const f32x4*)(g + col);
                        *(f32x4*)(op + col) = x4 * alpha + g4 * acc[ai][bj][m][n]; }
            }
    }
};
struct EpiCtxSplit {
    static constexpr bool PERM = false, AFTER_DRAIN = false;
    float* out; float* part; const float* g;
    __device__ __forceinline__ void operator()(const f32x4 (&acc)[2][2][4][2], const Unit& u, int wr, int wc, int fr, int fq) const {
#pragma unroll
        for (int ai = 0; ai < 2; ++ai)
#pragma unroll
            for (int m = 0; m < 4; ++m) {
                const size_t ro = (size_t)(u.pm * BM + ai * HALF + wr * 64 + m * 16 + fr) * DM;
#pragma unroll
                for (int bj = 0; bj < 2; ++bj)
#pragma unroll
                    for (int n = 0; n < 2; ++n) { const int col = u.pn * BM + bj * HALF + wc * 32 + n * 16 + fq * 4; const f32x4 v = *(const f32x4*)(g + col) * acc[ai][bj][m][n];
                        if (u.ks == 0) *(f32x4*)(out + ro + col) = *(const f32x4*)(out + ro + col) + v; else *(f32x4*)(part + ro + col) = v; }
            }
    }
};
}

struct Args { const float* in[26]; float* out; unsigned char* ws; };
typedef const float* cfp_t;
typedef const __attribute__((address_space(4))) cfp_t* kargp_t;
struct Fr {
    kargp_t kp; float* out; unsigned char* ws; unsigned char* lds;
    int tid, lane, wave, G, gw, NGW;
};
__device__ __forceinline__ const float* inp(const Fr& F, int k) { kargp_t p = F.kp; asm volatile("" : "+s"(p)); return p[k]; }
#define WSP(T, off) ((T*)(F.ws + (off)))
__device__ __forceinline__ Fr RL(const Fr& F0) { Fr F = F0; int t = threadIdx.x; asm volatile("" : "+v"(t)); F.tid = t; F.lane = t & 63; F.wave = __builtin_amdgcn_readfirstlane(t >> 6); F.gw = blockIdx.x * 8 + F.wave; return F; }

__device__ __forceinline__ void phase_ada(const Fr& F) {
    float* sl = (float*)F.lds;
    float* red = sl + 5 * 2048;
    float* ADA = WSP(float, WS_ADA);
    const float* p_c = inp(F, 1); const float* p_cc = inp(F, 3); const float* p_wada = inp(F, 4); const float* p_bada = inp(F, 5);
    for (int i = F.tid; i < 5 * 2048; i += 512) { const float c = (i < 4 * 2048) ? p_c[i] : p_cc[i - 4 * 2048]; sl[i] = siluf_(c); }
    __syncthreads();
    for (int it = blockIdx.x; it < 2 * 384; it += F.G) {
        const int l = it / 384, n0 = (it % 384) * 32, c4 = (F.tid & 7) * 4, ks = F.tid >> 3;
        const float* W = p_wada + (size_t)l * DM * ADAW + n0 + c4;
        f32x4 a0 = (f32x4){0.f, 0.f, 0.f, 0.f}, a1 = a0, a2 = a0, a3 = a0, a4 = a0;
        const int k0 = ks * 32;
#pragma unroll 16
        for (int k = 0; k < 32; ++k) { const f32x4 wv = *(const f32x4*)(W + (size_t)(k0 + k) * ADAW);
            a0 += wv * sl[k0 + k]; a1 += wv * sl[2048 + k0 + k]; a2 += wv * sl[4096 + k0 + k]; a3 += wv * sl[6144 + k0 + k]; a4 += wv * sl[8192 + k0 + k]; }
        *(f32x4*)(red + (ks * 5 + 0) * 32 + c4) = a0; *(f32x4*)(red + (ks * 5 + 1) * 32 + c4) = a1; *(f32x4*)(red + (ks * 5 + 2) * 32 + c4) = a2;
        *(f32x4*)(red + (ks * 5 + 3) * 32 + c4) = a3; *(f32x4*)(red + (ks * 5 + 4) * 32 + c4) = a4;
        __syncthreads();
        if (F.tid < 160) { const int v = F.tid >> 5, ln = F.tid & 31; float s = 0.f;
#pragma unroll 16
            for (int ww = 0; ww < 64; ++ww) s += red[(ww * 5 + v) * 32 + ln];
            ADA[((size_t)l * 5 + v) * ADAW + n0 + ln] = s + p_bada[(size_t)l * ADAW + n0 + ln]; }
        __syncthreads();
    }
    {
        f32x2* RP = WSP(f32x2, WS_ROPE);
        for (int e = blockIdx.x * 512 + F.tid; e < SEQ * 32; e += F.G * 512) { const int t = e >> 5, i = e & 31; const int pos = i < 16 ? (t >> 6) : (t & 63);
            const float freq = exp2f(-(float)(i & 15) * 0.8304820237218406f)  ; float sn, cs; sincosf((float)pos * freq, &sn, &cs); RP[e] = (f32x2){cs, sn}; }
    }
}

__device__ __forceinline__ void transpose_item(const float* W, int K, int N, int NP, bf16* WT, float* scr, int item, int lane) {
    const int nblk = NP / 32, kb = item / nblk, nb = item % nblk, k0 = 64 * kb, n0 = 32 * nb;
    const int l8 = lane & 7, kr = lane >> 3, nn = n0 + 4 * l8; const bool ok = nn < N;
    f32x4 wv[8];
#pragma unroll
    for (int i = 0; i < 8; ++i) { const int kk = 8 * i + kr; wv[i] = ok ? *(const f32x4*)(W + (size_t)(k0 + kk) * N + nn) : (f32x4){0.f, 0.f, 0.f, 0.f}; }
#pragma unroll
    for (int i = 0; i < 8; ++i) { const int kk = 8 * i + kr; float* d = scr + kk * 33 + 4 * l8; d[0] = wv[i][0]; d[1] = wv[i][1]; d[2] = wv[i][2]; d[3] = wv[i][3]; }
    LDS_WAIT();
    const int c = lane & 7;
#pragma unroll
    for (int j = 0; j < 4; ++j) { const int n = (lane >> 3) + 8 * j; const float* s = scr + (8 * c) * 33 + n;
        v4u o; o.x = pk2(s[0 * 33], s[1 * 33]); o.y = pk2(s[2 * 33], s[3 * 33]); o.z = pk2(s[4 * 33], s[5 * 33]); o.w = pk2(s[6 * 33], s[7 * 33]);
        *(v4u*)(WT + (size_t)(n0 + n) * K + k0 + 8 * c) = o; }
    LDS_WAIT();
}
__device__ __forceinline__ void phase_wconv(const Fr& F, int l, int mode, int w0, int nw) {
    float* scr = (float*)F.lds + F.wave * (64 * 33);
    constexpr int I_IN = 32 * 216, I_OUT = 32 * 64, I_M1 = 32 * 256, I_M2 = 128 * 64, I_UQ = 6 * 24, I_UK = 4 * 16, I_UV = 4 * 16;
    constexpr int NIT = I_IN + I_OUT + I_M1 + I_M2 + I_UQ + I_UK + I_UV;
    for (int q = w0; ; q += nw) {
        int it;
        if (mode == 0) { if (q >= I_IN + I_UQ + I_UK + I_UV) break; it = q < I_IN ? q : q + I_OUT + I_M1 + I_M2; }
        else { if (q >= I_OUT + I_M1 + I_M2) break; it = I_IN + q; }
        int r = it;
        if (r < I_IN) { transpose_item(inp(F, 6) + (size_t)l * DM * ZC, DM, ZC, ZP, WSP(bf16, WS_WIN), scr, r, F.lane); continue; } r -= I_IN;
        if (r < I_OUT) { transpose_item(inp(F, 19) + (size_t)l * DM * DM, DM, DM, DM, WSP(bf16, WS_WOUT), scr, r, F.lane); continue; } r -= I_OUT;
        if (r < I_M1) { transpose_item(inp(F, 22) + (size_t)l * DM * FF, DM, FF, FF, WSP(bf16, WS_WM1), scr, r, F.lane); continue; } r -= I_M1;
        if (r < I_M2) { transpose_item(inp(F, 23) + (size_t)l * FF * DM, FF, DM, DM, WSP(bf16, WS_WM2), scr, r, F.lane); continue; } r -= I_M2;
        if (r < I_UQ) { transpose_item(inp(F, 14) + (size_t)l * 384 * 768, 384, 768, 768, WSP(bf16, WS_WUQ), scr, r, F.lane); continue; } r -= I_UQ;
        if (r < I_UK) { transpose_item(inp(F, 15) + (size_t)l * 256 * 512, 256, 512, 512, WSP(bf16, WS_WUK), scr, r, F.lane); continue; } r -= I_UK;
        transpose_item(inp(F, 16) + (size_t)l * 256 * 512, 256, 512, 512, WSP(bf16, WS_WUV), scr, r, F.lane);
    }
}

__device__ __forceinline__ void phase_mod0(const Fr& F) {
    const float* ADA = WSP(float, WS_ADA); bf16* AY = WSP(bf16, WS_AY);
    const float* p_x = inp(F, 0); const float* p_ctx = inp(F, 2);
    f32x4 xv[8], xn[8], m1[8], m0[8]; int cur_v = -1;
    if (F.gw < RT) { const float* xr = F.gw < NLAT ? p_x + (size_t)F.gw * DM : p_ctx + (size_t)(F.gw - NLAT) * DM;
#pragma unroll
        for (int j = 0; j < 8; ++j) xv[j] = *(const f32x4*)(xr + j * 256 + F.lane * 4); }
    for (int row = F.gw; row < RT; row += F.NGW) {
        { const int rn = row + F.NGW; if (rn < RT) { const float* xr = rn < NLAT ? p_x + (size_t)rn * DM : p_ctx + (size_t)(rn - NLAT) * DM;
#pragma unroll
            for (int j = 0; j < 8; ++j) xn[j] = *(const f32x4*)(xr + j * 256 + F.lane * 4); } }
        const int v = row < NLAT ? (row >> 12) : 4;
        if (v != cur_v) { cur_v = v; const float* sh = ADA + (size_t)v * ADAW; const float* sc = sh + 2048;
#pragma unroll
            for (int j = 0; j < 8; ++j) { m1[j] = *(const f32x4*)(sc + j * 256 + F.lane * 4) + 1.f; m0[j] = *(const f32x4*)(sh + j * 256 + F.lane * 4); } }
#pragma unroll
        for (int j = 0; j < 8; ++j) { const int col = j * 256 + F.lane * 4;
            const f32x4 x = xv[j];
            const f32x4 y = x * m1[j] + m0[j];
            v2u o; o.x = pk2(y[0], y[1]); o.y = pk2(y[2], y[3]);
            *(v2u*)(AY + (size_t)row * DM + col) = o;
            if (row >= NLAT) *(f32x4*)(WSP(float, WS_X) + (size_t)row * DM + col) = x * ALPHA_RES; }
#pragma unroll
        for (int j = 0; j < 8; ++j) xv[j] = xn[j];
    }
}

__device__ __forceinline__ void phase_ln(const Fr& F, int l, int which, int nrows) {
    const float* ADA = WSP(float, WS_ADA); bf16* AY = WSP(bf16, WS_AY); float* X = WSP(float, WS_X);
    const float* lw = (which == 1 ? inp(F, 20) : inp(F, 24)) + (size_t)l * DM; const float* lb = (which == 1 ? inp(F, 21) : inp(F, 25)) + (size_t)l * DM;
    const bool last = (which == 2 && l == 1);
    const size_t aoff = which == 1 ? ((size_t)l * 5 * ADAW + 3 * 2048) : ((size_t)(l + 1) * 5 * ADAW);
    f32x4 scr[8], shr[8]; int cur_vi = -1;
    f32x4 v[8], vn[8], lwr[8], lbr[8];
#pragma unroll
    for (int j = 0; j < 8; ++j) { lwr[j] = *(const f32x4*)(lw + j * 256 + F.lane * 4); lbr[j] = *(const f32x4*)(lb + j * 256 + F.lane * 4); }
    if (F.gw < nrows) {
#pragma unroll
        for (int j = 0; j < 8; ++j) v[j] = *(const f32x4*)(X + (size_t)F.gw * DM + j * 256 + F.lane * 4); }
    for (int row = F.gw; row < nrows; row += F.NGW) {
        float* xr = X + (size_t)row * DM;
        if (row + F.NGW < nrows) {
#pragma unroll
            for (int j = 0; j < 8; ++j) vn[j] = *(const f32x4*)(xr + (size_t)F.NGW * DM + j * 256 + F.lane * 4); }
        float s = 0.f;
#pragma unroll
        for (int j = 0; j < 8; ++j) {
            if (which == 2 && l == 0 && row >= NLAT) v[j] = v[j] + *(const f32x4*)(WSP(float, WS_PART) + (size_t)(row - NLAT) * DM + j * 256 + F.lane * 4);
            s += (v[j][0] + v[j][1]) + (v[j][2] + v[j][3]); }
        const float mean = wave_sum(s) * (1.f / DM); float s2 = 0.f;
#pragma unroll
        for (int j = 0; j < 8; ++j) { v[j] = v[j] - mean; s2 += (v[j][0] * v[j][0] + v[j][1] * v[j][1]) + (v[j][2] * v[j][2] + v[j][3] * v[j][3]); }
        const float rstd = 1.f / sqrtf(wave_sum(s2) * (1.f / DM) + 1e-5f);
        const int vi = row < NLAT ? (row >> 12) : 4;
        if (!last && vi != cur_vi) {
            cur_vi = vi; const float* sh = ADA + aoff + (size_t)vi * ADAW; const float* sc = sh + 2048;
#pragma unroll
            for (int j = 0; j < 8; ++j) { scr[j] = *(const f32x4*)(sc + j * 256 + F.lane * 4) + 1.f; shr[j] = *(const f32x4*)(sh + j * 256 + F.lane * 4); } }
#pragma unroll
        for (int j = 0; j < 8; ++j) { const int col = j * 256 + F.lane * 4;
            const f32x4 y = v[j] * rstd * lwr[j] + lbr[j];
            if (last) { *(f32x4*)(F.out + (size_t)row * DM + col) = y; }
            else { *(f32x4*)(xr + col) = (which == 1) ? y * ALPHA_RES : y;
                const f32x4 a = y * scr[j] + shr[j];
                v2u o; o.x = pk2(a[0], a[1]); o.y = pk2(a[2], a[3]);
                *(v2u*)(AY + (size_t)row * DM + col) = o; }
        }
#pragma unroll
        for (int j = 0; j < 8; ++j) v[j] = vn[j];
    }
}

__device__ __forceinline__ void phase_prep(const Fr& F, int l) {
    const bf16* Z = WSP(bf16, WS_ZH); bf16* GQKV = WSP(bf16, WS_GQKV); float* GB = WSP(float, WS_GB);
    bf16* QN = WSP(bf16, WS_QN); bf16* CKVN = WSP(bf16, WS_CKVN); bf16* KROPE = WSP(bf16, WS_KROPE);
    const float* cw = inp(F, 7) + (size_t)l * 5 * 1536;
    const float* p_alog = inp(F, 8); const float* p_dtb = inp(F, 9); const float* p_qnw = inp(F, 12); const float* p_kvnw = inp(F, 13);
    f32x4 cwr[3][5][2];
#pragma unroll
    for (int g = 0; g < 3; ++g)
#pragma unroll
        for (int i = 0; i < 5; ++i) { cwr[g][i][0] = *(const f32x4*)(cw + i * 1536 + g * 512 + F.lane * 8); cwr[g][i][1] = *(const f32x4*)(cw + i * 1536 + g * 512 + F.lane * 8 + 4); }
    for (int row = F.gw; row < RT; row += F.NGW) {
        const bf16* zr = Z + (size_t)row * ZP;
#pragma unroll
      for (int g = 0; g < 4; ++g) {
        if (g < 3) {
            int t, len; if (row < NLAT) { t = row & 4095; len = SEQ; } else { t = (row - NLAT) & 255; len = CTX; }
            const int c0 = g * 512 + F.lane * 8;
            float acc[8];
#pragma unroll
            for (int j = 0; j < 8; ++j) acc[j] = 0.f;
#pragma unroll
            for (int i = 0; i < 5; ++i) { const int tt = t + i - 2; const bool okt = (tt >= 0 && tt < len);
                {
                    v4u zv = *(const v4u*)(zr + (okt ? (ptrdiff_t)(i - 2) * ZP : (ptrdiff_t)0) + c0); if (!okt) zv = (v4u){0u, 0u, 0u, 0u};
                    const f32x4 w0 = cwr[g][i][0], w1 = cwr[g][i][1];
                    acc[0] += bflo(zv.x) * w0[0]; acc[1] += bfhi(zv.x) * w0[1]; acc[2] += bflo(zv.y) * w0[2]; acc[3] += bfhi(zv.y) * w0[3];
                    acc[4] += bflo(zv.z) * w1[0]; acc[5] += bfhi(zv.z) * w1[1]; acc[6] += bflo(zv.w) * w1[2]; acc[7] += bfhi(zv.w) * w1[3]; } }
            float ss = 0.f;
#pragma unroll
            for (int j = 0; j < 8; ++j) { acc[j] = siluf_(acc[j]); ss += acc[j] * acc[j]; }
            if (g < 2) {
                ss += __shfl_xor(ss, 1); ss += __shfl_xor(ss, 2); ss += __shfl_xor(ss, 4); ss += __shfl_xor(ss, 8);
                float inv = 1.f / sqrtf(ss + 1e-6f); if (g == 0) inv *= 0.08838834764831845f;
#pragma unroll
                for (int j = 0; j < 8; ++j) acc[j] *= inv;
            }
            v4u o; o.x = pk2(acc[0], acc[1]); o.y = pk2(acc[2], acc[3]); o.z = pk2(acc[4], acc[5]); o.w = pk2(acc[6], acc[7]);
            *(v4u*)(GQKV + (size_t)row * 1536 + c0) = o;
            if (g == 0 && F.lane < 16) {
                float r;
                if (F.lane < 8) { const float a = bf2f(zr[2048 + F.lane]); const float x = a + p_dtb[l * 8 + F.lane];
                    const float ee = __expf(-fabsf(x)); const float l1p = (ee < 0.03f) ? ee * (1.f - ee * (0.5f - ee * 0.33333333f)) : __logf(1.f + ee); const float sp = fmaxf(x, 0.f) + l1p;     r = -__expf(p_alog[l * 8 + F.lane]) * sp; }
                else r = sigmoidf_(bf2f(zr[2056 + F.lane - 8]));
                GB[(size_t)row * 16 + F.lane] = r;
            }
        } else {
            {
                const unsigned* p = (const unsigned*)(zr + C_MLA + F.lane * 6); const unsigned w0 = p[0], w1 = p[1], w2 = p[2];
                float x[6] = {bflo(w0), bfhi(w0), bflo(w1), bfhi(w1), bflo(w2), bfhi(w2)};
                float ss = 0.f;
#pragma unroll
                for (int j = 0; j < 6; ++j) ss += x[j] * x[j];
                const float inv = 1.f / sqrtf(wave_sum(ss) * (1.f / 384.f) + 1e-6f);
                const float* nw = p_qnw + l * 384 + F.lane * 6;
                unsigned* q = (unsigned*)(QN + (size_t)row * 384 + F.lane * 6);
                q[0] = pk2(x[0] * inv * nw[0], x[1] * inv * nw[1]); q[1] = pk2(x[2] * inv * nw[2], x[3] * inv * nw[3]); q[2] = pk2(x[4] * inv * nw[4], x[5] * inv * nw[5]);
            }
            {
                const v2u w = *(const v2u*)(zr + C_MLA + 384 + F.lane * 4);
                float x[4] = {bflo(w.x), bfhi(w.x), bflo(w.y), bfhi(w.y)};
                const float ss = x[0] * x[0] + x[1] * x[1] + x[2] * x[2] + x[3] * x[3];
                const float inv = 1.f / sqrtf(wave_sum(ss) * (1.f / 256.f) + 1e-6f);
                const float* nw = p_kvnw + l * 256 + F.lane * 4;
                v2u o; o.x = pk2(x[0] * inv * nw[0], x[1] * inv * nw[1]); o.y = pk2(x[2] * inv * nw[2], x[3] * inv * nw[3]);
                *(v2u*)(CKVN + (size_t)row * 256 + F.lane * 4) = o;
            }
            {
                const float x = bf2f(zr[C_MLA + 640 + F.lane]);
                const float pr = __shfl_xor(x, 1);
                float o = x;
                if (row < NLAT) { const int t = row & 4095, i = F.lane >> 1; const f32x2 rc = WSP(const f32x2, WS_ROPE)[t * 32 + i]; const float cs = rc[0], sn = rc[1];
                    o = (F.lane & 1) ? (pr * sn + x * cs) : (x * cs - pr * sn); }
                KROPE[(size_t)row * 64 + F.lane] = (bf16)f2bf(o);
            }
        }
      }
    }
    { bf16* NAVT = WSP(bf16, WS_NAVT);
      for (int tile = F.gw; tile < (RT / 64) * 8; tile += F.NGW) {
        const int r0 = (tile >> 3) * 64, c0 = (tile & 7) * 64;
        const bf16* zr = Z + (size_t)(r0 + F.lane) * ZP + C_NA + 1024 + c0;
        v4u v[8];
#pragma unroll
        for (int j = 0; j < 8; ++j) v[j] = *(const v4u*)(zr + 8 * j);
        bf16* dst = NAVT + (size_t)c0 * RT + r0 + F.lane;
#pragma unroll
        for (int j = 0; j < 8; ++j) {
            dst[(size_t)(8 * j + 0) * RT] = (bf16)(v[j].x & 0xffffu); dst[(size_t)(8 * j + 1) * RT] = (bf16)(v[j].x >> 16);
            dst[(size_t)(8 * j + 2) * RT] = (bf16)(v[j].y & 0xffffu); dst[(size_t)(8 * j + 3) * RT] = (bf16)(v[j].y >> 16);
            dst[(size_t)(8 * j + 4) * RT] = (bf16)(v[j].z & 0xffffu); dst[(size_t)(8 * j + 5) * RT] = (bf16)(v[j].z >> 16);
            dst[(size_t)(8 * j + 6) * RT] = (bf16)(v[j].w & 0xffffu); dst[(size_t)(8 * j + 7) * RT] = (bf16)(v[j].w >> 16); }
      } }
}

__device__ __forceinline__ void phase_post(const Fr& F, int l, int nrows) {
    const bf16* Z = WSP(bf16, WS_ZH); bf16* Y = WSP(bf16, WS_AY);
    const bf16* OG = (const bf16*)((const unsigned char*)F.out + OUT_OG); const bf16* OH = (const bf16*)((const unsigned char*)F.out + OUT_OH);
    const float* p_gnw = inp(F, 10) + l * 128; const float* p_hnw = inp(F, 18) + l * 128;
    if (F.G - 64 == 192) {
        const bf16* PO = WSP(bf16, WS_PO); const float* PML = WSP(float, WS_PML);
        for (int it = F.gw; it < 64 * 256; it += F.NGW) { const int su = it >> 8, r = it & 255, u = 192 + su, hh = (u >> 4) & 3, qb = u & 15;
            float m[3], lv[3];
#pragma unroll
            for (int p = 0; p < 3; ++p) { m[p] = PML[((size_t)(su * 3 + p) * 256 + r) * 2]; lv[p] = PML[((size_t)(su * 3 + p) * 256 + r) * 2 + 1]; }
            const float M = fmaxf(m[0], fmaxf(m[1], m[2]));
            float L = 0.f, o0 = 0.f, o1 = 0.f;
#pragma unroll
            for (int p = 0; p < 3; ++p) { const float wp = __builtin_amdgcn_exp2f(m[p] - M); L += wp * lv[p];
                const unsigned pv = *(const unsigned*)(PO + ((size_t)(su * 3 + p) * 256 + r) * 128 + F.lane * 2); o0 += wp * bflo(pv); o1 += wp * bfhi(pv); }
            const float inv = 1.f / L;
            *(unsigned*)(Y + (size_t)(3 * SEQ + qb * 256 + r) * DM + 1024 + hh * 128 + F.lane * 2) = pk2(o0 * inv, o1 * inv); }
    }
    float nwr[2][8];
#pragma unroll
    for (int j = 0; j < 8; ++j) { nwr[0][j] = p_gnw[(F.lane & 15) * 8 + j]; nwr[1][j] = p_hnw[(F.lane & 15) * 8 + j]; }
    for (int row = F.gw; row < nrows; row += F.NGW) {
#pragma unroll
      for (int which = 0; which < 2; ++which) {
        const bf16* O = which ? OH : OG;
        const v4u a = *(const v4u*)(O + (size_t)row * 512 + F.lane * 8), b = *(const v4u*)(O + (size_t)(RT + row) * 512 + F.lane * 8);
        const v4u gz = *(const v4u*)(Z + (size_t)row * ZP + (which ? (C_HG + 4 * 512) : 1536) + F.lane * 8);
        float o[8] = {bflo(a.x) + bflo(b.x), bfhi(a.x) + bfhi(b.x), bflo(a.y) + bflo(b.y), bfhi(a.y) + bfhi(b.y), bflo(a.z) + bflo(b.z), bfhi(a.z) + bfhi(b.z), bflo(a.w) + bflo(b.w), bfhi(a.w) + bfhi(b.w)};
        const float gt[8] = {bflo(gz.x), bfhi(gz.x), bflo(gz.y), bfhi(gz.y), bflo(gz.z), bfhi(gz.z), bflo(gz.w), bfhi(gz.w)};
        float ss = 0.f;
#pragma unroll
        for (int j = 0; j < 8; ++j) ss += o[j] * o[j];
        ss += __shfl_xor(ss, 1); ss += __shfl_xor(ss, 2); ss += __shfl_xor(ss, 4); ss += __shfl_xor(ss, 8);
        const float inv = 1.f / sqrtf(ss * (1.f / 128.f) + 1e-6f);
#pragma unroll
        for (int j = 0; j < 8; ++j) o[j] = o[j] * inv * nwr[which][j] * siluf_(gt[j]);
        v4u w; w.x = pk2(o[0], o[1]); w.y = pk2(o[2], o[3]); w.z = pk2(o[4], o[5]); w.w = pk2(o[6], o[7]);
        *(v4u*)(Y + (size_t)row * DM + (which ? 1536 : 0) + F.lane * 8) = w;
      }
    }
}

constexpr int SC_PR = 0, SC_VS = 64 * 288 * 4, SC_SC = SC_VS + 64 * 64 * 4, SC_OB = SC_SC + 64 * 16, SC_END = SC_OB + 64 * 64 * 4;
static_assert(SC_END <= 131072, "scan LDS");
template <int CTRL> __device__ __forceinline__ float dppf(float v) { return __builtin_bit_cast(float, __builtin_amdgcn_update_dpp(0, __builtin_bit_cast(int, v), CTRL, 0xF, 0xF, true)); }
__device__ __forceinline__ float reduce8(float v) { v += dppf<0xB1>(v); v += dppf<0x4E>(v); v += dppf<0x141>(v); return v; }

template <bool GDN>
__device__ __forceinline__ void scan_item(const Fr& F, int l, int item) {
    const int chain = item >> 1, ch = item & 1, b = chain >> 3, h = (chain >> 1) & 3, dir = chain & 1;
    const int tid = F.tid, slice = tid & 7, cl = tid >> 3;
    float* PR = (float*)(F.lds + SC_PR); float* VS = (float*)(F.lds + SC_VS); f32x4* SC = (f32x4*)(F.lds + SC_SC); float* OB = (float*)(F.lds + SC_OB);
    const bf16* Z = WSP(bf16, WS_ZH); const bf16* GQKV = WSP(bf16, WS_GQKV); const float* GB = WSP(float, WS_GB);
    bf16* O = (bf16*)((unsigned char*)F.out + (GDN ? OUT_OG : OUT_OH)) + (size_t)dir * RT * 512 + h * 128 + ch * 64;
    const bf16* srcA; const bf16* srcB; const bf16* srcV; int pitch;
    if (GDN) { pitch = 1536; srcA = GQKV + 512 + h * 128; srcB = GQKV + h * 128; srcV = GQKV + 1024 + h * 128 + ch * 64; }
    else { pitch = ZP; srcA = Z + C_HG + 512 * (1 + dir) + h * 128; srcB = Z + C_HG + h * 128; srcV = Z + C_HG + 3 * 512 + h * 128 + ch * 64; }
    float lbv[2][8];
    if (!GDN) { const float* p_lb = inp(F, 17);
#pragma unroll
        for (int i = 0; i < 2; ++i) { const int d0 = ((tid + 512 * i) & 15) * 8;
#pragma unroll
            for (int j = 0; j < 8; ++j) lbv[i][j] = (l == 0) ? 0.f : sigmoidf_(p_lb[512 + h * 128 + d0 + j] - p_lb[h * 128 + d0 + j]); }
    }
    float S[16];
#pragma unroll
    for (int j = 0; j < 16; ++j) S[j] = 0.f;
    v4u ra[2], rb[2], rv; float rg = 0.f, rbeta = 0.f;
    constexpr int NCH = (CTX + SEQ) / 64;
    int base = 0, sgn = 1;
#define SCAN_ROWS(c) do { const int gs = (c) * 64; if (gs < CTX) { base = NLAT + b * CTX + (dir ? (CTX - 1 - gs) : gs); } else { const int t = gs - CTX; base = b * SEQ + (dir ? (SEQ - 1 - t) : t); } sgn = dir ? -1 : 1; } while (0)
#define SCAN_LOAD() do { _Pragma("unroll") for (int i = 0; i < 2; ++i) { const int p = tid + 512 * i, s = p >> 4, d0 = (p & 15) * 8; const size_t ro = (size_t)(base + sgn * s) * pitch + d0; \
        ra[i] = *(const v4u*)(srcA + ro); rb[i] = *(const v4u*)(srcB + ro); } \
        { const int s = tid >> 3, c0 = (tid & 7) * 8; rv = *(const v4u*)(srcV + (size_t)(base + sgn * s) * pitch + c0); } \
        if (GDN && tid < 64) { const size_t ro = (size_t)(base + sgn * tid) * 16 + dir * 4 + h; rg = GB[ro]; rbeta = GB[ro + 8]; } } while (0)
#define SCAN_STORE() do { _Pragma("unroll") for (int i = 0; i < 2; ++i) { const int p = tid + 512 * i, s = p >> 4, d0 = (p & 15) * 8; \
        float av[8] = {bflo(ra[i].x), bfhi(ra[i].x), bflo(ra[i].y), bfhi(ra[i].y), bflo(ra[i].z), bfhi(ra[i].z), bflo(ra[i].w), bfhi(ra[i].w)}; \
        float bv[8] = {bflo(rb[i].x), bfhi(rb[i].x), bflo(rb[i].y), bfhi(rb[i].y), bflo(rb[i].z), bfhi(rb[i].z), bflo(rb[i].w), bfhi(rb[i].w)}; \
        if (!GDN) { _Pragma("unroll") for (int j = 0; j < 8; ++j) { av[j] = lbv[i][j] + (1.f - lbv[i][j]) * sigmoidf_(av[j]); bv[j] = siluf_(bv[j]) * 0.08838834764831845f; } } \
        float* dst = PR + s * 288 + (d0 >> 4) * 36 + (d0 & 15) * 2; \
        _Pragma("unroll") for (int j = 0; j < 4; ++j) *(f32x4*)(dst + 4 * j) = (f32x4){av[2 * j], bv[2 * j], av[2 * j + 1], bv[2 * j + 1]}; } \
        { const int s = tid >> 3, c0 = (tid & 7) * 8; float* dv = VS + s * 64 + c0; \
          *(f32x4*)dv = (f32x4){bflo(rv.x), bfhi(rv.x), bflo(rv.y), bfhi(rv.y)}; *(f32x4*)(dv + 4) = (f32x4){bflo(rv.z), bfhi(rv.z), bflo(rv.w), bfhi(rv.w)}; } \
        if (GDN && tid < 64) { float* sc = (float*)(SC + tid); sc[0] = __expf(rg); sc[1] = rbeta; } } while (0)
#define SCAN_QK() do { if (GDN) { _Pragma("unroll") for (int e = 0; e < 8; ++e) { const int s = F.wave * 8 + e; const f32x4 kq = *(const f32x4*)(PR + s * 288 + (F.lane >> 3) * 36 + (F.lane & 7) * 4); \
        const float d = wave_sum(kq[0] * kq[1] + kq[2] * kq[3]); if (F.lane == 0) ((float*)(SC + s))[2] = d; } } } while (0)

    SCAN_ROWS(0); SCAN_LOAD(); SCAN_STORE(); __syncthreads(); SCAN_QK(); __syncthreads();
    const float* prs = PR + slice * 36;
    for (int c = 0; c < NCH; ++c) {
        const int obase = base, osgn = sgn;
        if (c + 1 < NCH) { SCAN_ROWS(c + 1); SCAN_LOAD(); }
        f32x4 cur[8];
#pragma unroll
        for (int i = 0; i < 8; ++i) cur[i] = *(const f32x4*)(prs + i * 4);
        f32x4 scv = SC[0]; float vv = VS[cl];
#pragma unroll 2
        for (int s = 0; s < 64; ++s) {
            f32x4 nxt[8]; f32x4 nsc; float nvv;
            const int sn = (s + 1) & 63;
#pragma unroll
            for (int i = 0; i < 8; ++i) nxt[i] = *(const f32x4*)(prs + sn * 288 + i * 4);
            nsc = SC[sn]; nvv = VS[sn * 64 + cl];
            float o;
            if (GDN) {
                float pk = 0.f, pq = 0.f;
#pragma unroll
                for (int i = 0; i < 8; ++i) { pk += cur[i][0] * S[2 * i]; pq += cur[i][1] * S[2 * i]; pk += cur[i][2] * S[2 * i + 1]; pq += cur[i][3] * S[2 * i + 1]; }
                pk = reduce8(pk); pq = reduce8(pq);
                const float a = scv[0], u = scv[1] * (vv - a * pk);
                o = a * pq + scv[2] * u;
#pragma unroll
                for (int i = 0; i < 8; ++i) { S[2 * i] = a * S[2 * i] + cur[i][0] * u; S[2 * i + 1] = a * S[2 * i + 1] + cur[i][2] * u; }
            } else {
                float po = 0.f;
#pragma unroll
                for (int i = 0; i < 8; ++i) { const float f0 = cur[i][0], f1 = cur[i][2];
                    S[2 * i] = f0 * S[2 * i] + (1.f - f0) * vv; S[2 * i + 1] = f1 * S[2 * i + 1] + (1.f - f1) * vv;
                    po += cur[i][1] * S[2 * i]; po += cur[i][3] * S[2 * i + 1]; }
                o = reduce8(po);
            }
            if (slice == 0) OB[s * 64 + cl] = o;
#pragma unroll
            for (int i = 0; i < 8; ++i) cur[i] = nxt[i];
            scv = nsc; vv = nvv;
        }
        __syncthreads();
        {
            const int s = tid >> 3, c0 = (tid & 7) * 8; const float* ob = OB + s * 64 + c0;
            const f32x4 x0 = *(const f32x4*)ob, x1 = *(const f32x4*)(ob + 4);
            v4u w; w.x = pk2(x0[0], x0[1]); w.y = pk2(x0[2], x0[3]); w.z = pk2(x1[0], x1[1]); w.w = pk2(x1[2], x1[3]);
            *(v4u*)(O + (size_t)(obase + osgn * s) * 512 + c0) = w;
        }
        if (c + 1 < NCH) SCAN_STORE();
        __syncthreads();
        if (c + 1 < NCH) SCAN_QK();
        __syncthreads();
    }
#undef SCAN_ROWS
#undef SCAN_LOAD
#undef SCAN_STORE
#undef SCAN_QK
}

__device__ __forceinline__ unsigned cvtpk(float lo, float hi) { unsigned r; asm volatile("v_cvt_pk_bf16_f32 %0, %1, %2" : "=v"(r) : "v"(lo), "v"(hi)); return r; }
template <int DQK, bool NA>
__device__ __forceinline__ void attn_unit(const Fr& F, const bf16* Qh, int qpitch, int qrow0, bool qrope,
                                          const bf16* K1h, int k1pitch, const bf16* Vth,
                                          int kbase0, int n0, int kbase1, int ntiles, bf16* Yh, float sl2, int lo, int qgr, const float* rpbh, int pidx) {
    const bf16* K2 = WSP(bf16, WS_KROPE);
    constexpr int NDC = DQK / 32, KPB = (DQK + 16) * 2, KBUF = 64 * KPB, VPB = 160, VBUF = 128 * VPB,     BUF = KBUF + VBUF, PPR = DQK / 8, NKP = 64 * PPR / 512;
    static_assert(2 * BUF + 2048 <= 131072, "attn LDS");
    unsigned char* lds = F.lds;
    float* bt = (float*)(lds + 2 * BUF);
    const int tid = F.tid, lane = F.lane, w = F.wave, r16 = lane & 15, quad = lane >> 4;
    if (NA) { for (int i = tid; i < 15 * 32; i += 512) { const int dr = i >> 5, dc = i & 31; bt[i] = (rpbh != nullptr && dc < 31) ? rpbh[dr * 31 + dc] * LOG2E : 0.f; } }
    bf16x8 qf[2][NDC];
#pragma unroll
    for (int n = 0; n < 2; ++n) { const int row = qrow0 + w * 32 + n * 16 + r16;
#pragma unroll
        for (int dc = 0; dc < NDC; ++dc) qf[n][dc] = *(const bf16x8*)(Qh + (size_t)row * qpitch + dc * 32 + quad * 8);
        if (!NA && qrope) { const int t = row & 4095;
#pragma unroll
            for (int dc = 4; dc < NDC; ++dc) {
#pragma unroll
                for (int jj = 0; jj < 4; ++jj) { const f32x2 rc = WSP(const f32x2, WS_ROPE)[t * 32 + (dc - 4) * 16 + quad * 4 + jj]; const float cs = rc[0], sn = rc[1];
                    const float x1 = bf2f((unsigned short)qf[n][dc][2 * jj]), x2 = bf2f((unsigned short)qf[n][dc][2 * jj + 1]);
                    qf[n][dc][2 * jj] = (short)f2bf(x1 * cs - x2 * sn); qf[n][dc][2 * jj + 1] = (short)f2bf(x1 * sn + x2 * cs); } } }
    }
    f32x4 o[8][2];
#pragma unroll
    for (int dt = 0; dt < 8; ++dt) { o[dt][0] = (f32x4){0.f, 0.f, 0.f, 0.f}; o[dt][1] = (f32x4){0.f, 0.f, 0.f, 0.f}; }
    float mrun[2] = {-1e30f, -1e30f}, lsum[2] = {0.f, 0.f};
    v4u kreg[NKP], vreg[2];
    const int gr = qgr + (w >> 1);
    const int w0 = min(max(gr - 4, 0), 56);
#define AT_KROW(i) ((i) < n0 ? kbase0 + 64 * (i) : kbase1 + 64 * ((i) - n0))
#define AT_LOADK(i) do { const int kr0 = AT_KROW(i); _Pragma("unroll") for (int x = 0; x < NKP; ++x) { const int p = tid + 512 * x, key = p / PPR, pc = p % PPR; \
        const bf16* src = (pc < 16) ? K1h + (size_t)(kr0 + key) * k1pitch + pc * 8 : K2 + (size_t)(kr0 + key) * 64 + (pc - 16) * 8; kreg[x] = *(const v4u*)src; } } while (0)
#define AT_LOADV(i) do { const int kr0 = AT_KROW(i); _Pragma("unroll") for (int x = 0; x < 2; ++x) { const int p = tid + 512 * x, d = p >> 3, pc = p & 7; vreg[x] = *(const v4u*)(Vth + (size_t)d * RT + kr0 + pc * 8); } } while (0)
#define AT_STOREK(buf) do { _Pragma("unroll") for (int x = 0; x < NKP; ++x) { const int p = tid + 512 * x, key = p / PPR, pc = p % PPR; \
        const int slot = (key & 32) + ((key >> 2) & 1) * 16 + ((key & 31) >> 3) * 4 + (key & 3); *(v4u*)(lds + (buf) * BUF + slot * KPB + pc * 16) = kreg[x]; } } while (0)
#define AT_STOREV(buf) do { _Pragma("unroll") for (int x = 0; x < 2; ++x) { const int p = tid + 512 * x, d = p >> 3, pc = p & 7; *(v4u*)(lds + (buf) * BUF + KBUF + d * VPB + pc * 16) = vreg[x]; } } while (0)
    AT_LOADK(0); AT_LOADV(0); AT_STOREK(0); AT_STOREV(0); __syncthreads();
    for (int i = 0; i < ntiles; ++i) {
        int tid = F.tid; asm volatile("" : "+v"(tid));
        if (i + 1 < ntiles) AT_LOADK(i + 1);
        const bool win = NA && (i < n0);
        const int kr = lo + i;
        const bool active = !win || (kr >= w0 && kr < w0 + 8);
        const unsigned char* kb = lds + (i & 1) * BUF; const unsigned char* vb = kb + KBUF;
#pragma unroll
        for (int sub = 0; sub < 2; ++sub) {
            if (sub == 1 && i + 1 < ntiles) { AT_STOREK((i + 1) & 1); AT_LOADV(i + 1); }
            if (active) {
                f32x4 s[2][2];
                __builtin_amdgcn_s_setprio(1);
#pragma unroll
                for (int t = 0; t < 2; ++t) { s[t][0] = (f32x4){0.f, 0.f, 0.f, 0.f}; s[t][1] = (f32x4){0.f, 0.f, 0.f, 0.f};
                    if (!NA && t == 1) asm volatile("" ::: "memory");
#pragma unroll
                    for (int dc = 0; dc < NDC; ++dc) { const bf16x8 a = *(const bf16x8*)(kb + (sub * 32 + t * 16 + r16) * KPB + dc * 64 + quad * 16);
                        s[t][0] = __builtin_amdgcn_mfma_f32_16x16x32_bf16(a, qf[0][dc], s[t][0], 0, 0, 0);
                        s[t][1] = __builtin_amdgcn_mfma_f32_16x16x32_bf16(a, qf[1][dc], s[t][1], 0, 0, 0); } }
                __builtin_amdgcn_s_setprio(0);
                bf16x8 pb[2];
#pragma unroll
                for (int n = 0; n < 2; ++n) {
                    float mx = -1e30f;
                    const int qc = (w & 1) * 32 + n * 16 + r16; const int c0 = min(max(qc - 8, 0), 48);
#pragma unroll
                    for (int t = 0; t < 2; ++t)
#pragma unroll
                        for (int j = 0; j < 4; ++j) { float x = s[t][n][j] * sl2;
                            if (win) { const int kc = sub * 32 + quad * 8 + t * 4 + j; const bool ok = (kc >= c0) && (kc < c0 + 16);
                                const int dcc = min(max(kc - qc + 15, 0), 30); const float bb = bt[(kr - gr + 7) * 32 + dcc]; x = ok ? x + bb : -1e30f; }
                            s[t][n][j] = x; mx = fmaxf(mx, x); }
                    mx = fmaxf(mx, __shfl_xor(mx, 16)); mx = fmaxf(mx, __shfl_xor(mx, 32));
                    const float mnew = fmaxf(mrun[n], mx), alpha = __builtin_amdgcn_exp2f(mrun[n] - mnew); mrun[n] = mnew;
                    float ps = 0.f;
#pragma unroll
                    for (int t = 0; t < 2; ++t)
#pragma unroll
                        for (int j = 0; j < 4; ++j) { const float p = __builtin_amdgcn_exp2f(s[t][n][j] - mnew); s[t][n][j] = p; ps += p; }
                    lsum[n] = lsum[n] * alpha + ps;
#pragma unroll
                    for (int dt = 0; dt < 8; ++dt) o[dt][n] = o[dt][n] * alpha;
                    v4u u; u.x = cvtpk(s[0][n][0], s[0][n][1]); u.y = cvtpk(s[0][n][2], s[0][n][3]); u.z = cvtpk(s[1][n][0], s[1][n][1]); u.w = cvtpk(s[1][n][2], s[1][n][3]);
                    pb[n] = __builtin_bit_cast(bf16x8, u);
                }
                __builtin_amdgcn_s_setprio(1);
#pragma unroll
                for (int dt = 0; dt < 8; ++dt) { const bf16x8 a = *(const bf16x8*)(vb + (dt * 16 + r16) * VPB + sub * 64 + quad * 16);
                    o[dt][0] = __builtin_amdgcn_mfma_f32_16x16x32_bf16(a, pb[0], o[dt][0], 0, 0, 0);
                    o[dt][1] = __builtin_amdgcn_mfma_f32_16x16x32_bf16(a, pb[1], o[dt][1], 0, 0, 0); }
                __builtin_amdgcn_s_setprio(0);
            }
        }
        if (i + 1 < ntiles) AT_STOREV((i + 1) & 1);
        __syncthreads();
    }
#pragma unroll
    for (int n = 0; n < 2; ++n) { float lt = lsum[n]; lt += __shfl_xor(lt, 16); lt += __shfl_xor(lt, 32);
        const bool part = (pidx >= 0); const float inv = part ? 1.f : 1.f / lt;
        bf16* PO = WSP(bf16, WS_PO) + (size_t)pidx * 256 * 128; float* PML = WSP(float, WS_PML) + (size_t)pidx * 512;
        const int rl = w * 32 + n * 16 + r16, row = qrow0 + rl;
        bf16* dst = part ? PO + (size_t)rl * 128 + quad * 4 : Yh + (size_t)row * DM + quad * 4;
#pragma unroll
        for (int dt = 0; dt < 8; ++dt) { const f32x4 v = o[dt][n] * inv; v2u u; u.x = cvtpk(v[0], v[1]); u.y = cvtpk(v[2], v[3]); *(v2u*)(dst + dt * 16) = u; }
        if (part && quad == 0) { PML[rl * 2] = mrun[n]; PML[rl * 2 + 1] = lt; } }
#undef AT_KROW
#undef AT_LOADK
#undef AT_LOADV
#undef AT_STOREK
#undef AT_STOREV
}


typedef short s16x4 __attribute__((ext_vector_type(4)));
typedef short v4i16_t __attribute__((ext_vector_type(4)));
__device__ __forceinline__ s16x4 ldtr(const unsigned char* p) { return __builtin_bit_cast(s16x4, __builtin_amdgcn_ds_read_tr16_b64_v4i16((LAS v4i16_t*)p)); }
__device__ __forceinline__ bf16x8 cat8(s16x4 a, s16x4 b) { return __builtin_shufflevector(a, b, 0, 1, 2, 3, 4, 5, 6, 7); }
__device__ __forceinline__ bf16x8 pack8(f32x4 a, f32x4 b) { v4u u; u.x = cvtpk(a[0], a[1]); u.y = cvtpk(a[2], a[3]); u.z = cvtpk(b[0], b[1]); u.w = cvtpk(b[2], b[3]); return __builtin_bit_cast(bf16x8, u); }
constexpr int NCHK = (CTX + SEQ) / 64;
__device__ __forceinline__ int chunk_row_lo(int b, int dir, int c) {
    const int gs = c * 64;
    if (gs < CTX) return NLAT + b * CTX + (dir ? (CTX - 64 - gs) : gs);
    const int t = gs - CTX; return b * SEQ + (dir ? (SEQ - 64 - t) : t);
}

__device__ __forceinline__ void hg_lb(const Fr& F, int l, int h, float (&lbv)[8]) {
    const float* p_lb = inp(F, 17); const int d0 = (F.tid & 15) * 8;
#pragma unroll
    for (int j = 0; j < 8; ++j) lbv[j] = (l == 0) ? 0.f : sigmoidf_(p_lb[512 + h * 128 + d0 + j] - p_lb[h * 128 + d0 + j]);
}
__device__ __forceinline__ void hg_load_qf(const Fr& F, int cid, v4u (&ra)[2], v4u (&rb)[2]) {
    const int chain = cid / NCHK, c = cid % NCHK, b = chain >> 3, h = (chain >> 1) & 3, dir = chain & 1; const int row_lo = chunk_row_lo(b, dir, c);
    const bf16* Z = WSP(bf16, WS_ZH);
#pragma unroll
    for (int i = 0; i < 2; ++i) { const int p = F.tid + 512 * i, m = p >> 4, d0 = (p & 15) * 8;
        const bf16* zr = Z + (size_t)(row_lo + m) * ZP + C_HG + h * 128 + d0; ra[i] = *(const v4u*)(zr + 512 * (1 + dir)); rb[i] = *(const v4u*)zr; }
}
__device__ __forceinline__ void hg_compute_qf(const float (&lbv)[8], const v4u (&ra)[2], const v4u (&rb)[2], float (&qv)[2][8], float (&fv)[2][8]) {
#pragma unroll
    for (int i = 0; i < 2; ++i) { const v4u a = ra[i], b = rb[i];
        const float av[8] = {bflo(a.x), bfhi(a.x), bflo(a.y), bfhi(a.y), bflo(a.z), bfhi(a.z), bflo(a.w), bfhi(a.w)};
        const float bv[8] = {bflo(b.x), bfhi(b.x), bflo(b.y), bfhi(b.y), bflo(b.z), bfhi(b.z), bflo(b.w), bfhi(b.w)};
#pragma unroll
        for (int j = 0; j < 8; ++j) { const float lb = lbv[j]; fv[i][j] = lb + (1.f - lb) * sigmoidf_(av[j]); qv[i][j] = siluf_(bv[j]) * 0.08838834764831845f; } }
}
template <int LP> __device__ __forceinline__ void time_cumsum(const Fr& F, float* Lm, float* SEG, int dir) {
    const int d = F.tid & 127, seg = F.tid >> 7;
    float s = 0.f;
#pragma unroll
    for (int i = 0; i < 16; ++i) { const int t = seg * 16 + i, m = dir ? 63 - t : t; s += Lm[m * LP + d]; Lm[m * LP + d] = s; }
    SEG[seg * 128 + d] = s;
    LDS_BARRIER();
    float off = 0.f;
#pragma unroll
    for (int j = 0; j < 3; ++j) if (j < seg) off += SEG[j * 128 + d];
    if (seg > 0) {
#pragma unroll
        for (int i = 0; i < 16; ++i) { const int t = seg * 16 + i, m = dir ? 63 - t : t; Lm[m * LP + d] += off; } }
    LDS_BARRIER();
}
constexpr int HP = 132;
__device__ __forceinline__ void hg_scores(const Fr& F, int l, int cid, int cid_next, v4u (&ra)[2], v4u (&rb)[2]) {
    const int chain = cid / NCHK, h = (chain >> 1) & 3, dir = chain & 1;
    float* Q_ = (float*)F.lds; float* K_ = Q_ + 64 * HP; float* L_ = K_ + 64 * HP; float* SEG = L_ + 64 * HP;
    bf16* SCG = WSP(bf16, WS_HSC) + (size_t)cid * 4096;
    float qv[2][8], fv[2][8];
    {
        float lbv[8];
        hg_lb(F, l, h, lbv);
        hg_compute_qf(lbv, ra, rb, qv, fv);
        if (cid_next < 32 * NCHK) hg_load_qf(F, cid_next, ra, rb);
#pragma unroll
        for (int i = 0; i < 2; ++i) { const int p = F.tid + 512 * i, m = p >> 4, d0 = (p & 15) * 8;
#pragma unroll
            for (int j = 0; j < 8; ++j) { Q_[m * HP + d0 + j] = qv[i][j]; K_[m * HP + d0 + j] = 1.f - fv[i][j]; L_[m * HP + d0 + j] = __logf(fv[i][j]); } }
    }
    LDS_BARRIER();
    time_cumsum<HP>(F, L_, SEG, dir);
    {
        const int mlast = dir ? 0 : 63;
        bf16* QDG = WSP(bf16, WS_HQD) + (size_t)cid * 8192;
        bf16* KEG = (cid < 1664) ? (bf16*)((unsigned char*)F.out + OUT_HKE) + (size_t)cid * 8192 : WSP(bf16, WS_HKE2) + (size_t)(cid - 1664) * 8192;
#pragma unroll
        for (int i = 0; i < 2; ++i) { const int p = F.tid + 512 * i, m = p >> 4, d0 = (p & 15) * 8;
            float qd[8], ke[8];
#pragma unroll
            for (int j = 0; j < 8; ++j) { const float Lv = L_[m * HP + d0 + j], Lt = L_[mlast * HP + d0 + j]; qd[j] = qv[i][j] * __expf(Lv); ke[j] = (1.f - fv[i][j]) * __expf(Lt - Lv); }
            v4u o; o.x = cvtpk(qd[0], qd[1]); o.y = cvtpk(qd[2], qd[3]); o.z = cvtpk(qd[4], qd[5]); o.w = cvtpk(qd[6], qd[7]); *(v4u*)(QDG + m * 128 + d0) = o;
            o.x = cvtpk(ke[0], ke[1]); o.y = cvtpk(ke[2], ke[3]); o.z = cvtpk(ke[4], ke[5]); o.w = cvtpk(ke[6], ke[7]); *(v4u*)(KEG + m * 128 + d0) = o; }
        if (F.tid < 128) WSP(float, WS_HDL)[(size_t)cid * 128 + F.tid] = __expf(L_[mlast * HP + F.tid]);
    }
    const int lane = F.lane, r16 = lane & 15, quad = lane >> 4;
    for (int p = F.wave; p < 16; p += 8) {
        int ip, jp;
        if (p < 10) { ip = (p >= 6) ? 3 : (p >= 3) ? 2 : (p >= 1) ? 1 : 0; jp = p - ip * (ip + 1) / 2; }
        else { const int r = p - 10; ip = (r >= 5) ? 2 : (r >= 3) ? 1 : 0; jp = (r >= 5) ? 3 : (r >= 3) ? (r - 3 + 2) : (r + 1); }
        const int i = dir ? 3 - ip : ip, j = dir ? 3 - jp : jp;
        f32x4 acc = (f32x4){0.f, 0.f, 0.f, 0.f};
        if (p < 10) {
            const int mt = 16 * i + r16, ms = 16 * j + r16, mref = dir ? 16 * i + 15 : 16 * i;
#pragma unroll
            for (int dk = 0; dk < 4; ++dk) { const int d0 = dk * 32 + quad * 8;
                float av[8], bv[8];
#pragma unroll
                for (int hh = 0; hh < 2; ++hh) { const f32x4 q4 = *(const f32x4*)(Q_ + mt * HP + d0 + 4 * hh), lt = *(const f32x4*)(L_ + mt * HP + d0 + 4 * hh), lr = *(const f32x4*)(L_ + mref * HP + d0 + 4 * hh);
                    const f32x4 k4 = *(const f32x4*)(K_ + ms * HP + d0 + 4 * hh), ls = *(const f32x4*)(L_ + ms * HP + d0 + 4 * hh);
#pragma unroll
                    for (int e = 0; e < 4; ++e) { av[4 * hh + e] = q4[e] * __expf(lt[e] - lr[e]); bv[4 * hh + e] = k4[e] * __expf(fminf(lr[e] - ls[e], 85.f)); } }
                v4u ua, ub; ua.x = cvtpk(av[0], av[1]); ua.y = cvtpk(av[2], av[3]); ua.z = cvtpk(av[4], av[5]); ua.w = cvtpk(av[6], av[7]);
                ub.x = cvtpk(bv[0], bv[1]); ub.y = cvtpk(bv[2], bv[3]); ub.z = cvtpk(bv[4], bv[5]); ub.w = cvtpk(bv[6], bv[7]);
                acc = __builtin_amdgcn_mfma_f32_16x16x32_bf16(__builtin_bit_cast(bf16x8, ua), __builtin_bit_cast(bf16x8, ub), acc, 0, 0, 0); }
        }
        const int ms = 16 * j + r16;
#pragma unroll
        for (int e = 0; e < 4; ++e) { const int mt = 16 * i + 4 * quad + e; const bool ok = (p < 10) && (dir ? (ms >= mt) : (ms <= mt));
            SCG[mt * 64 + ms] = (bf16)f2bf(ok ? acc[e] : 0.f); }
    }
    LDS_BARRIER();
}

constexpr int HS_DL = 0, HS_QD = 512, HS_KE = HS_QD + 64 * 272, HS_V = HS_KE + 64 * 272, HS_SC = HS_V + 64 * 272, HS_END = HS_SC + 64 * 144;
static_assert(HS_END <= 131072, "hgrn seq LDS");
__device__ __forceinline__ void hg_seq(const Fr& F, int l, int chain) {
    const int b = chain >> 3, h = (chain >> 1) & 3, dir = chain & 1;
    const int tid = F.tid, lane = F.lane, w = F.wave, r16 = lane & 15, quad = lane >> 4, tq = (lane & 15) >> 2, tp = lane & 3;
    unsigned char* lds = F.lds;
    float* DL = (float*)(lds + HS_DL);
    const bf16* Z = WSP(bf16, WS_ZH);
    bf16* O = (bf16*)((unsigned char*)F.out + OUT_OH) + (size_t)dir * RT * 512 + h * 128 + 16 * w + r16;
    f32x4 S[8];
#pragma unroll
    for (int dt = 0; dt < 8; ++dt) S[dt] = (f32x4){0.f, 0.f, 0.f, 0.f};
    v4u rQ[2], rK[2], rV[2], rS; float rD = 0.f;
#define HS_LOAD(c) do { const int cid = chain * NCHK + (c); const int rl = chunk_row_lo(b, dir, (c)); \
        const bf16* QDG = WSP(bf16, WS_HQD) + (size_t)cid * 8192; \
        const bf16* KEG = (cid < 1664) ? (const bf16*)((const unsigned char*)F.out + OUT_HKE) + (size_t)cid * 8192 : WSP(bf16, WS_HKE2) + (size_t)(cid - 1664) * 8192; \
        _Pragma("unroll") for (int i = 0; i < 2; ++i) { const int p = tid + 512 * i, m = p >> 4, d0 = (p & 15) * 8; rQ[i] = *(const v4u*)(QDG + m * 128 + d0); rK[i] = *(const v4u*)(KEG + m * 128 + d0); \
            rV[i] = *(const v4u*)(Z + (size_t)(rl + m) * ZP + C_HG + 3 * 512 + h * 128 + d0); } \
        rS = *(const v4u*)(WSP(bf16, WS_HSC) + (size_t)cid * 4096 + tid * 8); \
        if (tid < 128) rD = WSP(float, WS_HDL)[(size_t)cid * 128 + tid]; } while (0)
    HS_LOAD(0);
    for (int c = 0; c < NCHK; ++c) {
        const int row_lo = chunk_row_lo(b, dir, c);
#pragma unroll
        for (int i = 0; i < 2; ++i) { const int p = tid + 512 * i, m = p >> 4, d0 = (p & 15) * 8;
            *(v4u*)(lds + HS_QD + m * 272 + d0 * 2) = rQ[i]; *(v4u*)(lds + HS_KE + m * 272 + d0 * 2) = rK[i]; *(v4u*)(lds + HS_V + m * 272 + d0 * 2) = rV[i]; }
        { const int m = tid >> 3, c0 = (tid & 7) * 8; *(v4u*)(lds + HS_SC + m * 144 + c0 * 2) = rS; }
        if (tid < 128) DL[tid] = rD;
        if (c + 1 < NCHK) HS_LOAD(c + 1);
        LDS_BARRIER();
        bf16x8 vb[2], sb[4];
#pragma unroll
        for (int ks = 0; ks < 2; ++ks) { const unsigned char* p0 = lds + HS_V + (32 * ks + 8 * quad + tq) * 272 + (16 * w + 4 * tp) * 2; vb[ks] = cat8(ldtr(p0), ldtr(p0 + 4 * 272)); }
#pragma unroll
        for (int ks = 0; ks < 4; ++ks) sb[ks] = pack8(S[2 * ks], S[2 * ks + 1]);
#pragma unroll
        for (int i = 0; i < 4; ++i) {
            f32x4 acc = (f32x4){0.f, 0.f, 0.f, 0.f};
            const unsigned char* qrow = lds + HS_QD + (16 * i + r16) * 272;
#pragma unroll
            for (int ks = 0; ks < 4; ++ks) { const bf16x8 a = cat8(*(const s16x4*)(qrow + (32 * ks + 4 * quad) * 2), *(const s16x4*)(qrow + (32 * ks + 16 + 4 * quad) * 2));
                acc = __builtin_amdgcn_mfma_f32_16x16x32_bf16(a, sb[ks], acc, 0, 0, 0); }
            const unsigned char* srow = lds + HS_SC + (16 * i + r16) * 144;
#pragma unroll
            for (int ks = 0; ks < 2; ++ks) { const bf16x8 a = *(const bf16x8*)(srow + (32 * ks + 8 * quad) * 2); acc = __builtin_amdgcn_mfma_f32_16x16x32_bf16(a, vb[ks], acc, 0, 0, 0); }
#pragma unroll
            for (int e = 0; e < 4; ++e) O[(size_t)(row_lo + 16 * i + 4 * quad + e) * 512] = (bf16)f2bf(acc[e]);
        }
#pragma unroll
        for (int dt = 0; dt < 8; ++dt) {
            const f32x4 dl = *(const f32x4*)(DL + 16 * dt + 4 * quad);
            f32x4 acc = S[dt] * dl;
#pragma unroll
            for (int ks = 0; ks < 2; ++ks) { const unsigned char* p0 = lds + HS_KE + (32 * ks + 8 * quad + tq) * 272 + (16 * dt + 4 * tp) * 2;
                acc = __builtin_amdgcn_mfma_f32_16x16x32_bf16(cat8(ldtr(p0), ldtr(p0 + 4 * 272)), vb[ks], acc, 0, 0, 0); }
            S[dt] = acc;
        }
        LDS_BARRIER();
    }
#undef HS_LOAD
}

__device__ __forceinline__ void gd_pre(const Fr& F, int cid) {
    const int chain = cid / NCHK, c = cid % NCHK, b = chain >> 3, h = (chain >> 1) & 3, dir = chain & 1;
    const int row_lo = chunk_row_lo(b, dir, c), lane = F.lane, r16 = lane & 15, quad = lane >> 4;
    float* Af = (float*)(F.lds + F.wave * 16896);
    float* cumL = Af + 4096; float* betaL = cumL + 64;
    const bf16* GQKV = WSP(bf16, WS_GQKV); const float* GB = WSP(float, WS_GB);
    bf16* T1G = (bf16*)((unsigned char*)F.out + OUT_GT) + (size_t)cid * 2 * 4096; bf16* ATG = T1G + 4096;
    float* SCL = WSP(float, WS_GSCAL) + (size_t)cid * 132;
    const float g = GB[(size_t)(row_lo + lane) * 16 + dir * 4 + h], beta = GB[(size_t)(row_lo + lane) * 16 + 8 + dir * 4 + h];
    float cum = g;
#pragma unroll
    for (int off = 1; off < 64; off <<= 1) { const float v = dir ? __shfl_down(cum, off) : __shfl_up(cum, off); const bool ok = dir ? (lane + off < 64) : (lane >= off); if (ok) cum += v; }
    cumL[lane] = cum; betaL[lane] = beta;
    const float last = __shfl(cum, dir ? 0 : 63);
    SCL[lane] = __expf(cum); SCL[64 + lane] = __expf(last - cum); if (lane == 0) SCL[128] = __expf(last);
    LDS_WAIT();
#pragma unroll 1
    for (int i = 0; i < 4; ++i) {
        bf16x8 qf[4], kfi[4];
#pragma unroll
        for (int dk = 0; dk < 4; ++dk) { const bf16* gr = GQKV + (size_t)(row_lo + 16 * i + r16) * 1536 + h * 128 + dk * 32 + quad * 8; qf[dk] = *(const bf16x8*)gr; kfi[dk] = *(const bf16x8*)(gr + 512); }
#pragma unroll 1
        for (int j2 = 0; j2 < 2; ++j2) {
            bf16x8 kfj[2][4];
#pragma unroll
            for (int jj = 0; jj < 2; ++jj)
#pragma unroll
                for (int dk = 0; dk < 4; ++dk) kfj[jj][dk] = *(const bf16x8*)(GQKV + (size_t)(row_lo + 16 * (2 * j2 + jj) + r16) * 1536 + 512 + h * 128 + dk * 32 + quad * 8);
#pragma unroll
            for (int jj = 0; jj < 2; ++jj) { const int j = 2 * j2 + jj;
                f32x4 kk = (f32x4){0.f, 0.f, 0.f, 0.f}, qk = (f32x4){0.f, 0.f, 0.f, 0.f};
#pragma unroll
                for (int dk = 0; dk < 4; ++dk) { kk = __builtin_amdgcn_mfma_f32_16x16x32_bf16(kfi[dk], kfj[jj][dk], kk, 0, 0, 0); qk = __builtin_amdgcn_mfma_f32_16x16x32_bf16(qf[dk], kfj[jj][dk], qk, 0, 0, 0); }
                const int ms = 16 * j + r16, s = dir ? 63 - ms : ms; const float cs = cumL[ms];
#pragma unroll
                for (int e = 0; e < 4; ++e) { const int mt = 16 * i + 4 * quad + e, t = dir ? 63 - mt : mt;
                    const float dec = __expf(fminf(cumL[mt] - cs, 0.f));
                    Af[t * 64 + s] = (s < t) ? betaL[mt] * kk[e] * dec : 0.f;
                    ATG[mt * 64 + ms] = (bf16)f2bf((s <= t) ? qk[e] * dec : 0.f); } }
        }
    }
    LDS_WAIT();
    for (int t = 0; t < 64; ++t) {
        float v0 = (t == lane) ? 1.f : 0.f, v1 = 0.f, v2 = 0.f, v3 = 0.f;
        for (int s0 = 0; s0 < t; s0 += 16) {
            f32x4 a[4]; float ts[16];
#pragma unroll
            for (int x = 0; x < 4; ++x) a[x] = *(const f32x4*)(Af + t * 64 + s0 + 4 * x);
#pragma unroll
            for (int x = 0; x < 16; ++x) ts[x] = Af[(s0 + x) * 64 + lane];
#pragma unroll
            for (int x = 0; x < 4; ++x) {
                v0 -= (s0 + 4 * x + 0 < t) ? a[x][0] * ts[4 * x + 0] : 0.f; v1 -= (s0 + 4 * x + 1 < t) ? a[x][1] * ts[4 * x + 1] : 0.f;
                v2 -= (s0 + 4 * x + 2 < t) ? a[x][2] * ts[4 * x + 2] : 0.f; v3 -= (s0 + 4 * x + 3 < t) ? a[x][3] * ts[4 * x + 3] : 0.f; }
        }
        const float v = (v0 + v1) + (v2 + v3);
        Af[t * 64 + lane] = v;
    }
    LDS_WAIT();
    const int msl = dir ? 63 - lane : lane; const float bs = betaL[msl];
    for (int t = 0; t < 64; ++t) { const int mt = dir ? 63 - t : t; const float tv = Af[t * 64 + lane]; T1G[mt * 64 + msl] = (bf16)f2bf(tv * bs); }
    LDS_WAIT();
}

constexpr int GS_T1 = 0, GS_T2 = 9216, GS_AT = 18432, GS_K = 27648, GS_Q = GS_K + 17408, GS_V = GS_Q + 17408, GS_W = GS_V + 17408, GS_SCL = GS_W + 17408, GS_END = GS_SCL + 1024;
static_assert(GS_END <= 131072, "gdn seq LDS");
__device__ __forceinline__ void gd_seq(const Fr& F, int chain) {
    const int b = chain >> 3, h = (chain >> 1) & 3, dir = chain & 1;
    const int tid = F.tid, lane = F.lane, w = F.wave, r16 = lane & 15, quad = lane >> 4, tq = (lane & 15) >> 2, tp = lane & 3;
    unsigned char* lds = F.lds;
    const bf16* GQKV = WSP(bf16, WS_GQKV);
    const bf16* TG = (const bf16*)((const unsigned char*)F.out + OUT_GT) + (size_t)chain * NCHK * 2 * 4096;
    const float* SCG = WSP(float, WS_GSCAL) + (size_t)chain * NCHK * 132;
    float* SCL = (float*)(lds + GS_SCL);
    bf16* O = (bf16*)((unsigned char*)F.out + OUT_OG) + (size_t)dir * RT * 512 + h * 128 + 16 * w + r16;
    f32x4 S[8];
#pragma unroll
    for (int dt = 0; dt < 8; ++dt) S[dt] = (f32x4){0.f, 0.f, 0.f, 0.f};
    v4u rT[2], rK[2], rQ[2], rV[2]; f32x4 rE[2]; float rS = 0.f;
#define GS_LOAD(c) do { const int rl = chunk_row_lo(b, dir, (c)); \
        _Pragma("unroll") for (int x = 0; x < 2; ++x) rT[x] = *(const v4u*)(TG + ((size_t)(c) * 2 + x) * 4096 + tid * 8); \
        rE[0] = *(const f32x4*)(SCG + (size_t)(c) * 132 + (tid & 7) * 8); rE[1] = *(const f32x4*)(SCG + (size_t)(c) * 132 + (tid & 7) * 8 + 4); \
        _Pragma("unroll") for (int i = 0; i < 2; ++i) { const int p = tid + 512 * i, m = p >> 4, d0 = (p & 15) * 8; const bf16* gr = GQKV + (size_t)(rl + m) * 1536 + h * 128 + d0; \
            rQ[i] = *(const v4u*)gr; rK[i] = *(const v4u*)(gr + 512); rV[i] = *(const v4u*)(gr + 1024); } \
        if (tid < 132) rS = SCG[(size_t)(c) * 132 + tid]; } while (0)
    GS_LOAD(0);
    for (int c = 0; c < NCHK; ++c) {
        const int row_lo = chunk_row_lo(b, dir, c);
        { const int m = tid >> 3, c0 = (tid & 7) * 8;
          *(v4u*)(lds + GS_T1 + m * 144 + c0 * 2) = rT[0]; *(v4u*)(lds + GS_AT + m * 144 + c0 * 2) = rT[1];
          v4u t2; t2.x = cvtpk(-bflo(rT[0].x) * rE[0][0], -bfhi(rT[0].x) * rE[0][1]); t2.y = cvtpk(-bflo(rT[0].y) * rE[0][2], -bfhi(rT[0].y) * rE[0][3]);
          t2.z = cvtpk(-bflo(rT[0].z) * rE[1][0], -bfhi(rT[0].z) * rE[1][1]); t2.w = cvtpk(-bflo(rT[0].w) * rE[1][2], -bfhi(rT[0].w) * rE[1][3]);
          *(v4u*)(lds + GS_T2 + m * 144 + c0 * 2) = t2; }
#pragma unroll
        for (int i = 0; i < 2; ++i) { const int p = tid + 512 * i, m = p >> 4, d0 = (p & 15) * 8;
            *(v4u*)(lds + GS_K + m * 272 + d0 * 2) = rK[i]; *(v4u*)(lds + GS_Q + m * 272 + d0 * 2) = rQ[i]; *(v4u*)(lds + GS_V + m * 272 + d0 * 2) = rV[i]; }
        if (tid < 132) SCL[tid] = rS;
        if (c + 1 < NCHK) GS_LOAD(c + 1);
        LDS_BARRIER();
        {
            bf16x8 kb[2];
#pragma unroll
            for (int ks = 0; ks < 2; ++ks) { const unsigned char* p0 = lds + GS_K + (32 * ks + 8 * quad + tq) * 272 + (16 * w + 4 * tp) * 2; kb[ks] = cat8(ldtr(p0), ldtr(p0 + 4 * 272)); }
#pragma unroll
            for (int i = 0; i < 4; ++i) { f32x4 acc = (f32x4){0.f, 0.f, 0.f, 0.f};
                const unsigned char* trow = lds + GS_T2 + (16 * i + r16) * 144;
#pragma unroll
                for (int ks = 0; ks < 2; ++ks) acc = __builtin_amdgcn_mfma_f32_16x16x32_bf16(*(const bf16x8*)(trow + (32 * ks + 8 * quad) * 2), kb[ks], acc, 0, 0, 0);
#pragma unroll
                for (int e = 0; e < 4; ++e) *(bf16*)(lds + GS_W + (16 * i + 4 * quad + e) * 272 + (16 * w + r16) * 2) = (bf16)f2bf(acc[e]); }
        }
        LDS_BARRIER();
        {
            bf16x8 vb[2], sb[4];
#pragma unroll
            for (int ks = 0; ks < 2; ++ks) { const unsigned char* p0 = lds + GS_V + (32 * ks + 8 * quad + tq) * 272 + (16 * w + 4 * tp) * 2; vb[ks] = cat8(ldtr(p0), ldtr(p0 + 4 * 272)); }
#pragma unroll
            for (int ks = 0; ks < 4; ++ks) sb[ks] = pack8(S[2 * ks], S[2 * ks + 1]);
            f32x4 vn[4];
#pragma unroll
            for (int i = 0; i < 4; ++i) { f32x4 acc = (f32x4){0.f, 0.f, 0.f, 0.f};
                const unsigned char* trow = lds + GS_T1 + (16 * i + r16) * 144;
#pragma unroll
                for (int ks = 0; ks < 2; ++ks) acc = __builtin_amdgcn_mfma_f32_16x16x32_bf16(*(const bf16x8*)(trow + (32 * ks + 8 * quad) * 2), vb[ks], acc, 0, 0, 0);
                const unsigned char* wrow = lds + GS_W + (16 * i + r16) * 272;
#pragma unroll
                for (int ks = 0; ks < 4; ++ks) acc = __builtin_amdgcn_mfma_f32_16x16x32_bf16(cat8(*(const s16x4*)(wrow + (32 * ks + 4 * quad) * 2), *(const s16x4*)(wrow + (32 * ks + 16 + 4 * quad) * 2)), sb[ks], acc, 0, 0, 0);
                vn[i] = acc; }
            bf16x8 vnb[2];
#pragma unroll
            for (int ks = 0; ks < 2; ++ks) vnb[ks] = pack8(vn[2 * ks], vn[2 * ks + 1]);
#pragma unroll
            for (int i = 0; i < 4; ++i) { f32x4 acc = (f32x4){0.f, 0.f, 0.f, 0.f};
                const unsigned char* qrow = lds + GS_Q + (16 * i + r16) * 272;
#pragma unroll
                for (int ks = 0; ks < 4; ++ks) acc = __builtin_amdgcn_mfma_f32_16x16x32_bf16(cat8(*(const s16x4*)(qrow + (32 * ks + 4 * quad) * 2), *(const s16x4*)(qrow + (32 * ks + 16 + 4 * quad) * 2)), sb[ks], acc, 0, 0, 0);
                acc = acc * *(const f32x4*)(SCL + 16 * i + 4 * quad);
                const unsigned char* arow = lds + GS_AT + (16 * i + r16) * 144;
#pragma unroll
                for (int ks = 0; ks < 2; ++ks) acc = __builtin_amdgcn_mfma_f32_16x16x32_bf16(cat8(*(const s16x4*)(arow + (32 * ks + 4 * quad) * 2), *(const s16x4*)(arow + (32 * ks + 16 + 4 * quad) * 2)), vnb[ks], acc, 0, 0, 0);
#pragma unroll
                for (int e = 0; e < 4; ++e) O[(size_t)(row_lo + 16 * i + 4 * quad + e) * 512] = (bf16)f2bf(acc[e]); }
#pragma unroll
            for (int i = 0; i < 4; ++i) vn[i] = vn[i] * *(const f32x4*)(SCL + 64 + 16 * i + 4 * quad);
#pragma unroll
            for (int ks = 0; ks < 2; ++ks) vnb[ks] = pack8(vn[2 * ks], vn[2 * ks + 1]);
            const float elast = SCL[128];
#pragma unroll
            for (int dt = 0; dt < 8; ++dt) { f32x4 acc = S[dt] * elast;
#pragma unroll
                for (int ks = 0; ks < 2; ++ks) { const unsigned char* p0 = lds + GS_K + (32 * ks + 4 * quad + tq) * 272 + (16 * dt + 4 * tp) * 2;
                    acc = __builtin_amdgcn_mfma_f32_16x16x32_bf16(cat8(ldtr(p0), ldtr(p0 + 16 * 272)), vnb[ks], acc, 0, 0, 0); }
                S[dt] = acc; }
        }
        LDS_BARRIER();
    }
#undef GS_LOAD
}

__device__ __forceinline__ void phase_prepass(const Fr& F, int l) {
    {
        const int N = 32 * NCHK, bx = blockIdx.x; int c0, cstep, cend;
        if (F.G == 256) { if (bx < 240) { c0 = bx; cstep = 240; cend = N - 64; } else { c0 = N - 64 + (bx - 240); cstep = 16; cend = N; } }
        else { c0 = bx; cstep = F.G; cend = N; }
        v4u ra[2], rb[2]; if (c0 < cend) hg_load_qf(F, c0, ra, rb);
        for (int cid = c0; cid < cend; cid += cstep) hg_scores(F, l, cid, (cid + cstep < cend) ? cid + cstep : N, ra, rb);
    }
    __syncthreads();
    for (int cid = (F.G - 1 - (int)blockIdx.x) * 8 + F.wave; cid < 32 * NCHK; cid += F.NGW) gd_pre(F, cid);
    __syncthreads();
}

#define XB_TMO      128
#define XB_XCNT(j)  (256  + 64 * (j))
#define XB_XSUB(j)  (1280 + 64 * (j))
#define XB_XGEN(j)  (2304 + 64 * (j))
#define XB_TOP      3328
#define XB_TOPGEN   3392
#define XCD_BAR_WORDS 3456
#define XB_SPIN_CAP (1u << 18)

__device__ __forceinline__ unsigned xb_ld(unsigned* p)              { return __hip_atomic_load(p, __ATOMIC_RELAXED, __HIP_MEMORY_SCOPE_AGENT); }
__device__ __forceinline__ unsigned xb_add(unsigned* p, unsigned v) { return __hip_atomic_fetch_add(p, v, __ATOMIC_RELAXED, __HIP_MEMORY_SCOPE_AGENT); }
__device__ __forceinline__ unsigned xb_xcc_id() { return (unsigned)__builtin_amdgcn_s_getreg((3 << 11) | 20) & 0xFu; }
#define XB_SPIN(cond, bar) do { unsigned _sp = 0; while (cond) { __builtin_amdgcn_s_sleep(1); \
    if ((++_sp & 255u) == 0u) { if (xb_ld(&(bar)[XB_TMO])) break; if (_sp > XB_SPIN_CAP) { atomicAdd(&(bar)[XB_TMO], 1u); break; } } } } while (0)

struct XcdBarrier {
    unsigned* bar; unsigned x;
    volatile LAS unsigned* st;
};

__device__ __forceinline__ XcdBarrier xcd_barrier_post(unsigned* bar, volatile LAS unsigned* st) {
    XcdBarrier b; b.bar = bar; b.x = xb_xcc_id(); b.st = st;
    if (threadIdx.x == 0) (void)xb_add(&bar[XB_XCNT(b.x)], 1u);
    return b;
}
__device__ __forceinline__ void xcd_barrier_complete(unsigned* bar, unsigned x, unsigned& nloc, unsigned& nx) {
    const unsigned G = gridDim.x * gridDim.y * gridDim.z;
    unsigned sum, cnt, mine, sp = 0u;
    for (;;) {
        sum = 0u; cnt = 0u; mine = 0u;
#pragma unroll
        for (unsigned j = 0; j < 16; ++j) { const unsigned c = xb_ld(&bar[XB_XCNT(j)]); sum += c; cnt += (c > 0u) ? 1u : 0u; mine = (j == x) ? c : mine; }
        if (sum == G) break;
        __builtin_amdgcn_s_sleep(1);
        if ((++sp & 255u) == 0u) { if (xb_ld(&bar[XB_TMO])) break; if (sp > XB_SPIN_CAP) { atomicAdd(&bar[XB_TMO], 1u); break; } }
    }
    nloc = mine > 0u ? mine : 1u; nx = cnt > 0u ? cnt : 1u;
}

__device__ __forceinline__ void xcd_barrier(const XcdBarrier& b) {
    asm volatile("s_waitcnt vmcnt(0)" ::: "memory");
    __syncthreads();
    if (threadIdx.x == 0) {
        unsigned* bar = b.bar;
        __builtin_amdgcn_s_waitcnt(0);
        unsigned nloc = b.st[0], nx = b.st[1];
        if (nloc == 0u) { xcd_barrier_complete(bar, b.x, nloc, nx); b.st[0] = nloc; b.st[1] = nx; }
        const unsigned old = xb_add(&bar[XB_XSUB(b.x)], 1u);
        const unsigned gen = old / nloc;
        if (old + 1u == (gen + 1u) * nloc) {
            __builtin_amdgcn_fence(__ATOMIC_RELEASE, "agent");
            asm volatile("s_waitcnt vmcnt(0)" ::: "memory");
            const unsigned og = xb_add(&bar[XB_TOP], 1u);
            const unsigned tg = og / nx;
            if (og + 1u == (tg + 1u) * nx) xb_add(&bar[XB_TOPGEN], 1u);
            else XB_SPIN(xb_ld(&bar[XB_TOPGEN]) == tg, bar);
            __builtin_amdgcn_fence(__ATOMIC_ACQUIRE, "agent");
            xb_add(&bar[XB_XGEN(b.x)], 1u);
            asm volatile("s_waitcnt vmcnt(0)" ::: "memory");
        } else {
            XB_SPIN(xb_ld(&bar[XB_XGEN(b.x)]) == gen, bar);
            __builtin_amdgcn_fence(__ATOMIC_ACQUIRE, "agent");
            asm volatile("s_waitcnt vmcnt(0)" ::: "memory");
        }
    }
    __syncthreads();
}

__device__ __forceinline__ void phase_mixers(const Fr& F, int l) {
    const int G = F.G, nscan = 64, bx = blockIdx.x;
    const bool split = (G == 256);
    const int natt = split ? 192 : G, ab = split ? bx - nscan : bx;
    for (int it = bx; it < 64; it += G) { if (it < 32) gd_seq(RL(F), it); else hg_seq(RL(F), l, it - 32); __syncthreads(); }
    const bf16* Z = WSP(bf16, WS_ZH); bf16* Y = WSP(bf16, WS_AY);
    const bf16* MQ = WSP(bf16, WS_MQ); const bf16* MK = WSP(bf16, WS_MK); const bf16* MVT = WSP(bf16, WS_MVT); const bf16* NAVT = WSP(bf16, WS_NAVT); const bf16* KROPE = WSP(bf16, WS_KROPE);
    const int ntot = 512 + (l == 0 ? 32 : 0);
    const float sl_mla = 0.07216878364870322f * LOG2E, sl_na = 0.08838834764831845f * LOG2E;
    for (int k = 0; ; ++k) {
        int p, t0 = 0, nl = 64, pidx = -1;
        if (split && bx < 64) {
            if (bx < 32) { if (k >= 1) break; p = 256 + 64 + bx; } else { if (k >= 2) break; p = 256 + 2 * (bx - 32) + k; }
        } else if (split) {
            if (k == 0) p = ab;
            else if (k == 1) { const int su = ab / 3, part = ab - 3 * su; p = 192 + su; t0 = part * 23; nl = part == 2 ? 18 : 23; pidx = ab; }
            else if (k == 2) { if (ab >= 160) continue; p = 256 + 96 + ab; }
            else if (k == 3) { if (l != 0 || ab < 160) break; p = 512 + (ab - 160); }
            else break;
        } else { p = ab + k * natt; if (p >= ntot) break; }
        if (p < 256 || (p >= 512 && p < 528)) {
            const bool lat = p < 256; const int b_ = lat ? (p >> 6) : ((p - 512) >> 2), h_ = lat ? ((p >> 4) & 3) : (p & 3), qb_ = p & 15;
            attn_unit<192, false>(RL(F), MQ + h_ * 192, 768, lat ? b_ * SEQ + qb_ * 256 : NLAT + b_ * CTX, lat, MK + h_ * 128, 512, MVT + (size_t)h_ * 128 * RT,
                                  lat ? b_ * SEQ + t0 * 64 : 0, lat ? nl : 0, NLAT + b_ * CTX, lat ? ((pidx >= 0 && t0 < 46) ? nl : nl + 4) : 4, Y + 1024 + h_ * 128, sl_mla, 0, 0, nullptr, pidx);
        } else {
            const bool lat = p < 512; const int v_ = lat ? p - 256 : p - 528, b_ = lat ? (v_ >> 6) : (v_ >> 2), h_ = lat ? ((v_ >> 4) & 3) : (v_ & 3), rg_ = v_ & 15;
            const int lo_ = min(max(4 * rg_ - 4, 0), 56), hi_ = min(max(4 * rg_ + 3 - 4, 0), 56) + 7, nwin_ = lat ? hi_ - lo_ + 1 : 0;
            attn_unit<128, true>(RL(F), Z + C_NA + h_ * 128, ZP, lat ? b_ * SEQ + rg_ * 256 : NLAT + b_ * CTX, false, Z + C_NA + 512 + h_ * 128, ZP, NAVT + (size_t)h_ * 128 * RT,
                                 lat ? b_ * SEQ + lo_ * 64 : 0, nwin_, NLAT + b_ * CTX, nwin_ + 4, Y + 512 + h_ * 128, sl_na, lat ? lo_ : 0, lat ? 4 * rg_ : 0,
                                 lat ? inp(F, 11) + (size_t)(l * 4 + h_) * 15 * 31 : nullptr, -1);
        }
        __syncthreads();
    }
}

template <class Epi, bool OPAQUE_K = false>
__device__ __forceinline__ void run_gemm(const Fr& F, const bf16* A, const bf16* Bt, int M, int N, int K, const Epi& E) {
    if (OPAQUE_K) asm volatile("" : "+s"(K));
    pg8::Gemm g{A, Bt, M, N, K, K, K}; pg8::StaticOrder S; S.init(M, N, F.G, (int)blockIdx.x);
    pg8::gemm_phase<Epi, pg8::StaticOrder, true, true>((LAS unsigned char*)F.lds, g, S, E);
}

__device__ __forceinline__ void run_gemm_splitk(const Fr& F, const bf16* A, int lda, const bf16* Bt, int ldb, int M, int N, int K, int KS, const pg8::EpiCtxSplit& E) {
    pg8::Gemm g{A, Bt, M, N, K, lda, ldb}; pg8::SplitKOrder S; S.init(M, N, KS, F.G, (int)blockIdx.x);
    pg8::gemm_phase<pg8::EpiCtxSplit, pg8::SplitKOrder, true, true>((LAS unsigned char*)F.lds, g, S, E);
}

__global__ void __launch_bounds__(512, 2) mk_fwd(Args args) {
    extern __shared__ __attribute__((aligned(16))) unsigned char lds[];
    cg::grid_group grid = cg::this_grid();
    Fr F; F.kp = (kargp_t)__builtin_amdgcn_kernarg_segment_ptr(); F.out = args.out; F.ws = args.ws; F.lds = lds;
    F.tid = threadIdx.x; F.lane = F.tid & 63; F.wave = __builtin_amdgcn_readfirstlane(F.tid >> 6); F.G = gridDim.x;
    F.gw = blockIdx.x * 8 + F.wave; F.NGW = F.G * 8;
#define ADA WSP(float, WS_ADA)
#define AY WSP(bf16, WS_AY)
#define X WSP(float, WS_X)
#define ZH WSP(bf16, WS_ZH)
    unsigned* barw = (unsigned*)args.ws;
    if (blockIdx.x == 0) for (int i = threadIdx.x; i < 4096; i += 512) barw[i] = 0u;
    volatile LAS unsigned* bst = (volatile LAS unsigned*)((LAS unsigned char*)lds + 144000);
    if (threadIdx.x < 4) bst[threadIdx.x] = 0u;
    __syncthreads();

    phase_ada(RL(F)); __syncthreads(); { const Fr Fw = RL(F); phase_wconv(Fw, 0, 0, Fw.gw, Fw.NGW); }
    grid.sync();
    const XcdBarrier xb = xcd_barrier_post(barw, bst);
    phase_mod0(RL(F));
    xcd_barrier(xb);
    for (int l = 0; l < 2; ++l) {
        const int MR = (l == 0) ? RT : NLAT;
        run_gemm(F, AY, WSP(bf16, WS_WIN), RT, ZP, DM, pg8::EpiStore<0>{ZH, ZP});
        {
            const int rem = ((RT / 256) * (ZP / 256)) % F.G, first = rem == 0 ? 0 : rem;
            if ((int)blockIdx.x >= first) { __syncthreads(); const Fr Fw = RL(F); phase_wconv(Fw, l, 1, ((int)blockIdx.x - first) * 8 + Fw.wave, (F.G - first) * 8); }
        }
        xcd_barrier(xb);
        phase_prep(RL(F), l);
        xcd_barrier(xb);
        run_gemm<pg8::EpiStore<0>, true>(F, WSP(bf16, WS_QN), WSP(bf16, WS_WUQ), RT, 768, 384, pg8::EpiStore<0>{WSP(bf16, WS_MQ), 768});
        run_gemm<pg8::EpiStore<0>, true>(F, WSP(bf16, WS_CKVN), WSP(bf16, WS_WUK), RT, 512, 256, pg8::EpiStore<0>{WSP(bf16, WS_MK), 512});
        run_gemm<pg8::EpiStore<0>, true>(F, WSP(bf16, WS_WUV), WSP(bf16, WS_CKVN), 512, RT, 256, pg8::EpiStore<0>{WSP(bf16, WS_MVT), RT});
        phase_prepass(RL(F), l);
        xcd_barrier(xb);
        phase_mixers(RL(F), l);
        xcd_barrier(xb);
        phase_post(RL(F), l, MR);
        xcd_barrier(xb);
        if (l == 0) run_gemm(F, AY, WSP(bf16, WS_WOUT), RT, DM, DM, pg8::EpiResid{inp(F, 0), inp(F, 2), X, ADA + 2 * 2048, ALPHA_RES});
        else run_gemm(F, AY, WSP(bf16, WS_WOUT), NLAT, DM, DM, pg8::EpiResid{X, X, X, ADA + (size_t)5 * ADAW + 2 * 2048, ALPHA_RES});
        xcd_barrier(xb);
        phase_ln(RL(F), l, 1, MR);
        xcd_barrier(xb);
        run_gemm(F, AY, WSP(bf16, WS_WM1), MR, FF, DM, pg8::EpiStore<1>{ZH, FF});
        if (l == 0) {
            const int rem = ((MR / 256) * (FF / 256)) % F.G, first = rem;
            if ((int)blockIdx.x >= first) { __syncthreads(); const Fr Fw = RL(F); phase_wconv(Fw, 1, 0, ((int)blockIdx.x - first) * 8 + Fw.wave, (F.G - first) * 8); }
        }
        xcd_barrier(xb);
        run_gemm(F, ZH, WSP(bf16, WS_WM2), NLAT, DM, FF, pg8::EpiResid{X, X, X, ADA + (size_t)l * 5 * ADAW + 5 * 2048, 1.f});
        if (l == 0) {
            run_gemm_splitk(F, ZH + (size_t)NLAT * FF, FF, WSP(bf16, WS_WM2), FF, NCTX, DM, FF / 2, 2, pg8::EpiCtxSplit{X + (size_t)NLAT * DM, WSP(float, WS_PART), ADA + 4 * ADAW + 5 * 2048});
        }
        xcd_barrier(xb);
        phase_ln(RL(F), l, 2, MR);
        if (l == 0) xcd_barrier(xb);
    }
}
#undef ADA
#undef AY
#undef X
#undef ZH

extern "C" void kernel_launch(void* const* d_in, const int* in_sizes, int n_in, void* d_out, int out_size, void* d_ws, size_t ws_size, hipStream_t stream) {
    static int grid = 0;
    if (grid == 0) {
        int dev = 0, cus = 0, per_cu = 0;
        if (n_in != 26 || ws_size < WS_END) { fprintf(stderr, "kernel_launch: unexpected n_in %d / ws %zu (need %zu)\n", n_in, ws_size, (size_t)WS_END); grid = -1; return; }
        (void)hipGetDevice(&dev); (void)hipDeviceGetAttribute(&cus, hipDeviceAttributeMultiprocessorCount, dev);
        if (hipFuncSetAttribute((const void*)mk_fwd, hipFuncAttributeMaxDynamicSharedMemorySize, LDS_BYTES) != hipSuccess) { fprintf(stderr, "kernel_launch: hipFuncSetAttribute failed\n"); grid = -1; return; }
        if (hipOccupancyMaxActiveBlocksPerMultiprocessor(&per_cu, (const void*)mk_fwd, 512, LDS_BYTES) != hipSuccess || per_cu < 1) per_cu = 1;
        (void)hipGetLastError();
        grid = cus * 1;
        fprintf(stderr, "kernel_launch: grid %d (cus %d, occupancy query %d), ws %zu\n", grid, cus, per_cu, ws_size);
    }
    if (grid < 0) return;
    Args a{};
    for (int i = 0; i < 26; ++i) a.in[i] = (const float*)d_in[i];
    a.out = (float*)d_out; a.ws = (unsigned char*)d_ws;
    void* kargs[] = {&a};
    const hipError_t e = hipLaunchCooperativeKernel((const void*)mk_fwd, dim3(grid), dim3(512), kargs, LDS_BYTES, stream);
    if (e != hipSuccess) fprintf(stderr, "kernel_launch: cooperative launch failed: %s (grid %d)\n", hipGetErrorString(e), grid);
}
```
